# Optimizing an MI355X kernel written in HIP

```python
import jax
import jax.numpy as jnp
from jax import lax
import numpy as np


D_MODEL = 1024
BATCH = 16
SEQ = 2048
DEPTH = 1

SB_HEADS = 16
SB_HEAD_DIM = 64
SB_WIDTH = SB_HEADS * SB_HEAD_DIM
RET_HEADS = 4
RET_QK_DIM = 256
RET_V_DIM = 2 * RET_QK_DIM
RET_QK_WIDTH = RET_HEADS * RET_QK_DIM
RET_V_WIDTH = RET_HEADS * RET_V_DIM
N_BRANCH = 2
BLOCK = 128
D_FF = -(-8 * D_MODEL // (3 * 256)) * 256
ROPE_BASE = 10000.0
EPS = 1e-6
N_MOD = 6
IN_SPLITS = (SB_WIDTH, 2 * SB_WIDTH, 3 * SB_WIDTH,
             3 * SB_WIDTH + RET_QK_WIDTH,
             3 * SB_WIDTH + 2 * RET_QK_WIDTH,
             3 * SB_WIDTH + 2 * RET_QK_WIDTH + RET_V_WIDTH,
             3 * SB_WIDTH + 2 * RET_QK_WIDTH + 2 * RET_V_WIDTH)
IN_WIDTH = 3 * SB_WIDTH + 2 * RET_QK_WIDTH + 2 * RET_V_WIDTH + N_BRANCH * D_MODEL

kernel_name = 'hybrid_stickbreaking_retention_block'


def rmsnorm(t, g):
    tf = t.astype(jnp.float32)
    y = tf * lax.rsqrt(jnp.mean(tf * tf, axis=-1, keepdims=True) + EPS)
    return (y * g.astype(jnp.float32)).astype(t.dtype)


def head_rmsnorm(t):
    tf = t.astype(jnp.float32)
    return (tf * lax.rsqrt(jnp.mean(tf * tf, axis=-1, keepdims=True) + EPS)).astype(t.dtype)


def modulate(h, shift, scale):
    return h * (1.0 + scale[:, None, :]) + shift[:, None, :]


def rotary(t):
    s, d = t.shape[1], t.shape[-1]
    inv_freq = ROPE_BASE ** (-jnp.arange(0, d, 2, dtype=jnp.float32) / d)
    ang = jnp.arange(s, dtype=jnp.float32)[:, None] * inv_freq[None, :]
    cos = jnp.cos(ang)[None, :, None, :]
    sin = jnp.sin(ang)[None, :, None, :]
    t1, t2 = jnp.split(t.astype(jnp.float32), 2, axis=-1)
    return jnp.concatenate([t1 * cos - t2 * sin, t1 * sin + t2 * cos], axis=-1).astype(t.dtype)


def stick_breaking_attention(q, k, v):
    s_len = q.shape[2]
    scale = SB_HEAD_DIM ** -0.5
    outs = []
    for i in range(s_len // BLOCK):
        end = (i + 1) * BLOCK
        qb = q[:, :, i * BLOCK:end]
        kb = k[:, :, :end]
        vb = v[:, :, :end]
        z = jnp.einsum('bhtd,bhsd->bhts', qb, kb).astype(jnp.float32) * scale
        t_pos = i * BLOCK + jnp.arange(BLOCK)
        s_pos = jnp.arange(end)
        mask = s_pos[None, :] < t_pos[:, None]
        log_1m_beta = jnp.where(mask, jax.nn.log_sigmoid(-z), 0.0)
        after = lax.cumsum(log_1m_beta, axis=3, reverse=True) - log_1m_beta
        log_a = jax.nn.log_sigmoid(z) + after
        a = jnp.where(mask, jnp.exp(log_a), 0.0)
        outs.append(jnp.einsum('bhts,bhsd->bhtd', a.astype(v.dtype), vb))
    return jnp.concatenate(outs, axis=2)


def retention(q, k, v):
    out_dtype = v.dtype
    q = q.astype(jnp.float32)
    k = k.astype(jnp.float32)
    v = v.astype(jnp.float32)
    b, h, s_len, dk = q.shape
    dv = v.shape[-1]
    n_chunks = s_len // BLOCK
    log_gamma = jnp.log(1.0 - 2.0 ** (-5.0 - jnp.arange(h, dtype=jnp.float32)))
    idx = jnp.arange(BLOCK, dtype=jnp.float32)
    diff = idx[:, None] - idx[None, :]
    decay_mask = jnp.where(diff >= 0, jnp.exp(jnp.maximum(diff, 0.0) * log_gamma[:, None, None]), 0.0)
    query_decay = jnp.exp((idx + 1.0) * log_gamma[:, None])
    key_decay = jnp.exp((BLOCK - 1.0 - idx) * log_gamma[:, None])
    chunk_decay = jnp.exp(BLOCK * log_gamma)
    qc = q.reshape(b, h, n_chunks, BLOCK, dk)
    kc = k.reshape(b, h, n_chunks, BLOCK, dk)
    vc = v.reshape(b, h, n_chunks, BLOCK, dv)
    scores = jnp.einsum('bhncd,bhnmd->bhncm', qc, kc) * decay_mask[None, :, None]
    intra = jnp.einsum('bhncm,bhnme->bhnce', scores, vc)
    k_dec = kc * key_decay[None, :, None, :, None]

    def step(state, xs):
        q_i, k_i, v_i = xs
        cross = jnp.einsum('bhcd,bhde->bhce', q_i, state) * query_decay[None, :, :, None]
        state = state * chunk_decay[None, :, None, None] + jnp.einsum('bhcd,bhce->bhde', k_i, v_i)
        return state, cross

    xs = (jnp.moveaxis(qc, 2, 0), jnp.moveaxis(k_dec, 2, 0), jnp.moveaxis(vc, 2, 0))
    init = jnp.zeros((b, h, dk, dv), jnp.float32)
    _, cross = lax.scan(step, init, xs)
    out = intra + jnp.moveaxis(cross, 0, 2)
    return out.reshape(b, h, s_len, dv).astype(out_dtype)


def setup_inputs(seed: int = 0) -> dict:
    key = jax.random.key(seed)
    ks = jax.random.split(key, 14)

    def nrm(k, shape, fan_in):
        return jax.random.normal(k, shape, jnp.float32) * (fan_in ** -0.5)

    x = jax.random.normal(ks[0], (BATCH, SEQ, D_MODEL), jnp.float32)
    c = jax.random.normal(ks[1], (BATCH, D_MODEL), jnp.float32)
    w_ada = nrm(ks[2], (DEPTH, D_MODEL, N_MOD * D_MODEL), D_MODEL)
    b_ada = 0.02 * jax.random.normal(ks[3], (DEPTH, N_MOD * D_MODEL), jnp.float32)
    g_norm1 = 1.0 + 0.02 * jax.random.normal(ks[4], (DEPTH, D_MODEL), jnp.float32)
    w_in = nrm(ks[5], (DEPTH, D_MODEL, IN_WIDTH), D_MODEL)
    b_branch = 0.02 * jax.random.normal(ks[6], (DEPTH, N_BRANCH * D_MODEL), jnp.float32)
    w_proj_sb = nrm(ks[7], (DEPTH, SB_WIDTH, D_MODEL), SB_WIDTH)
    w_proj_ret = nrm(ks[8], (DEPTH, RET_V_WIDTH, D_MODEL), RET_V_WIDTH)
    w_out = nrm(ks[9], (DEPTH, D_MODEL, D_MODEL), D_MODEL)
    g_norm2 = 1.0 + 0.02 * jax.random.normal(ks[10], (DEPTH, D_MODEL), jnp.float32)
    w_ffn_in = nrm(ks[11], (DEPTH, D_MODEL, 2 * D_FF), D_MODEL)
    w_ffn_out = nrm(ks[12], (DEPTH, D_FF, D_MODEL), D_FF)
    g_final = 1.0 + 0.02 * jax.random.normal(ks[13], (D_MODEL,), jnp.float32)
    return {'x': x, 'c': c, 'w_ada': w_ada, 'b_ada': b_ada, 'g_norm1': g_norm1,
            'w_in': w_in, 'b_branch': b_branch, 'w_proj_sb': w_proj_sb,
            'w_proj_ret': w_proj_ret, 'w_out': w_out, 'g_norm2': g_norm2,
            'w_ffn_in': w_ffn_in, 'w_ffn_out': w_ffn_out, 'g_final': g_final}


def reference(x, c, w_ada, b_ada, g_norm1, w_in, b_branch, w_proj_sb, w_proj_ret,
              w_out, g_norm2, w_ffn_in, w_ffn_out, g_final):
    b, s_len, _ = x.shape
    c_act = jax.nn.silu(c)
    for l in range(DEPTH):
        mod = jnp.einsum('bd,de->be', c_act, w_ada[l]) + b_ada[l]
        shift1, scale1, gate1, shift2, scale2, gate2 = jnp.split(mod, N_MOD, axis=-1)

        hmix = modulate(rmsnorm(x, g_norm1[l]), shift1, scale1)
        proj = jnp.einsum('bsd,de->bse', hmix, w_in[l])
        sb_q, sb_k, sb_v, r_q, r_k, r_v, r_g, br = jnp.split(proj, IN_SPLITS, axis=-1)

        def sb_heads(t):
            return t.reshape(b, s_len, SB_HEADS, SB_HEAD_DIM).transpose(0, 2, 1, 3)
        o_sb = stick_breaking_attention(sb_heads(sb_q), sb_heads(sb_k), sb_heads(sb_v))
        o_sb = o_sb.transpose(0, 2, 1, 3).reshape(b, s_len, SB_WIDTH)

        rq = rotary(r_q.reshape(b, s_len, RET_HEADS, RET_QK_DIM))
        rk = rotary(r_k.reshape(b, s_len, RET_HEADS, RET_QK_DIM)) * (RET_QK_DIM ** -0.5)
        rv = r_v.reshape(b, s_len, RET_HEADS, RET_V_DIM)
        o_ret = retention(rq.transpose(0, 2, 1, 3), rk.transpose(0, 2, 1, 3), rv.transpose(0, 2, 1, 3))
        o_ret = head_rmsnorm(o_ret.transpose(0, 2, 1, 3)).reshape(b, s_len, RET_V_WIDTH)
        o_ret = jax.nn.silu(r_g) * o_ret

        g_sb, g_ret = jnp.split(jax.nn.sigmoid(br + b_branch[l]), N_BRANCH, axis=-1)
        merged = (g_sb * jnp.einsum('bse,ed->bsd', o_sb, w_proj_sb[l])
                  + g_ret * jnp.einsum('bse,ed->bsd', o_ret, w_proj_ret[l]))
        x = x + gate1[:, None, :] * jnp.einsum('bsd,de->bse', merged, w_out[l])

        hffn = modulate(rmsnorm(x, g_norm2[l]), shift2, scale2)
        a, u = jnp.split(jnp.einsum('bsd,df->bsf', hffn, w_ffn_in[l]), 2, axis=-1)
        x = x + gate2[:, None, :] * jnp.einsum('bsf,fd->bsd', jax.nn.silu(a) * u, w_ffn_out[l])

    return rmsnorm(x, g_final)
```

```cpp
#include <hip/hip_runtime.h>
#include <hip/hip_cooperative_groups.h>
#include <cstdio>
#include <cstdint>
namespace cg = cooperative_groups;
namespace pg8 {
#define PG8_LAS __attribute__((address_space(3)))
typedef unsigned short bf16_t;
typedef short bf16x8 __attribute__((ext_vector_type(8)));
typedef float f32x4 __attribute__((ext_vector_type(4)));
typedef unsigned u32x4 __attribute__((ext_vector_type(4)));
constexpr int BM = 256, BK = 64, HALF = 128, HTB = HALF * BK * 2  , STAGE_BYTES = 8 * HTB, NXCD = 8, WGM = 8;

__host__ __device__ __forceinline__ int lds_byte(int r, int c) { const int st = (r >> 4) * 2 + (c >> 5), rr = r & 15, cc = c & 31, ob = rr * 64 + cc * 2; return st * 1024 + (ob ^ (((ob >> 9) & 1) << 5)); }
__host__ __device__ __forceinline__ void stage_rc(int b, int& R, int& C) { const int st = b / 1024, sb = b % 1024, swz = sb ^ (((sb >> 9) & 1) << 5); R = (st >> 1) * 16 + swz / 64; C = (st & 1) * 32 + (swz % 64) / 2; }
__host__ __device__ __forceinline__ int perm32(int rho) { const int n = rho >> 4, i = rho & 15; return 8 * (i >> 2) + 4 * n + (i & 3); }

struct Unit { int pm, pn; };
struct Gemm { const bf16_t* A; const bf16_t* Bt; int M, N, K; };

struct StaticOrder {
    int nM, nN, nwg, G, c;
    __host__ __device__ void init(int M, int N, int G_, int c_) { nM = M / BM; nN = N / BM; nwg = nM * nN; G = G_; c = c_; }
    __host__ __device__ bool next(int i, Unit& u) const {
        const long L = (long)i * G + c; if (L >= nwg) return false;
        int wgid = (int)L; { const int q = nwg / NXCD, r = nwg % NXCD, xcd = wgid % NXCD, off = wgid / NXCD; wgid = (xcd < r ? xcd * (q + 1) : r * (q + 1) + (xcd - r) * q) + off; }
        const int nig = WGM * nN, gid = wgid / nig, fm = gid * WGM, gsz = (nM - fm) < WGM ? (nM - fm) : WGM;
        u.pm = fm + ((wgid % nig) % gsz); u.pn = (wgid % nig) / gsz; return true;
    }
    __device__ __forceinline__ void a_ready(const Unit&) const {}
    __device__ __forceinline__ void done(const Unit&) const {}
};

__device__ __forceinline__ unsigned cvt_pk_bf16(float lo, float hi) { unsigned r; asm volatile("v_cvt_pk_bf16_f32 %0, %1, %2" : "=v"(r) : "v"(lo), "v"(hi)); return r; }
template <class Epi, class Sched, bool ALIGN_EPI = false, bool SP2 = false>
__device__ __forceinline__ void gemm_phase(PG8_LAS unsigned char* lds, const Gemm g, const Sched& S, const Epi& E) {
    const int tid = threadIdx.x, wid = __builtin_amdgcn_readfirstlane(tid >> 6), lane = tid & 63, wr = wid >> 2, wc = wid & 3, fr = lane & 15, fq = lane >> 4;
    const int K = g.K, nt = K / BK;
    unsigned voffA[2], voffB[2];
#pragma unroll
    for (int i = 0; i < 2; ++i) { int R, C; stage_rc(tid * 16 + i * 8192, R, C); const int Rb = Epi::PERM ? ((R & ~31) + perm32(R & 31)) : R;
        voffA[i] = (unsigned)(R * K + C) * 2u; voffB[i] = (unsigned)(Rb * K + C) * 2u; }
    const size_t kstep = (size_t)(BK * 2);
    const size_t hstep = (size_t)HALF * K * 2;
    const size_t tstep = 2 * hstep;
    const unsigned ldsw = (unsigned)wid * 1024u;
    const int aoff = lds_byte(wr * 64 + fr, fq * 8), boff = lds_byte(wc * 32 + fr, fq * 8);
#define PG8_SA(b, h) (((b) * 2 + (h)) * HTB)
#define PG8_SB(b, h) ((4 + (b) * 2 + (h)) * HTB)
#define PG8_STAGE(bufoff, gbase, voff) do { _Pragma("unroll") for (int _i = 0; _i < 2; ++_i) \
        __builtin_amdgcn_global_load_lds((const unsigned*)((const char*)(gbase) + (voff)[_i]), (PG8_LAS unsigned*)(lds + (bufoff) + ldsw + _i * 8192), 16, 0, 0); } while (0)
#define PG8_LDA(dst, b, h) do { _Pragma("unroll") for (int m = 0; m < 4; ++m) _Pragma("unroll") for (int k = 0; k < 2; ++k) dst[m][k] = *(const PG8_LAS bf16x8*)(lds + PG8_SA(b, h) + aoff + m * 2048 + k * 1024); } while (0)
#define PG8_LDB(dst, b, h) do { _Pragma("unroll") for (int n = 0; n < 2; ++n) _Pragma("unroll") for (int k = 0; k < 2; ++k) dst[n][k] = *(const PG8_LAS bf16x8*)(lds + PG8_SB(b, h) + boff + n * 2048 + k * 1024); } while (0)
#define PG8_MMA(ai, bj, At, Bt) do { __builtin_amdgcn_s_setprio(1); _Pragma("unroll") for (int m = 0; m < 4; ++m) _Pragma("unroll") for (int n = 0; n < 2; ++n) _Pragma("unroll") for (int k = 0; k < 2; ++k) \
        acc[ai][bj][m][n] = __builtin_amdgcn_mfma_f32_16x16x32_bf16(Bt[n][k], At[m][k], acc[ai][bj][m][n], 0, 0, 0); __builtin_amdgcn_s_setprio(0); } while (0)
#define PG8_WAIT_V(n) asm volatile("s_waitcnt vmcnt(" #n ")" ::: "memory")
#define PG8_WAIT_L(n) asm volatile("s_waitcnt lgkmcnt(" #n ")" ::: "memory")
#define PG8_BAR __builtin_amdgcn_s_barrier()
#define PG8_SCHED __builtin_amdgcn_sched_barrier(0)
    Unit cur, nxt; int ui = 0;
    if (!S.next(0, cur)) return;
    f32x4 acc[2][2][4][2];
#pragma unroll
    for (int a = 0; a < 2; ++a)
#pragma unroll
        for (int b = 0; b < 2; ++b)
#pragma unroll
            for (int m = 0; m < 4; ++m)
#pragma unroll
                for (int n = 0; n < 2; ++n) acc[a][b][m][n] = (f32x4){0.f, 0.f, 0.f, 0.f};
    bf16x8 At[4][2], B0[2][2], B1[2][2];
    const char* cA = (const char*)g.A + (size_t)cur.pm * tstep; const char* cB = (const char*)g.Bt + (size_t)cur.pn * tstep;
    S.a_ready(cur);
    if constexpr (SP2) {
        PG8_STAGE(PG8_SB(0, 0), cB, voffB); PG8_STAGE(PG8_SB(0, 1), cB + hstep, voffB); PG8_STAGE(PG8_SA(0, 0), cA, voffA); PG8_STAGE(PG8_SA(0, 1), cA + hstep, voffA);
        if (wr == 1) PG8_BAR;
        PG8_WAIT_V(2); PG8_BAR;
        PG8_STAGE(PG8_SB(1, 0), cB + kstep, voffB); PG8_STAGE(PG8_SA(1, 0), cA + kstep, voffA); PG8_STAGE(PG8_SB(1, 1), cB + hstep + kstep, voffB);
        PG8_WAIT_V(6); PG8_BAR;
    } else {
        PG8_STAGE(PG8_SB(0, 0), cB, voffB); PG8_STAGE(PG8_SA(0, 0), cA, voffA); PG8_STAGE(PG8_SB(0, 1), cB + hstep, voffB); PG8_STAGE(PG8_SA(0, 1), cA + hstep, voffA);
        if (wr == 1) PG8_BAR;
        PG8_WAIT_V(4); PG8_BAR;
        PG8_STAGE(PG8_SB(1, 0), cB + kstep, voffB); PG8_STAGE(PG8_SA(1, 0), cA + kstep, voffA); PG8_STAGE(PG8_SB(1, 1), cB + hstep + kstep, voffB);
        PG8_WAIT_V(6); PG8_BAR;
    }
    for (;;) {
        const bool has_next = S.next(ui + 1, nxt);
        const char* nA = has_next ? (const char*)g.A + (size_t)nxt.pm * tstep : cA; const char* nB = has_next ? (const char*)g.Bt + (size_t)nxt.pn * tstep : cB;
        for (int t = 0; t < nt; t += 2) {
            const bool last = (t == nt - 2);
            const char* a1 = cA + (size_t)(t + 1) * kstep;
            const char* a2 = last ? nA : cA + (size_t)(t + 2) * kstep; const char* b2 = last ? nB : cB + (size_t)(t + 2) * kstep;
            const char* a3 = a2 + kstep; const char* b3 = b2 + kstep;
            if (last && has_next) S.a_ready(nxt);
            if constexpr (SP2) {
            PG8_LDB(B0, 0, 0); PG8_LDB(B1, 0, 1); PG8_SCHED; PG8_LDA(At, 0, 0); PG8_STAGE(PG8_SA(1, 1), a1 + hstep, voffA);
            PG8_WAIT_V(8); PG8_WAIT_L(0); PG8_BAR; PG8_MMA(0, 0, At, B0); PG8_MMA(0, 1, At, B1); PG8_BAR; PG8_SCHED;
            PG8_LDA(At, 0, 1); PG8_STAGE(PG8_SB(0, 0), b2, voffB); PG8_STAGE(PG8_SB(0, 1), b2 + hstep, voffB); PG8_STAGE(PG8_SA(0, 0), a2, voffA);
            PG8_WAIT_V(8); PG8_WAIT_L(0); PG8_BAR; PG8_MMA(1, 0, At, B0); PG8_MMA(1, 1, At, B1); PG8_BAR; PG8_SCHED;
            PG8_LDB(B0, 1, 0); PG8_LDB(B1, 1, 1); PG8_SCHED; PG8_LDA(At, 1, 0); PG8_STAGE(PG8_SA(0, 1), a2 + hstep, voffA);
            PG8_WAIT_V(8); PG8_WAIT_L(0); PG8_BAR; PG8_MMA(0, 0, At, B0); PG8_MMA(0, 1, At, B1); PG8_BAR; PG8_SCHED;
            PG8_LDA(At, 1, 1); PG8_STAGE(PG8_SB(1, 0), b3, voffB); PG8_STAGE(PG8_SB(1, 1), b3 + hstep, voffB); PG8_STAGE(PG8_SA(1, 0), a3, voffA);
            PG8_WAIT_V(8); PG8_WAIT_L(0); PG8_BAR; PG8_MMA(1, 0, At, B0); PG8_MMA(1, 1, At, B1); PG8_BAR; PG8_SCHED;
            } else {
            PG8_LDB(B0, 0, 0); PG8_SCHED; PG8_LDA(At, 0, 0); PG8_STAGE(PG8_SA(1, 1), a1 + hstep, voffA);
            PG8_WAIT_L(8); PG8_BAR; PG8_WAIT_L(0); PG8_MMA(0, 0, At, B0); PG8_BAR; PG8_SCHED;
            PG8_LDB(B1, 0, 1); PG8_STAGE(PG8_SB(0, 0), b2, voffB);
            PG8_BAR; PG8_WAIT_L(0); PG8_MMA(0, 1, At, B1); PG8_BAR;
            PG8_LDA(At, 0, 1); PG8_STAGE(PG8_SA(0, 0), a2, voffA);
            PG8_BAR; PG8_WAIT_L(0); PG8_MMA(1, 0, At, B0); PG8_BAR; PG8_SCHED;
            PG8_STAGE(PG8_SB(0, 1), b2 + hstep, voffB);
            PG8_WAIT_V(6); PG8_BAR; PG8_MMA(1, 1, At, B1); PG8_BAR;
            PG8_LDB(B0, 1, 0); PG8_SCHED; PG8_LDA(At, 1, 0); PG8_STAGE(PG8_SA(0, 1), a2 + hstep, voffA);
            PG8_WAIT_L(8); PG8_BAR; PG8_WAIT_L(0); PG8_MMA(0, 0, At, B0); PG8_BAR; PG8_SCHED;
            PG8_LDB(B1, 1, 1); PG8_STAGE(PG8_SB(1, 0), b3, voffB);
            PG8_BAR; PG8_WAIT_L(0); PG8_MMA(0, 1, At, B1); PG8_BAR;
            PG8_LDA(At, 1, 1); PG8_STAGE(PG8_SA(1, 0), a3, voffA);
            PG8_BAR; PG8_WAIT_L(0); PG8_MMA(1, 0, At, B0); PG8_BAR; PG8_SCHED;
            PG8_STAGE(PG8_SB(1, 1), b3 + hstep, voffB);
            PG8_WAIT_V(6); PG8_BAR; PG8_MMA(1, 1, At, B1); PG8_BAR;
            }
        }
        if constexpr (ALIGN_EPI) { if (wr == 0) PG8_BAR; }
        if constexpr (!Epi::AFTER_DRAIN) { E(acc, cur, wr, wc, fr, fq); S.done(cur); }
        if (!has_next) break;
#pragma unroll
        for (int a = 0; a < 2; ++a)
#pragma unroll
            for (int b = 0; b < 2; ++b)
#pragma unroll
                for (int m = 0; m < 4; ++m)
#pragma unroll
                    for (int n = 0; n < 2; ++n) acc[a][b][m][n] = (f32x4){0.f, 0.f, 0.f, 0.f};
        cur = nxt; cA = nA; cB = nB; ++ui;
        if constexpr (ALIGN_EPI) { if (wr == 1) PG8_BAR; }
    }
    PG8_WAIT_V(0);
    if constexpr (!ALIGN_EPI) { if (wr == 0) PG8_BAR; }
    PG8_BAR;
    if constexpr (Epi::AFTER_DRAIN) { E.fused(acc, cur, wr, wc, fr, fq, lds, wid, lane); S.done(cur); }
#undef PG8_SA
#undef PG8_SB
#undef PG8_STAGE
#undef PG8_LDA
#undef PG8_LDB
#undef PG8_MMA
#undef PG8_WAIT_V
#undef PG8_WAIT_L
#undef PG8_BAR
#undef PG8_SCHED
}
}

#define GAS __attribute__((address_space(1)))
#define LAS __attribute__((address_space(3)))
#define DI __device__ __forceinline__
typedef unsigned short bf16;
typedef unsigned u32x4 __attribute__((ext_vector_type(4)));
typedef unsigned u32x2 __attribute__((ext_vector_type(2)));
typedef float f32x4 __attribute__((ext_vector_type(4)));
typedef float f32x16 __attribute__((ext_vector_type(16)));
typedef short bf16x8 __attribute__((ext_vector_type(8)));
typedef short s16x4 __attribute__((ext_vector_type(4)));
typedef LAS unsigned char* ldsp;

constexpr int NWAVES = 8, NTHR = 512;
constexpr int T_ = 32768, D_ = 1024, S_ = 2048, NB = 16, DFF = 2816, INW = 11264, NMOD = 6144;
constexpr float EPS_ = 1e-6f;
constexpr size_t MiB = 1u << 20;
constexpr size_t WS_SBQ = 0, WS_SBK = 64 * MiB, WS_SBV = 128 * MiB, WS_RQ = 192 * MiB, WS_RK = 256 * MiB, WS_RV = 320 * MiB;
constexpr size_t WS_WIN = 448 * MiB, WS_WSB = 470 * MiB, WS_WRET = 472 * MiB, WS_WOUT = 476 * MiB, WS_WFFI = 478 * MiB, WS_WFFO = 489 * MiB;
constexpr size_t WS_MODP = 495 * MiB, WS_MODF = 498 * MiB, WS_COS = 499 * MiB, WS_SIN = 500 * MiB, WS_RS = 501 * MiB, WS_END = 512 * MiB;
constexpr size_t WS_GATES = 64 * MiB, WS_M1 = 192 * MiB, WS_MERGED = 256 * MiB, WS_HFFN = 0, WS_H = 64 * MiB;
constexpr int LDS_BYTES = 147456;

DI unsigned pk2(float lo, float hi) { return pg8::cvt_pk_bf16(lo, hi); }
DI float bf2f(unsigned short v) { return __uint_as_float((unsigned)v << 16); }
DI float bflo(unsigned w) { return __uint_as_float(w << 16); }
DI float bfhi(unsigned w) { return __uint_as_float(w & 0xffff0000u); }
DI float wave_sum(float v) {
#pragma unroll
    for (int o = 1; o < 64; o <<= 1) v += __shfl_xor(v, o);
    return v;
}
DI float fsigmoid(float v) { return 1.0f / (1.0f + __expf(-v)); }
DI u32x4 pack8(f32x4 a, f32x4 b) { u32x4 w; w.x = pk2(a[0], a[1]); w.y = pk2(a[2], a[3]); w.z = pk2(b[0], b[1]); w.w = pk2(b[2], b[3]); return w; }
DI void unpack8(u32x4 w, f32x4& a, f32x4& b) { a = (f32x4){bflo(w.x), bfhi(w.x), bflo(w.y), bfhi(w.y)}; b = (f32x4){bflo(w.z), bfhi(w.z), bflo(w.w), bfhi(w.w)}; }

struct Args {
    const float *x, *c, *w_ada, *b_ada, *g1, *w_in, *b_branch, *w_sb, *w_ret, *w_out, *g2, *w_ffi, *w_ffo, *gf;
    float* out; unsigned char* ws;
};

using pg8::Unit;
#define EPI_ARGS const f32x4 (&acc)[2][2][4][2], const Unit& u, int wr, int wc, int fr, int fq
struct EpiInProj {
    static constexpr bool PERM = true, AFTER_DRAIN = false;
    bf16 *sbq, *sbk, *sbv, *rq, *rk, *rv; const float *cosT, *sinT;
    DI void operator()(EPI_ARGS) const {
        const int pn = u.pn, row0 = u.pm * 256 + wr * 64 + fr, cw = wc * 32 + 8 * fq;
        if (pn < 12 || pn >= 20) {
            bf16* base; int ld = 1024, colt;
            if (pn < 4) { base = sbq; colt = pn * 256; } else if (pn < 8) { base = sbk; colt = (pn - 4) * 256; }
            else if (pn < 12) { base = sbv; colt = (pn - 8) * 256; } else { base = rv; ld = 2048; colt = (pn - 20) * 256; }
#pragma unroll
            for (int ai = 0; ai < 2; ++ai)
#pragma unroll
                for (int m = 0; m < 4; ++m) { bf16* rowp = base + (size_t)(row0 + ai * 128 + m * 16) * ld + colt + cw;
#pragma unroll
                    for (int bj = 0; bj < 2; ++bj) *(u32x4*)(rowp + bj * 128) = pack8(acc[ai][bj][m][0], acc[ai][bj][m][1]); }
        } else {
            const bool isk = pn >= 16; const int hh = isk ? pn - 16 : pn - 12; bf16* base = (isk ? rk : rq) + hh * 256 + cw;
            const float lg = __log2f(1.0f - exp2f(-5.0f - (float)hh));
#pragma unroll
            for (int ai = 0; ai < 2; ++ai)
#pragma unroll
                for (int m = 0; m < 4; ++m) {
                    const int row = row0 + ai * 128 + m * 16, pos = row & 2047, c = row & 127;
                    const float f = isk ? exp2f(-(float)c * lg) * 0.0625f : exp2f((float)c * lg);
                    const float* cp = cosT + pos * 128 + cw; const float* sp = sinT + pos * 128 + cw;
                    bf16* rowp = base + (size_t)row * 1024;
#pragma unroll
                    for (int n = 0; n < 2; ++n) {
                        const f32x4 cs = *(const f32x4*)(cp + 4 * n), sn = *(const f32x4*)(sp + 4 * n);
                        const f32x4 v1 = acc[ai][0][m][n], v2 = acc[ai][1][m][n];
                        const f32x4 o1 = (v1 * cs - v2 * sn) * f, o2 = (v1 * sn + v2 * cs) * f;
                        u32x2 w1, w2; w1.x = pk2(o1[0], o1[1]); w1.y = pk2(o1[2], o1[3]); w2.x = pk2(o2[0], o2[1]); w2.y = pk2(o2[2], o2[3]);
                        *(u32x2*)(rowp + 4 * n) = w1; *(u32x2*)(rowp + 128 + 4 * n) = w2;
                    }
                }
        }
    }
};
struct EpiGates {
    static constexpr bool PERM = true, AFTER_DRAIN = false;
    bf16 *rv, *gates; const float *rs, *bb;
    DI void operator()(EPI_ARGS) const {
        const int pn = u.pn, row0 = u.pm * 256 + wr * 64 + fr, cw = wc * 32 + 8 * fq;
        if (pn < 8) {
            const int head = pn >> 1;
#pragma unroll
            for (int ai = 0; ai < 2; ++ai)
#pragma unroll
                for (int m = 0; m < 4; ++m) {
                    const int row = row0 + ai * 128 + m * 16;
                    const f32x4 q = *(const f32x4*)(rs + (size_t)row * 16 + head * 4);
                    const float rsv = rsqrtf(((q[0] + q[1]) + (q[2] + q[3])) * (1.0f / 512.0f) + EPS_);
#pragma unroll
                    for (int bj = 0; bj < 2; ++bj) {
                        bf16* p = rv + (size_t)row * 2048 + pn * 256 + bj * 128 + cw;
                        f32x4 oa, ob; unpack8(*(const u32x4*)p, oa, ob);
                        f32x4 ga = acc[ai][bj][m][0], gb = acc[ai][bj][m][1];
#pragma unroll
                        for (int e = 0; e < 4; ++e) { ga[e] = ga[e] * fsigmoid(ga[e]) * oa[e] * rsv; gb[e] = gb[e] * fsigmoid(gb[e]) * ob[e] * rsv; }
                        *(u32x4*)p = pack8(ga, gb);
                    }
                }
        } else {
#pragma unroll
            for (int bj = 0; bj < 2; ++bj) {
                const int col = (pn - 8) * 256 + bj * 128 + cw;
                const f32x4 b0 = *(const f32x4*)(bb + col), b1 = *(const f32x4*)(bb + col + 4);
#pragma unroll
                for (int ai = 0; ai < 2; ++ai)
#pragma unroll
                    for (int m = 0; m < 4; ++m) {
                        const int row = row0 + ai * 128 + m * 16;
                        f32x4 ga = acc[ai][bj][m][0] + b0, gb = acc[ai][bj][m][1] + b1;
#pragma unroll
                        for (int e = 0; e < 4; ++e) { ga[e] = fsigmoid(ga[e]); gb[e] = fsigmoid(gb[e]); }
                        *(u32x4*)(gates + (size_t)row * 2048 + col) = pack8(ga, gb);
                    }
            }
        }
    }
};
template <int MODE> struct EpiMerge {
    static constexpr bool PERM = true, AFTER_DRAIN = false;
    const bf16* gates; const bf16* m1; bf16* outp;
    DI void operator()(EPI_ARGS) const {
        const int row0 = u.pm * 256 + wr * 64 + fr, cw = wc * 32 + 8 * fq;
#pragma unroll
        for (int ai = 0; ai < 2; ++ai)
#pragma unroll
            for (int m = 0; m < 4; ++m) {
                const int row = row0 + ai * 128 + m * 16;
#pragma unroll
                for (int bj = 0; bj < 2; ++bj) {
                    const int col = u.pn * 256 + bj * 128 + cw;
                    f32x4 ga, gb; unpack8(*(const u32x4*)(gates + (size_t)row * 2048 + MODE * 1024 + col), ga, gb);
                    f32x4 ra = ga * acc[ai][bj][m][0], rb = gb * acc[ai][bj][m][1];
                    if (MODE == 1) { f32x4 pa, pb; unpack8(*(const u32x4*)(m1 + (size_t)row * 1024 + col), pa, pb); ra += pa; rb += pb; }
                    *(u32x4*)(outp + (size_t)row * 1024 + col) = pack8(ra, rb);
                }
            }
    }
};
struct EpiResid {
    static constexpr bool PERM = true, AFTER_DRAIN = false;
    const float* base; float* outp; const float* gate;
    DI void operator()(EPI_ARGS) const {
        const int row0 = u.pm * 256 + wr * 64 + fr, cw = wc * 32 + 8 * fq, b = u.pm >> 3;
#pragma unroll
        for (int bj = 0; bj < 2; ++bj) {
            const int col = u.pn * 256 + bj * 128 + cw;
            const f32x4 g0 = *(const f32x4*)(gate + b * NMOD + col), g1v = *(const f32x4*)(gate + b * NMOD + col + 4);
#pragma unroll
            for (int ai = 0; ai < 2; ++ai)
#pragma unroll
                for (int m = 0; m < 4; ++m) {
                    const size_t off = (size_t)(row0 + ai * 128 + m * 16) * 1024 + col;
                    const f32x4 x0 = *(const f32x4*)(base + off), x1 = *(const f32x4*)(base + off + 4);
                    *(f32x4*)(outp + off) = x0 + g0 * acc[ai][bj][m][0]; *(f32x4*)(outp + off + 4) = x1 + g1v * acc[ai][bj][m][1];
                }
        }
    }
};
struct EpiSwiglu {
    static constexpr bool PERM = true, AFTER_DRAIN = false;
    bf16* H;
    DI void operator()(EPI_ARGS) const {
        const int row0 = u.pm * 256 + wr * 64 + fr, cw = wc * 32 + 8 * fq;
#pragma unroll
        for (int ai = 0; ai < 2; ++ai)
#pragma unroll
            for (int m = 0; m < 4; ++m) {
                f32x4 a0 = acc[ai][0][m][0], a1 = acc[ai][0][m][1]; const f32x4 u0 = acc[ai][1][m][0], u1 = acc[ai][1][m][1];
#pragma unroll
                for (int e = 0; e < 4; ++e) { a0[e] = a0[e] * fsigmoid(a0[e]) * u0[e]; a1[e] = a1[e] * fsigmoid(a1[e]) * u1[e]; }
                *(u32x4*)(H + (size_t)(row0 + ai * 128 + m * 16) * DFF + u.pn * 128 + cw) = pack8(a0, a1);
            }
    }
};

DI int ffi_row(int n) { return n < DFF ? 256 * (n >> 7) + (n & 127) : 256 * ((n - DFF) >> 7) + 128 + ((n - DFF) & 127); }
DI void transpose_item(const float* W, int K, int N, bf16* WT, int mode, LAS float* scr, int item, int lane) {
    const int nblk = N / 32, kb = item / nblk, nb = item % nblk, k0 = 64 * kb, n0 = 32 * nb;
    const int d0 = mode ? ffi_row(n0) : n0;
#pragma unroll 8
    for (int i = 0; i < 32; ++i) { const int kk = 2 * i + (lane >> 5); scr[kk * 33 + (lane & 31)] = W[(size_t)(k0 + kk) * N + n0 + (lane & 31)]; }
    asm volatile("s_waitcnt lgkmcnt(0)" ::: "memory");
    const int c = lane & 7;
#pragma unroll
    for (int j = 0; j < 4; ++j) { const int n = (lane >> 3) + 8 * j; const LAS float* s = scr + (8 * c) * 33 + n;
        u32x4 o; o.x = pk2(s[0 * 33], s[1 * 33]); o.y = pk2(s[2 * 33], s[3 * 33]); o.z = pk2(s[4 * 33], s[5 * 33]); o.w = pk2(s[6 * 33], s[7 * 33]);
        *(u32x4*)(WT + (size_t)(d0 + n) * K + k0 + 8 * c) = o; }
    asm volatile("s_waitcnt lgkmcnt(0)" ::: "memory");
}
DI void p0_prologue(const Args& A, ldsp lds, int G) {
    const int tid = threadIdx.x, lane = tid & 63, wave = tid >> 6;
    LAS float* scr = (LAS float*)(lds + wave * 16384);
    const int gw = blockIdx.x * NWAVES + wave, NGW = G * NWAVES;
    unsigned char* ws = A.ws;
    constexpr int I_IN = (D_ / 64) * (INW / 32), I_SB = 16 * 32, I_RET = 32 * 32, I_OUT = 16 * 32, I_FFI = 16 * (2 * DFF / 32), I_FFO = (DFF / 64) * 32;
    constexpr int I_MOD = 96 * 8, I_ROPE = 2048 * 128 / 64;
    constexpr int NIT = I_IN + I_SB + I_RET + I_OUT + I_FFI + I_FFO + I_MOD + I_ROPE;
    for (int it = gw; it < NIT; it += NGW) {
        int r = it;
        if (r < I_IN) { transpose_item(A.w_in, D_, INW, (bf16*)(ws + WS_WIN), 0, scr, r, lane); continue; } r -= I_IN;
        if (r < I_SB) { transpose_item(A.w_sb, 1024, 1024, (bf16*)(ws + WS_WSB), 0, scr, r, lane); continue; } r -= I_SB;
        if (r < I_RET) { transpose_item(A.w_ret, 2048, 1024, (bf16*)(ws + WS_WRET), 0, scr, r, lane); continue; } r -= I_RET;
        if (r < I_OUT) { transpose_item(A.w_out, 1024, 1024, (bf16*)(ws + WS_WOUT), 0, scr, r, lane); continue; } r -= I_OUT;
        if (r < I_FFI) { transpose_item(A.w_ffi, 1024, 2 * DFF, (bf16*)(ws + WS_WFFI), 1, scr, r, lane); continue; } r -= I_FFI;
        if (r < I_FFO) { transpose_item(A.w_ffo, DFF, 1024, (bf16*)(ws + WS_WFFO), 0, scr, r, lane); continue; } r -= I_FFO;
        if (r < I_MOD) {
            const int eb = r % 96, ks = r / 96, d0 = ks * 128, e = eb * 64 + lane;
#pragma unroll 4
            for (int i = 0; i < 32; ++i) { const int idx = i * 64 + lane, b = idx >> 7, dd = idx & 127; const float cv = A.c[b * 1024 + d0 + dd]; scr[idx] = cv * fsigmoid(cv); }
            asm volatile("s_waitcnt lgkmcnt(0)" ::: "memory");
            float a[16];
#pragma unroll
            for (int b = 0; b < 16; ++b) a[b] = 0.f;
            for (int dd = 0; dd < 128; ++dd) { const float w = A.w_ada[(size_t)(d0 + dd) * NMOD + e];
#pragma unroll
                for (int b = 0; b < 16; ++b) a[b] += scr[b * 128 + dd] * w; }
            float* mp = (float*)(ws + WS_MODP) + (size_t)ks * NB * NMOD + e;
#pragma unroll
            for (int b = 0; b < 16; ++b) mp[b * NMOD] = a[b];
            asm volatile("s_waitcnt lgkmcnt(0)" ::: "memory");
            continue;
        } r -= I_MOD;
        {
            const int idx = r * 64 + lane, pos = idx >> 7, j = idx & 127;
            const float inv = exp2f(-(float)j * (13.287712379549449f / 128.0f));
            const float ang = (float)pos * inv;
            const float n = rintf(ang * 0.15915494309189535f);
            float rr = __builtin_fmaf(-n, 6.28125f, ang); rr = __builtin_fmaf(-n, 0.0019353071795864769f, rr);
            ((float*)(ws + WS_COS))[idx] = cosf(rr); ((float*)(ws + WS_SIN))[idx] = sinf(rr);
        }
    }
}
template <bool FIRST> DI void norm_mod_phase(const Args& A, ldsp lds, int G, const float* src, const float* gw_, bf16* dst, int shift_off) {
    const int tid = threadIdx.x, lane = tid & 63, wave = tid >> 6;
    LAS float* modl = (LAS float*)lds;
    const float* modp = (const float*)(A.ws + WS_MODP); float* modf = (float*)(A.ws + WS_MODF);
    for (int rb = blockIdx.x; rb < 256; rb += G) {
        const int b = rb >> 4;
        __syncthreads();
        for (int i = tid; i < 2048; i += NTHR) {
            float v;
            if (FIRST) { const int e = i; v = A.b_ada[e]; for (int ks = 0; ks < 8; ++ks) v += modp[(size_t)ks * NB * NMOD + b * NMOD + e]; }
            else v = modf[b * NMOD + shift_off + i];
            modl[i] = v;
        }
        if (FIRST && tid < 384) { const int idx = rb * 384 + tid, e = idx % NMOD; float v = A.b_ada[e]; for (int ks = 0; ks < 8; ++ks) v += modp[(size_t)ks * NB * NMOD + idx]; modf[idx] = v; }
        __syncthreads();
        for (int rr = 0; rr < 16; ++rr) {
            const int row = rb * 128 + wave * 16 + rr;
            const f32x4* xr = (const f32x4*)(src + (size_t)row * 1024) + lane;
            f32x4 v[4]; float s = 0.f;
#pragma unroll
            for (int j = 0; j < 4; ++j) { v[j] = xr[64 * j]; s += (v[j][0] * v[j][0] + v[j][1] * v[j][1]) + (v[j][2] * v[j][2] + v[j][3] * v[j][3]); }
            const float rstd = rsqrtf(wave_sum(s) * (1.0f / 1024.0f) + EPS_);
            unsigned long long* o8 = (unsigned long long*)(dst + (size_t)row * 1024) + lane;
#pragma unroll
            for (int j = 0; j < 4; ++j) {
                const int col = 4 * lane + 256 * j;
                const f32x4 g = *(const f32x4*)(gw_ + col); const f32x4 sh = *(const LAS f32x4*)(modl + col), sc = *(const LAS f32x4*)(modl + 1024 + col);
                const f32x4 y = v[j] * rstd * g * (sc + 1.0f) + sh;
                o8[64 * j] = (unsigned long long)pk2(y[0], y[1]) | ((unsigned long long)pk2(y[2], y[3]) << 32);
            }
        }
    }
    __syncthreads();
}
DI void final_norm_phase(const Args& A, int G) {
    const int tid = threadIdx.x, lane = tid & 63, wave = tid >> 6;
    const int gw = blockIdx.x * NWAVES + wave, NGW = G * NWAVES;
    for (int row = gw; row < T_; row += NGW) {
        f32x4* xr = (f32x4*)(A.out + (size_t)row * 1024) + lane;
        f32x4 v[4]; float s = 0.f;
#pragma unroll
        for (int j = 0; j < 4; ++j) { v[j] = xr[64 * j]; s += (v[j][0] * v[j][0] + v[j][1] * v[j][1]) + (v[j][2] * v[j][2] + v[j][3] * v[j][3]); }
        const float rstd = rsqrtf(wave_sum(s) * (1.0f / 1024.0f) + EPS_);
#pragma unroll
        for (int j = 0; j < 4; ++j) { const f32x4 g = *(const f32x4*)(A.gf + 4 * lane + 256 * j); xr[64 * j] = v[j] * rstd * g; }
    }
}

typedef short v4i16_t __attribute__((ext_vector_type(4)));
DI s16x4 tr_read(const LAS unsigned char* p) { return __builtin_bit_cast(s16x4, __builtin_amdgcn_ds_read_tr16_b64_v4i16((LAS v4i16_t*)p)); }
#define MFMA32(a, b, c) __builtin_amdgcn_mfma_f32_32x32x16_bf16((a), (b), (c), 0, 0, 0)
#define MFMA16(a, b, c) __builtin_amdgcn_mfma_f32_16x16x32_bf16((a), (b), (c), 0, 0, 0)
DI int crow(int r, int hi) { return (r & 3) + 8 * (r >> 2) + 4 * hi; }
DI bf16x8 pack_step(const f32x16& x, int s) {
    u32x4 p; p.x = pk2(x[8 * s], x[8 * s + 1]); p.y = pk2(x[8 * s + 2], x[8 * s + 3]); p.z = pk2(x[8 * s + 4], x[8 * s + 5]); p.w = pk2(x[8 * s + 6], x[8 * s + 7]);
    return __builtin_bit_cast(bf16x8, p);
}
constexpr int SB_PK = 144, SB_PV = 192;
constexpr int SB_KBYTES = 64 * SB_PK, SB_VBYTES = 64 * SB_PV, SB_BUF = SB_KBYTES + SB_VBYTES;
DI void sb_attn_unit(ldsp lds, const bf16* Q, const bf16* K, const bf16* V, bf16* O, int b, int h, int qb) {
    const int tid = threadIdx.x, lane = tid & 63, wave = __builtin_amdgcn_readfirstlane(tid >> 6), r32 = lane & 31, hi = lane >> 5;
    const int t0 = qb * 256 + wave * 32, tq = t0 + r32;
    const size_t rowbase = (size_t)b * S_;
    bf16x8 qf[4];
#pragma unroll
    for (int ks = 0; ks < 4; ++ks) qf[ks] = *(const bf16x8*)(Q + (rowbase + tq) * 1024 + h * 64 + 16 * ks + 8 * hi);
    bf16x8 U0, U1, ONES;
#pragma unroll
    for (int jj = 0; jj < 8; ++jj) { const int k0 = 8 * (jj >> 2) + 4 * hi + (jj & 3); U0[jj] = (k0 >= r32) ? (short)0x3F80 : (short)0; U1[jj] = (16 + k0 >= r32) ? (short)0x3F80 : (short)0; ONES[jj] = (short)0x3F80; }
    f32x16 o0, o1;
#pragma unroll
    for (int i = 0; i < 16; ++i) { o0[i] = 0.f; o1[i] = 0.f; }
    float R2 = 0.f;
    const int ntiles = qb * 4 + 4;
    const int srow = tid >> 3, schunk = tid & 7;
    const bf16* kg = K + (rowbase + srow) * 1024 + h * 64 + schunk * 8; const bf16* vg = V + (rowbase + srow) * 1024 + h * 64 + schunk * 8;
    const int kso = srow * SB_PK + schunk * 16, vso = SB_KBYTES + srow * SB_PV + schunk * 16;
    __syncthreads();
    { const int jt = ntiles - 1; const u32x4 kr = *(const u32x4*)(kg + (size_t)jt * 64 * 1024), vr = *(const u32x4*)(vg + (size_t)jt * 64 * 1024);
      *(LAS u32x4*)(lds + kso) = kr; *(LAS u32x4*)(lds + vso) = vr; }
    __syncthreads();
    const float C2 = 0.125f * 1.4426950408889634f;
    const int i16 = lane & 15, blk = (lane >> 4) & 1, qq = i16 >> 2, pp = i16 & 3;
    for (int jt = ntiles - 1; jt >= 0; --jt) {
        const int cur = (ntiles - 1 - jt) & 1;
        u32x4 kr, vr;
        if (jt > 0) { kr = *(const u32x4*)(kg + (size_t)(jt - 1) * 64 * 1024); vr = *(const u32x4*)(vg + (size_t)(jt - 1) * 64 * 1024); }
        if (64 * jt < t0 + 31) {
            const LAS unsigned char* Kb = lds + cur * SB_BUF; const LAS unsigned char* Vb = Kb + SB_KBYTES;
            const bool diag = (64 * jt + 63 >= t0);
            f32x16 z[2];
#pragma unroll
            for (int rb = 0; rb < 2; ++rb) {
#pragma unroll
                for (int i = 0; i < 16; ++i) z[rb][i] = 0.f;
#pragma unroll
                for (int ks = 0; ks < 4; ++ks) { const bf16x8 a = *(const LAS bf16x8*)(Kb + (32 * rb + r32) * SB_PK + (16 * ks + 8 * hi) * 2); z[rb] = MFMA32(a, qf[ks], z[rb]); }
            }
            float lsum = 0.f; f32x16 L[2];
#pragma unroll
            for (int rb = 0; rb < 2; ++rb)
#pragma unroll
                for (int i = 0; i < 16; ++i) {
                    const float z2 = z[rb][i] * C2;
                    const float e = __builtin_amdgcn_exp2f(-__builtin_fabsf(z2));
                    float l = -(__builtin_fmaxf(z2, 0.f) + __builtin_amdgcn_logf(1.0f + e));
                    if (diag) { const int s = 64 * jt + 32 * rb + crow(i, hi); if (!(s < tq)) l = 0.f; }
                    L[rb][i] = l; lsum += l; z[rb][i] = z2 + R2;
                }
            bf16x8 Lp[4];
#pragma unroll
            for (int q = 0; q < 4; ++q) Lp[q] = pack_step(L[q >> 1], q & 1);
            f32x16 la0 = MFMA32(U0, Lp[0], z[0]); la0 = MFMA32(U1, Lp[1], la0); la0 = MFMA32(ONES, Lp[2], la0); la0 = MFMA32(ONES, Lp[3], la0);
            f32x16 la1 = MFMA32(U0, Lp[2], z[1]); la1 = MFMA32(U1, Lp[3], la1);
#pragma unroll
            for (int i = 0; i < 16; ++i) {
                float a0 = __builtin_amdgcn_exp2f(la0[i]), a1 = __builtin_amdgcn_exp2f(la1[i]);
                if (diag) { const int s = 64 * jt + crow(i, hi); if (!(s < tq)) a0 = 0.f; if (!(s + 32 < tq)) a1 = 0.f; }
                la0[i] = a0; la1[i] = a1;
            }
            bf16x8 Ap[4]; Ap[0] = pack_step(la0, 0); Ap[1] = pack_step(la0, 1); Ap[2] = pack_step(la1, 0); Ap[3] = pack_step(la1, 1);
#pragma unroll
            for (int q = 0; q < 4; ++q) {
                const int key0 = 16 * q + 4 * hi;
#pragma unroll
                for (int db = 0; db < 2; ++db) {
                    const LAS unsigned char* ap = Vb + (key0 + qq) * SB_PV + (32 * db + 16 * blk + 4 * pp) * 2;
                    const s16x4 lo = tr_read(ap), hi4 = tr_read(ap + 8 * SB_PV);
                    const bf16x8 va = __builtin_shufflevector(lo, hi4, 0, 1, 2, 3, 4, 5, 6, 7);
                    if (db == 0) o0 = MFMA32(va, Ap[q], o0); else o1 = MFMA32(va, Ap[q], o1);
                }
            }
            R2 += lsum + __shfl_xor(lsum, 32);
        }
        if (jt > 0) { *(LAS u32x4*)(lds + (cur ^ 1) * SB_BUF + kso) = kr; *(LAS u32x4*)(lds + (cur ^ 1) * SB_BUF + vso) = vr; }
        __syncthreads();
    }
    bf16* op = O + (rowbase + tq) * 1024 + h * 64 + 4 * hi;
#pragma unroll
    for (int g = 0; g < 4; ++g) {
        u32x2 w0, w1; w0.x = pk2(o0[4 * g], o0[4 * g + 1]); w0.y = pk2(o0[4 * g + 2], o0[4 * g + 3]); w1.x = pk2(o1[4 * g], o1[4 * g + 1]); w1.y = pk2(o1[4 * g + 2], o1[4 * g + 3]);
        *(u32x2*)(op + 8 * g) = w0; *(u32x2*)(op + 32 + 8 * g) = w1;
    }
}

constexpr int RT_P = 272;
constexpr int RT_TILE = 128 * RT_P, RT_Q = 0, RT_K = RT_TILE, RT_V = 2 * RT_TILE, RT_PS = 3 * RT_TILE, RT_SS = 4 * RT_TILE;
#define RT_STAGE(dh_, withv_) do { \
    const int row_ = tid >> 4, chunk_ = tid & 15; \
    const bf16* qg_ = RQ + (rowbase + c0 + row_) * 1024 + hh * 256 + (dh_) * 128 + chunk_ * 8; \
    const bf16* kg_ = RK + (rowbase + c0 + row_) * 1024 + hh * 256 + (dh_) * 128 + chunk_ * 8; \
    const ldsp lq_ = lds + row_ * RT_P + chunk_ * 16; \
    _Pragma("unroll") for (int i_ = 0; i_ < 4; ++i_) *(LAS u32x4*)(lq_ + RT_Q + i_ * 32 * RT_P) = *(const u32x4*)(qg_ + (size_t)i_ * 32 * 1024); \
    __builtin_amdgcn_sched_barrier(0); \
    _Pragma("unroll") for (int i_ = 0; i_ < 4; ++i_) *(LAS u32x4*)(lq_ + RT_K + i_ * 32 * RT_P) = *(const u32x4*)(kg_ + (size_t)i_ * 32 * 1024); \
    __builtin_amdgcn_sched_barrier(0); \
    if (withv_) { const bf16* vg_ = RV + (rowbase + c0 + row_) * 2048 + hh * 512 + es * 128 + chunk_ * 8; \
        _Pragma("unroll") for (int i_ = 0; i_ < 4; ++i_) *(LAS u32x4*)(lq_ + RT_V + i_ * 32 * RT_P) = *(const u32x4*)(vg_ + (size_t)i_ * 32 * 2048); } \
    __builtin_amdgcn_sched_barrier(0); } while (0)
DI void retention_unit(ldsp lds, const bf16* RQ, const bf16* RK, bf16* RV, float* RS, int b, int hh, int es) {
    const int tid = threadIdx.x, lane = tid & 63, w = __builtin_amdgcn_readfirstlane(tid >> 6), i16 = lane & 15, g = lane >> 4, qq = i16 >> 2, pp = i16 & 3;
    const size_t rowbase = (size_t)b * S_;
    const float g128 = exp2f(128.0f * __log2f(1.0f - exp2f(-5.0f - (float)hh)));
    f32x4 Tst[16];
#pragma unroll
    for (int i = 0; i < 16; ++i) Tst[i] = (f32x4){0.f, 0.f, 0.f, 0.f};
    for (int ch = 0; ch < 16; ++ch) {
        const int c0 = ch * 128;
        {
            f32x4 sc[8];
#pragma unroll
            for (int i = 0; i < 8; ++i) sc[i] = (f32x4){0.f, 0.f, 0.f, 0.f};
#pragma unroll
            for (int dh = 0; dh < 2; ++dh) {
                __syncthreads();
                RT_STAGE(dh, false);
                __syncthreads();
#pragma unroll
                for (int kb = 0; kb < 4; ++kb) {
                    const bf16x8 bq = *(const LAS bf16x8*)(lds + RT_Q + (16 * w + i16) * RT_P + (32 * kb + 8 * g) * 2);
#pragma unroll
                    for (int mb = 0; mb < 8; ++mb) { const bf16x8 ak = *(const LAS bf16x8*)(lds + RT_K + (16 * mb + i16) * RT_P + (32 * kb + 8 * g) * 2); sc[mb] = MFMA16(ak, bq, sc[mb]); }
                    __builtin_amdgcn_sched_barrier(0);
                }
            }
            const int c = 16 * w + i16;
#pragma unroll
            for (int mb = 0; mb < 8; ++mb) {
                const int m0 = 16 * mb + 4 * g;
                const float v0 = (m0 <= c) ? sc[mb][0] : 0.f, v1 = (m0 + 1 <= c) ? sc[mb][1] : 0.f, v2 = (m0 + 2 <= c) ? sc[mb][2] : 0.f, v3 = (m0 + 3 <= c) ? sc[mb][3] : 0.f;
                u32x2 pw; pw.x = pk2(v0, v1); pw.y = pk2(v2, v3);
                *(LAS u32x2*)(lds + RT_PS + c * RT_P + m0 * 2) = pw;
            }
        }
        __builtin_amdgcn_sched_barrier(0);
        f32x4 cr[8]; bf16x8 vf[4];
#pragma unroll
        for (int i = 0; i < 8; ++i) cr[i] = (f32x4){0.f, 0.f, 0.f, 0.f};
#pragma unroll
        for (int dh = 0; dh < 2; ++dh) {
            __syncthreads();
            RT_STAGE(dh, dh == 0);
            __syncthreads();
            if (dh == 0) {
#pragma unroll
                for (int cbk = 0; cbk < 4; ++cbk) {
                    const LAS unsigned char* ap = lds + RT_V + (32 * cbk + 8 * g + qq) * RT_P + (16 * w + 4 * pp) * 2;
                    const s16x4 lo = tr_read(ap), hi4 = tr_read(ap + 4 * RT_P);
                    vf[cbk] = __builtin_shufflevector(lo, hi4, 0, 1, 2, 3, 4, 5, 6, 7);
                }
            }
#pragma unroll
            for (int kb = 0; kb < 4; ++kb) {
                const int kbg = 4 * dh + kb;
                u32x4 tp; tp.x = pk2(Tst[2 * kbg][0], Tst[2 * kbg][1]); tp.y = pk2(Tst[2 * kbg][2], Tst[2 * kbg][3]); tp.z = pk2(Tst[2 * kbg + 1][0], Tst[2 * kbg + 1][1]); tp.w = pk2(Tst[2 * kbg + 1][2], Tst[2 * kbg + 1][3]);
                const bf16x8 tb = __builtin_bit_cast(bf16x8, tp);
#pragma unroll
                for (int cb = 0; cb < 8; ++cb) {
                    const LAS unsigned char* qp = lds + RT_Q + (16 * cb + i16) * RT_P + (32 * kb + 4 * g) * 2;
                    const s16x4 lo = *(const LAS s16x4*)qp, hi4 = *(const LAS s16x4*)(qp + 32);
                    const bf16x8 aq = __builtin_shufflevector(lo, hi4, 0, 1, 2, 3, 4, 5, 6, 7);
                    cr[cb] = MFMA16(aq, tb, cr[cb]);
                }
                __builtin_amdgcn_sched_barrier(0);
            }
#pragma unroll
            for (int dtl = 0; dtl < 8; ++dtl) {
                const int dt = 8 * dh + dtl;
                Tst[dt] = Tst[dt] * g128;
#pragma unroll
                for (int cbk = 0; cbk < 4; ++cbk) {
                    const LAS unsigned char* ap = lds + RT_K + (32 * cbk + 8 * g + qq) * RT_P + (16 * dtl + 4 * pp) * 2;
                    const s16x4 lo = tr_read(ap), hi4 = tr_read(ap + 4 * RT_P);
                    const bf16x8 ak = __builtin_shufflevector(lo, hi4, 0, 1, 2, 3, 4, 5, 6, 7);
                    Tst[dt] = MFMA16(ak, vf[cbk], Tst[dt]);
                }
                __builtin_amdgcn_sched_barrier(0);
            }
        }
#pragma unroll
        for (int cb = 0; cb < 8; ++cb) cr[cb] = cr[cb] * g128;
#pragma unroll
        for (int cb = 0; cb < 8; ++cb)
#pragma unroll
            for (int mbk = 0; mbk < 4; ++mbk) if (32 * mbk <= 16 * cb + 15) {
                const bf16x8 ap = *(const LAS bf16x8*)(lds + RT_PS + (16 * cb + i16) * RT_P + (32 * mbk + 8 * g) * 2);
                cr[cb] = MFMA16(ap, vf[mbk], cr[cb]);
            }
        LAS float* ssq = (LAS float*)(lds + RT_SS);
#pragma unroll
        for (int cb = 0; cb < 8; ++cb)
#pragma unroll
            for (int j = 0; j < 4; ++j) {
                const int c = 16 * cb + 4 * g + j;
                const unsigned short ob = (unsigned short)(pk2(cr[cb][j], 0.f) & 0xffffu);
                RV[(rowbase + c0 + c) * 2048 + hh * 512 + es * 128 + 16 * w + i16] = ob;
                const float of = bf2f(ob); float s = of * of;
                s += __shfl_xor(s, 1); s += __shfl_xor(s, 2); s += __shfl_xor(s, 4); s += __shfl_xor(s, 8);
                if (i16 == 0) ssq[w * 128 + c] = s;
            }
        __syncthreads();
        if (tid < 128) { float s = 0.f;
#pragma unroll
            for (int ww = 0; ww < 8; ++ww) s += ssq[ww * 128 + tid];
            RS[(rowbase + c0 + tid) * 16 + hh * 4 + es] = s; }
    }
    __syncthreads();
}

#define GEMM_PHASE(EpiT, E, Aptr, Bptr, N_, K_) do { pg8::Gemm g_{(const pg8::bf16_t*)(Aptr), (const pg8::bf16_t*)(Bptr), T_, (N_), (K_)}; pg8::StaticOrder S_o; S_o.init(T_, (N_), G, (int)blockIdx.x); \
    pg8::gemm_phase<EpiT, pg8::StaticOrder, true, true>(lds, g_, S_o, (E)); } while (0)
#ifndef PH_LO
#define PH_LO 0
#endif
#ifndef PH_HI
#define PH_HI 99
#endif
__global__ void __launch_bounds__(NTHR, 2) fwd_megakernel(Args A) {
    extern __shared__ __attribute__((aligned(16))) unsigned char lds_raw[];
    ldsp lds = (ldsp)lds_raw;
    cg::grid_group grid = cg::this_grid();
    const int G = gridDim.x;
    unsigned char* ws = A.ws;
    bf16* hmix = (bf16*)A.out;
#ifndef PHM
#define PHM 0xFFFF
#endif
    if (PHM & 1) p0_prologue(A, lds, G);
    grid.sync();
    if (PHM & 2) norm_mod_phase<true>(A, lds, G, A.x, A.g1, hmix, 0);
    grid.sync();
    if (PHM & 4) { EpiInProj E{(bf16*)(ws + WS_SBQ), (bf16*)(ws + WS_SBK), (bf16*)(ws + WS_SBV), (bf16*)(ws + WS_RQ), (bf16*)(ws + WS_RK), (bf16*)(ws + WS_RV), (const float*)(ws + WS_COS), (const float*)(ws + WS_SIN)};
      GEMM_PHASE(EpiInProj, E, hmix, ws + WS_WIN, 7168, 1024); }
    grid.sync();
    if (PHM & 8) for (int u = blockIdx.x; u < 256; u += G) retention_unit(lds, (const bf16*)(ws + WS_RQ), (const bf16*)(ws + WS_RK), (bf16*)(ws + WS_RV), (float*)(ws + WS_RS), u >> 4, (u >> 2) & 3, u & 3);
    if (PHM & 16) for (int u = blockIdx.x; u < 256; u += G)
        for (int k = 0; k < 4; ++k) {
            sb_attn_unit(lds, (const bf16*)(ws + WS_SBQ), (const bf16*)(ws + WS_SBK), (const bf16*)(ws + WS_SBV), (bf16*)(ws + WS_SBQ), u >> 4, u & 15, 7 - k);
            sb_attn_unit(lds, (const bf16*)(ws + WS_SBQ), (const bf16*)(ws + WS_SBK), (const bf16*)(ws + WS_SBV), (bf16*)(ws + WS_SBQ), u >> 4, u & 15, k);
        }
    grid.sync();
    if (PHM & 32) { EpiGates E{(bf16*)(ws + WS_RV), (bf16*)(ws + WS_GATES), (const float*)(ws + WS_RS), A.b_branch};
      GEMM_PHASE(EpiGates, E, hmix, ws + WS_WIN + (size_t)7168 * 1024 * 2, 4096, 1024); }
    grid.sync();
    if (PHM & 64) { EpiMerge<0> E{(const bf16*)(ws + WS_GATES), nullptr, (bf16*)(ws + WS_M1)};
      GEMM_PHASE(EpiMerge<0>, E, ws + WS_SBQ, ws + WS_WSB, 1024, 1024); }
    grid.sync();
    if (PHM & 128) { EpiMerge<1> E{(const bf16*)(ws + WS_GATES), (const bf16*)(ws + WS_M1), (bf16*)(ws + WS_MERGED)};
      GEMM_PHASE(EpiMerge<1>, E, ws + WS_RV, ws + WS_WRET, 1024, 2048); }
    grid.sync();
    if (PHM & 256) { EpiResid E{A.x, A.out, (const float*)(ws + WS_MODF) + 2048};
      GEMM_PHASE(EpiResid, E, ws + WS_MERGED, ws + WS_WOUT, 1024, 1024); }
    grid.sync();
    if (PHM & 512) norm_mod_phase<false>(A, lds, G, A.out, A.g2, (bf16*)(ws + WS_HFFN), 3072);
    grid.sync();
    if (PHM & 1024) { EpiSwiglu E{(bf16*)(ws + WS_H)};
      GEMM_PHASE(EpiSwiglu, E, ws + WS_HFFN, ws + WS_WFFI, 2 * DFF, 1024); }
    grid.sync();
    if (PHM & 2048) { EpiResid E{A.out, A.out, (const float*)(ws + WS_MODF) + 5120};
      GEMM_PHASE(EpiResid, E, ws + WS_H, ws + WS_WFFO, 1024, DFF); }
    grid.sync();
    if (PHM & 4096) final_norm_phase(A, G);
}

extern "C" void kernel_launch(void* const* d_in, const int* in_sizes, int n_in, void* d_out, int out_size, void* d_ws, size_t ws_size, hipStream_t stream) {
    static int grid = 0;
    if (grid == 0) {
        if (n_in != 14 || in_sizes[0] != T_ * D_ || out_size != T_ * D_ || ws_size < WS_END) { fprintf(stderr, "kernel_launch: unexpected shapes / ws %zu\n", ws_size); grid = -1; return; }
        int dev = 0, cus = 0, per_cu = 0;
        hipGetDevice(&dev); hipDeviceGetAttribute(&cus, hipDeviceAttributeMultiprocessorCount, dev);
        if (hipFuncSetAttribute((const void*)fwd_megakernel, hipFuncAttributeMaxDynamicSharedMemorySize, LDS_BYTES) != hipSuccess) { fprintf(stderr, "hipFuncSetAttribute failed\n"); grid = -1; return; }
        if (hipOccupancyMaxActiveBlocksPerMultiprocessor(&per_cu, (const void*)fwd_megakernel, NTHR, LDS_BYTES) != hipSuccess || per_cu < 1) { fprintf(stderr, "occupancy query: %d\n", per_cu); per_cu = 1; }
        (void)hipGetLastError();
        grid = cus * per_cu;
    }
    if (grid < 0) return;
    Args a{};
    a.x = (const float*)d_in[0]; a.c = (const float*)d_in[1]; a.w_ada = (const float*)d_in[2]; a.b_ada = (const float*)d_in[3]; a.g1 = (const float*)d_in[4];
    a.w_in = (const float*)d_in[5]; a.b_branch = (const float*)d_in[6]; a.w_sb = (const float*)d_in[7]; a.w_ret = (const float*)d_in[8]; a.w_out = (const float*)d_in[9];
    a.g2 = (const float*)d_in[10]; a.w_ffi = (const float*)d_in[11]; a.w_ffo = (const float*)d_in[12]; a.gf = (const float*)d_in[13];
    a.out = (float*)d_out; a.ws = (unsigned char*)d_ws;
    void* args[] = {&a};
    hipError_t e = hipLaunchCooperativeKernel((const void*)fwd_megakernel, dim3(grid), dim3(NTHR), args, LDS_BYTES, stream);
    if (e != hipSuccess) fprintf(stderr, "cooperative launch failed: %s (grid %d)\n", hipGetErrorString(e), grid);
}
```

```cpp
#include <hip/hip_runtime.h>
#include <hip/hip_cooperative_groups.h>
#include <cstdio>
#include <cstdint>
namespace cg = cooperative_groups;
namespace pg8 {
#define PG8_LAS __attribute__((address_space(3)))
typedef unsigned short bf16_t;
typedef short bf16x8 __attribute__((ext_vector_type(8)));
typedef float f32x4 __attribute__((ext_vector_type(4)));
typedef unsigned u32x4 __attribute__((ext_vector_type(4)));
constexpr int BM = 256, BK = 64, HALF = 128, HTB = HALF * BK * 2  , STAGE_BYTES = 8 * HTB, NXCD = 8, WGM = 8;

__host__ __device__ __forceinline__ int lds_byte(int r, int c) { const int st = (r >> 4) * 2 + (c >> 5), rr = r & 15, cc = c & 31, ob = rr * 64 + cc * 2; return st * 1024 + (ob ^ (((ob >> 9) & 1) << 5)); }
__host__ __device__ __forceinline__ void stage_rc(int b, int& R, int& C) { const int st = b / 1024, sb = b % 1024, swz = sb ^ (((sb >> 9) & 1) << 5); R = (st >> 1) * 16 + swz / 64; C = (st & 1) * 32 + (swz % 64) / 2; }
__host__ __device__ __forceinline__ int perm32(int rho) { const int n = rho >> 4, i = rho & 15; return 8 * (i >> 2) + 4 * n + (i & 3); }

struct Unit { int pm, pn; };
struct Gemm { const bf16_t* A; const bf16_t* Bt; int M, N, K; };

struct StaticOrder {
    int nM, nN, nwg, G, c;
    __host__ __device__ void init(int M, int N, int G_, int c_) { nM = M / BM; nN = N / BM; nwg = nM * nN; G = G_; c = c_; }
    __host__ __device__ bool next(int i, Unit& u) const {
        const long L = (long)i * G + c; if (L >= nwg) return false;
        int wgid = (int)L; { const int q = nwg / NXCD, r = nwg % NXCD, xcd = wgid % NXCD, off = wgid / NXCD; wgid = (xcd < r ? xcd * (q + 1) : r * (q + 1) + (xcd - r) * q) + off; }
        const int nig = WGM * nN, gid = wgid / nig, fm = gid * WGM, gsz = (nM - fm) < WGM ? (nM - fm) : WGM;
        u.pm = fm + ((wgid % nig) % gsz); u.pn = (wgid % nig) / gsz; return true;
    }
    __device__ __forceinline__ void a_ready(const Unit&) const {}
    __device__ __forceinline__ void done(const Unit&) const {}
};

__device__ __forceinline__ unsigned cvt_pk_bf16(float lo, float hi) { unsigned r; asm volatile("v_cvt_pk_bf16_f32 %0, %1, %2" : "=v"(r) : "v"(lo), "v"(hi)); return r; }
template <class Epi, class Sched, bool ALIGN_EPI = false, bool SP2 = false>
__device__ __forceinline__ void gemm_phase(PG8_LAS unsigned char* lds, const Gemm g, const Sched& S, const Epi& E) {
    int tid_ = threadIdx.x; asm volatile("" : "+v"(tid_));
    const int tid = tid_, wid = __builtin_amdgcn_readfirstlane(tid >> 6), lane = tid & 63, wr = wid >> 2, wc = wid & 3, fr = lane & 15, fq = lane >> 4;
    const int K = g.K, nt = K / BK;
    unsigned voffA[2], voffB[2];
#pragma unroll
    for (int i = 0; i < 2; ++i) { int R, C; stage_rc(tid * 16 + i * 8192, R, C); const int Rb = Epi::PERM ? ((R & ~31) + perm32(R & 31)) : R;
        voffA[i] = (unsigned)(R * K + C) * 2u; voffB[i] = (unsigned)(Rb * K + C) * 2u; }
    const size_t kstep = (size_t)(BK * 2);
    const size_t hstep = (size_t)HALF * K * 2;
    const size_t tstep = 2 * hstep;
    const unsigned ldsw = (unsigned)wid * 1024u;
    const int aoff = lds_byte(wr * 64 + fr, fq * 8), boff = lds_byte(wc * 32 + fr, fq * 8);
#define PG8_SA(b, h) (((b) * 2 + (h)) * HTB)
#define PG8_SB(b, h) ((4 + (b) * 2 + (h)) * HTB)
#define PG8_STAGE(bufoff, gbase, voff) do { _Pragma("unroll") for (int _i = 0; _i < 2; ++_i) \
        __builtin_amdgcn_global_load_lds((const unsigned*)((const char*)(gbase) + (voff)[_i]), (PG8_LAS unsigned*)(lds + (bufoff) + ldsw + _i * 8192), 16, 0, 0); } while (0)
#define PG8_LDA(dst, b, h) do { _Pragma("unroll") for (int m = 0; m < 4; ++m) _Pragma("unroll") for (int k = 0; k < 2; ++k) dst[m][k] = *(const PG8_LAS bf16x8*)(lds + PG8_SA(b, h) + aoff + m * 2048 + k * 1024); } while (0)
#define PG8_LDB(dst, b, h) do { _Pragma("unroll") for (int n = 0; n < 2; ++n) _Pragma("unroll") for (int k = 0; k < 2; ++k) dst[n][k] = *(const PG8_LAS bf16x8*)(lds + PG8_SB(b, h) + boff + n * 2048 + k * 1024); } while (0)
#define PG8_MMA(ai, bj, At, Bt) do { __builtin_amdgcn_s_setprio(1); _Pragma("unroll") for (int m = 0; m < 4; ++m) _Pragma("unroll") for (int n = 0; n < 2; ++n) _Pragma("unroll") for (int k = 0; k < 2; ++k) \
        acc[ai][bj][m][n] = __builtin_amdgcn_mfma_f32_16x16x32_bf16(Bt[n][k], At[m][k], acc[ai][bj][m][n], 0, 0, 0); __builtin_amdgcn_s_setprio(0); } while (0)
#define PG8_WAIT_V(n) asm volatile("s_waitcnt vmcnt(" #n ")" ::: "memory")
#define PG8_WAIT_L(n) asm volatile("s_waitcnt lgkmcnt(" #n ")" ::: "memory")
#define PG8_BAR __builtin_amdgcn_s_barrier()
#define PG8_SCHED __builtin_amdgcn_sched_barrier(0)
    Unit cur, nxt; int ui = 0;
    if (!S.next(0, cur)) return;
    f32x4 acc[2][2][4][2];
#pragma unroll
    for (int a = 0; a < 2; ++a)
#pragma unroll
        for (int b = 0; b < 2; ++b)
#pragma unroll
            for (int m = 0; m < 4; ++m)
#pragma unroll
                for (int n = 0; n < 2; ++n) acc[a][b][m][n] = (f32x4){0.f, 0.f, 0.f, 0.f};
    bf16x8 At[4][2], B0[2][2], B1[2][2];
    const char* cA = (const char*)g.A + (size_t)cur.pm * tstep; const char* cB = (const char*)g.Bt + (size_t)cur.pn * tstep;
    S.a_ready(cur);
    if constexpr (SP2) {
        PG8_STAGE(PG8_SB(0, 0), cB, voffB); PG8_STAGE(PG8_SB(0, 1), cB + hstep, voffB); PG8_STAGE(PG8_SA(0, 0), cA, voffA); PG8_STAGE(PG8_SA(0, 1), cA + hstep, voffA);
        if (wr == 1) PG8_BAR;
        PG8_WAIT_V(2); PG8_BAR;
        PG8_STAGE(PG8_SB(1, 0), cB + kstep, voffB); PG8_STAGE(PG8_SA(1, 0), cA + kstep, voffA); PG8_STAGE(PG8_SB(1, 1), cB + hstep + kstep, voffB);
        PG8_WAIT_V(6); PG8_BAR;
    } else {
        PG8_STAGE(PG8_SB(0, 0), cB, voffB); PG8_STAGE(PG8_SA(0, 0), cA, voffA); PG8_STAGE(PG8_SB(0, 1), cB + hstep, voffB); PG8_STAGE(PG8_SA(0, 1), cA + hstep, voffA);
        if (wr == 1) PG8_BAR;
        PG8_WAIT_V(4); PG8_BAR;
        PG8_STAGE(PG8_SB(1, 0), cB + kstep, voffB); PG8_STAGE(PG8_SA(1, 0), cA + kstep, voffA); PG8_STAGE(PG8_SB(1, 1), cB + hstep + kstep, voffB);
        PG8_WAIT_V(6); PG8_BAR;
    }
    for (;;) {
        const bool has_next = S.next(ui + 1, nxt);
        const char* nA = has_next ? (const char*)g.A + (size_t)nxt.pm * tstep : cA; const char* nB = has_next ? (const char*)g.Bt + (size_t)nxt.pn * tstep : cB;
        for (int t = 0; t < nt; t += 2) {
            const bool last = (t == nt - 2);
            const char* a1 = cA + (size_t)(t + 1) * kstep;
            const char* a2 = last ? nA : cA + (size_t)(t + 2) * kstep; const char* b2 = last ? nB : cB + (size_t)(t + 2) * kstep;
            const char* a3 = a2 + kstep; const char* b3 = b2 + kstep;
            if (last && has_next) S.a_ready(nxt);
            if constexpr (SP2) {
            PG8_LDB(B0, 0, 0); PG8_LDB(B1, 0, 1); PG8_SCHED; PG8_LDA(At, 0, 0); PG8_STAGE(PG8_SA(1, 1), a1 + hstep, voffA);
            PG8_WAIT_V(8); PG8_WAIT_L(0); PG8_BAR; PG8_MMA(0, 0, At, B0); PG8_MMA(0, 1, At, B1); PG8_BAR; PG8_SCHED;
            PG8_LDA(At, 0, 1); PG8_STAGE(PG8_SB(0, 0), b2, voffB); PG8_STAGE(PG8_SB(0, 1), b2 + hstep, voffB); PG8_STAGE(PG8_SA(0, 0), a2, voffA);
            PG8_WAIT_V(8); PG8_WAIT_L(0); PG8_BAR; PG8_MMA(1, 0, At, B0); PG8_MMA(1, 1, At, B1); PG8_BAR; PG8_SCHED;
            PG8_LDB(B0, 1, 0); PG8_LDB(B1, 1, 1); PG8_SCHED; PG8_LDA(At, 1, 0); PG8_STAGE(PG8_SA(0, 1), a2 + hstep, voffA);
            PG8_WAIT_V(8); PG8_WAIT_L(0); PG8_BAR; PG8_MMA(0, 0, At, B0); PG8_MMA(0, 1, At, B1); PG8_BAR; PG8_SCHED;
            PG8_LDA(At, 1, 1); PG8_STAGE(PG8_SB(1, 0), b3, voffB); PG8_STAGE(PG8_SB(1, 1), b3 + hstep, voffB); PG8_STAGE(PG8_SA(1, 0), a3, voffA);
            PG8_WAIT_V(8); PG8_WAIT_L(0); PG8_BAR; PG8_MMA(1, 0, At, B0); PG8_MMA(1, 1, At, B1); PG8_BAR; PG8_SCHED;
            } else {
            PG8_LDB(B0, 0, 0); PG8_SCHED; PG8_LDA(At, 0, 0); PG8_STAGE(PG8_SA(1, 1), a1 + hstep, voffA);
            PG8_WAIT_L(8); PG8_BAR; PG8_WAIT_L(0); PG8_MMA(0, 0, At, B0); PG8_BAR; PG8_SCHED;
            PG8_LDB(B1, 0, 1); PG8_STAGE(PG8_SB(0, 0), b2, voffB);
            PG8_BAR; PG8_WAIT_L(0); PG8_MMA(0, 1, At, B1); PG8_BAR;
            PG8_LDA(At, 0, 1); PG8_STAGE(PG8_SA(0, 0), a2, voffA);
            PG8_BAR; PG8_WAIT_L(0); PG8_MMA(1, 0, At, B0); PG8_BAR; PG8_SCHED;
            PG8_STAGE(PG8_SB(0, 1), b2 + hstep, voffB);
            PG8_WAIT_V(6); PG8_BAR; PG8_MMA(1, 1, At, B1); PG8_BAR;
            PG8_LDB(B0, 1, 0); PG8_SCHED; PG8_LDA(At, 1, 0); PG8_STAGE(PG8_SA(0, 1), a2 + hstep, voffA);
            PG8_WAIT_L(8); PG8_BAR; PG8_WAIT_L(0); PG8_MMA(0, 0, At, B0); PG8_BAR; PG8_SCHED;
            PG8_LDB(B1, 1, 1); PG8_STAGE(PG8_SB(1, 0), b3, voffB);
            PG8_BAR; PG8_WAIT_L(0); PG8_MMA(0, 1, At, B1); PG8_BAR;
            PG8_LDA(At, 1, 1); PG8_STAGE(PG8_SA(1, 0), a3, voffA);
            PG8_BAR; PG8_WAIT_L(0); PG8_MMA(1, 0, At, B0); PG8_BAR; PG8_SCHED;
            PG8_STAGE(PG8_SB(1, 1), b3 + hstep, voffB);
            PG8_WAIT_V(6); PG8_BAR; PG8_MMA(1, 1, At, B1); PG8_BAR;
            }
        }
        if constexpr (ALIGN_EPI) { if (wr == 0) PG8_BAR; }
        if constexpr (!Epi::AFTER_DRAIN) { E(acc, cur, wr, wc, fr, fq); S.done(cur); }
        if (!has_next) break;
#pragma unroll
        for (int a = 0; a < 2; ++a)
#pragma unroll
            for (int b = 0; b < 2; ++b)
#pragma unroll
                for (int m = 0; m < 4; ++m)
#pragma unroll
                    for (int n = 0; n < 2; ++n) acc[a][b][m][n] = (f32x4){0.f, 0.f, 0.f, 0.f};
        cur = nxt; cA = nA; cB = nB; ++ui;
        if constexpr (ALIGN_EPI) { if (wr == 1) PG8_BAR; }
    }
    PG8_WAIT_V(0);
    if constexpr (!ALIGN_EPI) { if (wr == 0) PG8_BAR; }
    PG8_BAR;
    if constexpr (Epi::AFTER_DRAIN) { E.fused(acc, cur, wr, wc, fr, fq, lds, wid, lane); S.done(cur); }
#undef PG8_SA
#undef PG8_SB
#undef PG8_STAGE
#undef PG8_LDA
#undef PG8_LDB
#undef PG8_MMA
#undef PG8_WAIT_V
#undef PG8_WAIT_L
#undef PG8_BAR
#undef PG8_SCHED
}
}

#define GAS __attribute__((address_space(1)))
#define LAS __attribute__((address_space(3)))
#define DI __device__ __forceinline__
typedef unsigned short bf16;
typedef unsigned u32x4 __attribute__((ext_vector_type(4)));
typedef unsigned u32x2 __attribute__((ext_vector_type(2)));
typedef float f32x4 __attribute__((ext_vector_type(4)));
typedef float f32x16 __attribute__((ext_vector_type(16)));
typedef short bf16x8 __attribute__((ext_vector_type(8)));
typedef short s16x4 __attribute__((ext_vector_type(4)));
typedef LAS unsigned char* ldsp;

constexpr int NWAVES = 8, NTHR = 512;
constexpr int T_ = 32768, D_ = 1024, S_ = 2048, NB = 16, DFF = 2816, INW = 11264, NMOD = 6144;
constexpr float EPS_ = 1e-6f;
constexpr size_t MiB = 1u << 20;
constexpr size_t WS_SBQ = 0, WS_SBK = 64 * MiB, WS_SBV = 128 * MiB, WS_RQ = 192 * MiB, WS_RK = 256 * MiB, WS_RV = 320 * MiB;
constexpr size_t WS_WIN = 448 * MiB, WS_WSB = 470 * MiB, WS_WRET = 472 * MiB, WS_WOUT = 476 * MiB, WS_WFFI = 478 * MiB, WS_WFFO = 489 * MiB;
constexpr size_t WS_MODP = 495 * MiB, WS_MODF = 498 * MiB, WS_COS = 499 * MiB, WS_SIN = 500 * MiB, WS_RS = 501 * MiB, WS_END = 512 * MiB;
constexpr size_t WS_GATES = 64 * MiB, WS_M1 = 192 * MiB, WS_MERGED = 256 * MiB, WS_HFFN = 0, WS_H = 64 * MiB;
constexpr int LDS_BYTES = 147456;

DI unsigned pk2(float lo, float hi) { return pg8::cvt_pk_bf16(lo, hi); }
DI float bf2f(unsigned short v) { return __uint_as_float((unsigned)v << 16); }
DI float bflo(unsigned w) { return __uint_as_float(w << 16); }
DI float bfhi(unsigned w) { return __uint_as_float(w & 0xffff0000u); }
DI float wave_sum(float v) {
#pragma unroll
    for (int o = 1; o < 64; o <<= 1) v += __shfl_xor(v, o);
    return v;
}
DI float fsigmoid(float v) { return 1.0f / (1.0f + __expf(-v)); }
DI u32x4 pack8(f32x4 a, f32x4 b) { u32x4 w; w.x = pk2(a[0], a[1]); w.y = pk2(a[2], a[3]); w.z = pk2(b[0], b[1]); w.w = pk2(b[2], b[3]); return w; }
DI void unpack8(u32x4 w, f32x4& a, f32x4& b) { a = (f32x4){bflo(w.x), bfhi(w.x), bflo(w.y), bfhi(w.y)}; b = (f32x4){bflo(w.z), bfhi(w.z), bflo(w.w), bfhi(w.w)}; }

struct Args {
    const float *x, *c, *w_ada, *b_ada, *g1, *w_in, *b_branch, *w_sb, *w_ret, *w_out, *g2, *w_ffi, *w_ffo, *gf;
    float* out; unsigned char* ws;
};

using pg8::Unit;
#define EPI_ARGS const f32x4 (&acc)[2][2][4][2], const Unit& u, int wr, int wc, int fr, int fq
struct EpiInProj {
    static constexpr bool PERM = true, AFTER_DRAIN = false;
    bf16 *sbq, *sbk, *sbv, *rq, *rk, *rv; const float *cosT, *sinT;
    DI void operator()(EPI_ARGS) const {
        const int pn = u.pn, row0 = u.pm * 256 + wr * 64 + fr, cw = wc * 32 + 8 * fq;
        if (pn < 12 || pn >= 20) {
            bf16* base; int ld = 1024, colt;
            if (pn < 4) { base = sbq; colt = pn * 256; } else if (pn < 8) { base = sbk; colt = (pn - 4) * 256; }
            else if (pn < 12) { base = sbv; colt = (pn - 8) * 256; } else { base = rv; ld = 2048; colt = (pn - 20) * 256; }
#pragma unroll
            for (int ai = 0; ai < 2; ++ai)
#pragma unroll
                for (int m = 0; m < 4; ++m) { bf16* rowp = base + (size_t)(row0 + ai * 128 + m * 16) * ld + colt + cw;
#pragma unroll
                    for (int bj = 0; bj < 2; ++bj) *(u32x4*)(rowp + bj * 128) = pack8(acc[ai][bj][m][0], acc[ai][bj][m][1]); }
        } else {
            const bool isk = pn >= 16; const int hh = isk ? pn - 16 : pn - 12; bf16* base = (isk ? rk : rq) + hh * 256 + cw;
            const float lg = __log2f(1.0f - exp2f(-5.0f - (float)hh));
#pragma unroll
            for (int ai = 0; ai < 2; ++ai)
#pragma unroll
                for (int m = 0; m < 4; ++m) {
                    const int row = row0 + ai * 128 + m * 16, pos = row & 2047, c = row & 127;
                    const float f = isk ? exp2f(-(float)c * lg) * 0.0625f : exp2f((float)c * lg);
                    const float* cp = cosT + pos * 128 + cw; const float* sp = sinT + pos * 128 + cw;
                    bf16* rowp = base + (size_t)row * 1024;
#pragma unroll
                    for (int n = 0; n < 2; ++n) {
                        const f32x4 cs = *(const f32x4*)(cp + 4 * n), sn = *(const f32x4*)(sp + 4 * n);
                        const f32x4 v1 = acc[ai][0][m][n], v2 = acc[ai][1][m][n];
                        const f32x4 o1 = (v1 * cs - v2 * sn) * f, o2 = (v1 * sn + v2 * cs) * f;
                        u32x2 w1, w2; w1.x = pk2(o1[0], o1[1]); w1.y = pk2(o1[2], o1[3]); w2.x = pk2(o2[0], o2[1]); w2.y = pk2(o2[2], o2[3]);
                        *(u32x2*)(rowp + 4 * n) = w1; *(u32x2*)(rowp + 128 + 4 * n) = w2;
                    }
                }
        }
    }
};
struct EpiGates {
    static constexpr bool PERM = true, AFTER_DRAIN = false;
    bf16 *rv, *gates; const float *rs, *bb;
    DI void operator()(EPI_ARGS) const {
        const int pn = u.pn, row0 = u.pm * 256 + wr * 64 + fr, cw = wc * 32 + 8 * fq;
        if (pn < 8) {
            const int head = pn >> 1;
#pragma unroll
            for (int ai = 0; ai < 2; ++ai)
#pragma unroll
                for (int m = 0; m < 4; ++m) {
                    const int row = row0 + ai * 128 + m * 16;
                    const f32x4 q = *(const f32x4*)(rs + (size_t)row * 16 + head * 4);
                    const float rsv = rsqrtf(((q[0] + q[1]) + (q[2] + q[3])) * (1.0f / 512.0f) + EPS_);
#pragma unroll
                    for (int bj = 0; bj < 2; ++bj) {
                        bf16* p = rv + (size_t)row * 2048 + pn * 256 + bj * 128 + cw;
                        f32x4 oa, ob; unpack8(*(const u32x4*)p, oa, ob);
                        f32x4 ga = acc[ai][bj][m][0], gb = acc[ai][bj][m][1];
#pragma unroll
                        for (int e = 0; e < 4; ++e) { ga[e] = ga[e] * fsigmoid(ga[e]) * oa[e] * rsv; gb[e] = gb[e] * fsigmoid(gb[e]) * ob[e] * rsv; }
                        *(u32x4*)p = pack8(ga, gb);
                    }
                }
        } else {
#pragma unroll
            for (int bj = 0; bj < 2; ++bj) {
                const int col = (pn - 8) * 256 + bj * 128 + cw;
                const f32x4 b0 = *(const f32x4*)(bb + col), b1 = *(const f32x4*)(bb + col + 4);
#pragma unroll
                for (int ai = 0; ai < 2; ++ai)
#pragma unroll
                    for (int m = 0; m < 4; ++m) {
                        const int row = row0 + ai * 128 + m * 16;
                        f32x4 ga = acc[ai][bj][m][0] + b0, gb = acc[ai][bj][m][1] + b1;
#pragma unroll
                        for (int e = 0; e < 4; ++e) { ga[e] = fsigmoid(ga[e]); gb[e] = fsigmoid(gb[e]); }
                        *(u32x4*)(gates + (size_t)row * 2048 + col) = pack8(ga, gb);
                    }
            }
        }
    }
};
template <int MODE> struct EpiMerge {
    static constexpr bool PERM = true, AFTER_DRAIN = false;
    const bf16* gates; const bf16* m1; bf16* outp;
    DI void operator()(EPI_ARGS) const {
        const int row0 = u.pm * 256 + wr * 64 + fr, cw = wc * 32 + 8 * fq;
#pragma unroll
        for (int ai = 0; ai < 2; ++ai)
#pragma unroll
            for (int m = 0; m < 4; ++m) {
                const int row = row0 + ai * 128 + m * 16;
#pragma unroll
                for (int bj = 0; bj < 2; ++bj) {
                    const int col = u.pn * 256 + bj * 128 + cw;
                    f32x4 ga, gb; unpack8(*(const u32x4*)(gates + (size_t)row * 2048 + MODE * 1024 + col), ga, gb);
                    f32x4 ra = ga * acc[ai][bj][m][0], rb = gb * acc[ai][bj][m][1];
                    if (MODE == 1) { f32x4 pa, pb; unpack8(*(const u32x4*)(m1 + (size_t)row * 1024 + col), pa, pb); ra += pa; rb += pb; }
                    *(u32x4*)(outp + (size_t)row * 1024 + col) = pack8(ra, rb);
                }
            }
    }
};
struct EpiResid {
    static constexpr bool PERM = true, AFTER_DRAIN = false;
    const float* base; float* outp; const float* gate;
    DI void operator()(EPI_ARGS) const {
        const int row0 = u.pm * 256 + wr * 64 + fr, cw = wc * 32 + 8 * fq, b = u.pm >> 3;
#pragma unroll
        for (int bj = 0; bj < 2; ++bj) {
            const int col = u.pn * 256 + bj * 128 + cw;
            const f32x4 g0 = *(const f32x4*)(gate + b * NMOD + col), g1v = *(const f32x4*)(gate + b * NMOD + col + 4);
#pragma unroll
            for (int ai = 0; ai < 2; ++ai)
#pragma unroll
                for (int m = 0; m < 4; ++m) {
                    const size_t off = (size_t)(row0 + ai * 128 + m * 16) * 1024 + col;
                    const f32x4 x0 = *(const f32x4*)(base + off), x1 = *(const f32x4*)(base + off + 4);
                    *(f32x4*)(outp + off) = x0 + g0 * acc[ai][bj][m][0]; *(f32x4*)(outp + off + 4) = x1 + g1v * acc[ai][bj][m][1];
                }
        }
    }
};
struct EpiSwiglu {
    static constexpr bool PERM = true, AFTER_DRAIN = false;
    bf16* H;
    DI void operator()(EPI_ARGS) const {
        const int row0 = u.pm * 256 + wr * 64 + fr, cw = wc * 32 + 8 * fq;
#pragma unroll
        for (int ai = 0; ai < 2; ++ai)
#pragma unroll
            for (int m = 0; m < 4; ++m) {
                f32x4 a0 = acc[ai][0][m][0], a1 = acc[ai][0][m][1]; const f32x4 u0 = acc[ai][1][m][0], u1 = acc[ai][1][m][1];
#pragma unroll
                for (int e = 0; e < 4; ++e) { a0[e] = a0[e] * fsigmoid(a0[e]) * u0[e]; a1[e] = a1[e] * fsigmoid(a1[e]) * u1[e]; }
                *(u32x4*)(H + (size_t)(row0 + ai * 128 + m * 16) * DFF + u.pn * 128 + cw) = pack8(a0, a1);
            }
    }
};

DI int ffi_row(int n) { return n < DFF ? 256 * (n >> 7) + (n & 127) : 256 * ((n - DFF) >> 7) + 128 + ((n - DFF) & 127); }
DI void transpose_item(const float* W, int K, int N, bf16* WT, int mode, LAS float* scr, int item, int lane) {
    const int nblk = N / 32, kb = item / nblk, nb = item % nblk, k0 = 64 * kb, n0 = 32 * nb;
    const int d0 = mode ? ffi_row(n0) : n0;
#pragma unroll 8
    for (int i = 0; i < 32; ++i) { const int kk = 2 * i + (lane >> 5); scr[kk * 33 + (lane & 31)] = W[(size_t)(k0 + kk) * N + n0 + (lane & 31)]; }
    asm volatile("s_waitcnt lgkmcnt(0)" ::: "memory");
    const int c = lane & 7;
#pragma unroll
    for (int j = 0; j < 4; ++j) { const int n = (lane >> 3) + 8 * j; const LAS float* s = scr + (8 * c) * 33 + n;
        u32x4 o; o.x = pk2(s[0 * 33], s[1 * 33]); o.y = pk2(s[2 * 33], s[3 * 33]); o.z = pk2(s[4 * 33], s[5 * 33]); o.w = pk2(s[6 * 33], s[7 * 33]);
        *(u32x4*)(WT + (size_t)(d0 + n) * K + k0 + 8 * c) = o; }
    asm volatile("s_waitcnt lgkmcnt(0)" ::: "memory");
}
DI void p0_prologue(const Args& A, ldsp lds, int G) {
    const int tid = threadIdx.x, lane = tid & 63, wave = tid >> 6;
    LAS float* scr = (LAS float*)(lds + wave * 16384);
    const int gw = blockIdx.x * NWAVES + wave, NGW = G * NWAVES;
    unsigned char* ws = A.ws;
    constexpr int I_IN = (D_ / 64) * (INW / 32), I_SB = 16 * 32, I_RET = 32 * 32, I_OUT = 16 * 32, I_FFI = 16 * (2 * DFF / 32), I_FFO = (DFF / 64) * 32;
    constexpr int I_MOD = 96 * 8, I_ROPE = 2048 * 128 / 64;
    constexpr int NIT = I_IN + I_SB + I_RET + I_OUT + I_FFI + I_FFO + I_MOD + I_ROPE;
    for (int it = gw; it < NIT; it += NGW) {
        int r = it;
        if (r < I_IN) { transpose_item(A.w_in, D_, INW, (bf16*)(ws + WS_WIN), 0, scr, r, lane); continue; } r -= I_IN;
        if (r < I_SB) { transpose_item(A.w_sb, 1024, 1024, (bf16*)(ws + WS_WSB), 0, scr, r, lane); continue; } r -= I_SB;
        if (r < I_RET) { transpose_item(A.w_ret, 2048, 1024, (bf16*)(ws + WS_WRET), 0, scr, r, lane); continue; } r -= I_RET;
        if (r < I_OUT) { transpose_item(A.w_out, 1024, 1024, (bf16*)(ws + WS_WOUT), 0, scr, r, lane); continue; } r -= I_OUT;
        if (r < I_FFI) { transpose_item(A.w_ffi, 1024, 2 * DFF, (bf16*)(ws + WS_WFFI), 1, scr, r, lane); continue; } r -= I_FFI;
        if (r < I_FFO) { transpose_item(A.w_ffo, DFF, 1024, (bf16*)(ws + WS_WFFO), 0, scr, r, lane); continue; } r -= I_FFO;
        if (r < I_MOD) {
            const int eb = r % 96, ks = r / 96, d0 = ks * 128, e = eb * 64 + lane;
#pragma unroll 4
            for (int i = 0; i < 32; ++i) { const int idx = i * 64 + lane, b = idx >> 7, dd = idx & 127; const float cv = A.c[b * 1024 + d0 + dd]; scr[idx] = cv * fsigmoid(cv); }
            asm volatile("s_waitcnt lgkmcnt(0)" ::: "memory");
            float a[16];
#pragma unroll
            for (int b = 0; b < 16; ++b) a[b] = 0.f;
            for (int dd = 0; dd < 128; ++dd) { const float w = A.w_ada[(size_t)(d0 + dd) * NMOD + e];
#pragma unroll
                for (int b = 0; b < 16; ++b) a[b] += scr[b * 128 + dd] * w; }
            float* mp = (float*)(ws + WS_MODP) + (size_t)ks * NB * NMOD + e;
#pragma unroll
            for (int b = 0; b < 16; ++b) mp[b * NMOD] = a[b];
            asm volatile("s_waitcnt lgkmcnt(0)" ::: "memory");
            continue;
        } r -= I_MOD;
        {
            const int idx = r * 64 + lane, pos = idx >> 7, j = idx & 127;
            const float inv = exp2f(-(float)j * (13.287712379549449f / 128.0f));
            const float ang = (float)pos * inv;
            const float n = rintf(ang * 0.15915494309189535f);
            float rr = __builtin_fmaf(-n, 6.28125f, ang); rr = __builtin_fmaf(-n, 0.0019353071795864769f, rr);
            ((float*)(ws + WS_COS))[idx] = cosf(rr); ((float*)(ws + WS_SIN))[idx] = sinf(rr);
        }
    }
}
template <bool FIRST> DI void norm_mod_phase(const Args& A, ldsp lds, int G, const float* src, const float* gw_, bf16* dst, int shift_off) {
    const int tid = threadIdx.x, lane = tid & 63, wave = tid >> 6;
    LAS float* modl = (LAS float*)lds;
    const float* modp = (const float*)(A.ws + WS_MODP); float* modf = (float*)(A.ws + WS_MODF);
    for (int rb = blockIdx.x; rb < 256; rb += G) {
        const int b = rb >> 4;
        __syncthreads();
        for (int i = tid; i < 2048; i += NTHR) {
            float v;
            if (FIRST) { const int e = i; v = A.b_ada[e]; for (int ks = 0; ks < 8; ++ks) v += modp[(size_t)ks * NB * NMOD + b * NMOD + e]; }
            else v = modf[b * NMOD + shift_off + i];
            modl[i] = v;
        }
        if (FIRST && tid < 384) { const int idx = rb * 384 + tid, e = idx % NMOD; float v = A.b_ada[e]; for (int ks = 0; ks < 8; ++ks) v += modp[(size_t)ks * NB * NMOD + idx]; modf[idx] = v; }
        __syncthreads();
        for (int rr = 0; rr < 16; ++rr) {
            const int row = rb * 128 + wave * 16 + rr;
            const f32x4* xr = (const f32x4*)(src + (size_t)row * 1024) + lane;
            f32x4 v[4]; float s = 0.f;
#pragma unroll
            for (int j = 0; j < 4; ++j) { v[j] = xr[64 * j]; s += (v[j][0] * v[j][0] + v[j][1] * v[j][1]) + (v[j][2] * v[j][2] + v[j][3] * v[j][3]); }
            const float rstd = rsqrtf(wave_sum(s) * (1.0f / 1024.0f) + EPS_);
            unsigned long long* o8 = (unsigned long long*)(dst + (size_t)row * 1024) + lane;
#pragma unroll
            for (int j = 0; j < 4; ++j) {
                const int col = 4 * lane + 256 * j;
                const f32x4 g = *(const f32x4*)(gw_ + col); const f32x4 sh = *(const LAS f32x4*)(modl + col), sc = *(const LAS f32x4*)(modl + 1024 + col);
                const f32x4 y = v[j] * rstd * g * (sc + 1.0f) + sh;
                o8[64 * j] = (unsigned long long)pk2(y[0], y[1]) | ((unsigned long long)pk2(y[2], y[3]) << 32);
            }
        }
    }
    __syncthreads();
}
DI void final_norm_phase(const Args& A, int G) {
    const int tid = threadIdx.x, lane = tid & 63, wave = tid >> 6;
    const int gw = blockIdx.x * NWAVES + wave, NGW = G * NWAVES;
    for (int row = gw; row < T_; row += NGW) {
        f32x4* xr = (f32x4*)(A.out + (size_t)row * 1024) + lane;
        f32x4 v[4]; float s = 0.f;
#pragma unroll
        for (int j = 0; j < 4; ++j) { v[j] = xr[64 * j]; s += (v[j][0] * v[j][0] + v[j][1] * v[j][1]) + (v[j][2] * v[j][2] + v[j][3] * v[j][3]); }
        const float rstd = rsqrtf(wave_sum(s) * (1.0f / 1024.0f) + EPS_);
#pragma unroll
        for (int j = 0; j < 4; ++j) { const f32x4 g = *(const f32x4*)(A.gf + 4 * lane + 256 * j); xr[64 * j] = v[j] * rstd * g; }
    }
}

typedef short v4i16_t __attribute__((ext_vector_type(4)));
DI s16x4 tr_read(const LAS unsigned char* p) { return __builtin_bit_cast(s16x4, __builtin_amdgcn_ds_read_tr16_b64_v4i16((LAS v4i16_t*)p)); }
#define MFMA32(a, b, c) __builtin_amdgcn_mfma_f32_32x32x16_bf16((a), (b), (c), 0, 0, 0)
#define MFMA16(a, b, c) __builtin_amdgcn_mfma_f32_16x16x32_bf16((a), (b), (c), 0, 0, 0)
DI int crow(int r, int hi) { return (r & 3) + 8 * (r >> 2) + 4 * hi; }
DI bf16x8 pack_step(const f32x16& x, int s) {
    u32x4 p; p.x = pk2(x[8 * s], x[8 * s + 1]); p.y = pk2(x[8 * s + 2], x[8 * s + 3]); p.z = pk2(x[8 * s + 4], x[8 * s + 5]); p.w = pk2(x[8 * s + 6], x[8 * s + 7]);
    return __builtin_bit_cast(bf16x8, p);
}
constexpr int SB_PK = 144, SB_PV = 192;
constexpr int SB_KBYTES = 64 * SB_PK, SB_VBYTES = 64 * SB_PV, SB_BUF = SB_KBYTES + SB_VBYTES;
DI void sb_attn_unit(ldsp lds, const bf16* Q, const bf16* K, const bf16* V, bf16* O, int b, int h, int qb, int dry = 0) {
    const int tid = threadIdx.x, lane = tid & 63, wave = __builtin_amdgcn_readfirstlane(tid >> 6), r32 = lane & 31, hi = lane >> 5;
    const int t0 = qb * 256 + wave * 32, tq = t0 + r32;
    const size_t rowbase = (size_t)b * S_;
    bf16x8 qf[4];
#pragma unroll
    for (int ks = 0; ks < 4; ++ks) qf[ks] = *(const bf16x8*)(Q + (rowbase + tq) * 1024 + h * 64 + 16 * ks + 8 * hi);
    bf16x8 U0, U1, ONES;
#pragma unroll
    for (int jj = 0; jj < 8; ++jj) { const int k0 = 8 * (jj >> 2) + 4 * hi + (jj & 3); U0[jj] = (k0 >= r32) ? (short)0x3F80 : (short)0; U1[jj] = (16 + k0 >= r32) ? (short)0x3F80 : (short)0; ONES[jj] = (short)0x3F80; }
    f32x16 o0, o1;
#pragma unroll
    for (int i = 0; i < 16; ++i) { o0[i] = 0.f; o1[i] = 0.f; }
    float R2 = 0.f;
    const int ntiles = qb * 4 + 4;
    const int srow = tid >> 3, schunk = tid & 7;
    const bf16* kg = K + (rowbase + srow) * 1024 + h * 64 + schunk * 8; const bf16* vg = V + (rowbase + srow) * 1024 + h * 64 + schunk * 8;
    const int kso = srow * SB_PK + schunk * 16, vso = SB_KBYTES + srow * SB_PV + schunk * 16;
    LAS unsigned* doneF = (LAS unsigned*)(lds + 2 * SB_BUF);
    bool wdone = false;
    __syncthreads();
    { const int jt = ntiles - 1; const u32x4 kr = *(const u32x4*)(kg + (size_t)jt * 64 * 1024), vr = *(const u32x4*)(vg + (size_t)jt * 64 * 1024);
      *(LAS u32x4*)(lds + kso) = kr; *(LAS u32x4*)(lds + vso) = vr; }
    __syncthreads();
    const float C2 = 0.125f * 1.4426950408889634f;
    const int i16 = lane & 15, blk = (lane >> 4) & 1, qq = i16 >> 2, pp = i16 & 3;
    for (int jt = ntiles - 1; jt >= 0; --jt) {
        const int cur = (ntiles - 1 - jt) & 1;
        u32x4 kr, vr;
        if (jt > 0) { kr = *(const u32x4*)(kg + (size_t)(jt - 1) * 64 * 1024); vr = *(const u32x4*)(vg + (size_t)(jt - 1) * 64 * 1024); }
        if (!wdone && 64 * jt < t0 + 31) {
            const LAS unsigned char* Kb = lds + cur * SB_BUF; const LAS unsigned char* Vb = Kb + SB_KBYTES;
            const bool diag = (64 * jt + 63 >= t0);
            f32x16 z[2];
#pragma unroll
            for (int rb = 0; rb < 2; ++rb) {
#pragma unroll
                for (int i = 0; i < 16; ++i) z[rb][i] = 0.f;
#pragma unroll
                for (int ks = 0; ks < 4; ++ks) { const bf16x8 a = *(const LAS bf16x8*)(Kb + (32 * rb + r32) * SB_PK + (16 * ks + 8 * hi) * 2); z[rb] = MFMA32(a, qf[ks], z[rb]); }
            }
            float lsum = 0.f; f32x16 L[2];
#pragma unroll
            for (int rb = 0; rb < 2; ++rb)
#pragma unroll
                for (int i = 0; i < 16; ++i) {
                    const float z2 = z[rb][i] * C2;
                    const float e = __builtin_amdgcn_exp2f(-__builtin_fabsf(z2));
                    float l = -(__builtin_fmaxf(z2, 0.f) + __builtin_amdgcn_logf(1.0f + e));
                    if (diag) { const int s = 64 * jt + 32 * rb + crow(i, hi); if (!(s < tq)) l = 0.f; }
                    L[rb][i] = l; lsum += l; z[rb][i] = z2 + R2;
                }
            bf16x8 Lp[4];
#pragma unroll
            for (int q = 0; q < 4; ++q) Lp[q] = pack_step(L[q >> 1], q & 1);
            f32x16 la0 = MFMA32(U0, Lp[0], z[0]); la0 = MFMA32(U1, Lp[1], la0); la0 = MFMA32(ONES, Lp[2], la0); la0 = MFMA32(ONES, Lp[3], la0);
            f32x16 la1 = MFMA32(U0, Lp[2], z[1]); la1 = MFMA32(U1, Lp[3], la1);
#pragma unroll
            for (int i = 0; i < 16; ++i) {
                float a0 = __builtin_amdgcn_exp2f(la0[i]), a1 = __builtin_amdgcn_exp2f(la1[i]);
                if (diag) { const int s = 64 * jt + crow(i, hi); if (!(s < tq)) a0 = 0.f; if (!(s + 32 < tq)) a1 = 0.f; }
                la0[i] = a0; la1[i] = a1;
            }
            bf16x8 Ap[4]; Ap[0] = pack_step(la0, 0); Ap[1] = pack_step(la0, 1); Ap[2] = pack_step(la1, 0); Ap[3] = pack_step(la1, 1);
#pragma unroll
            for (int q = 0; q < 4; ++q) {
                const int key0 = 16 * q + 4 * hi;
#pragma unroll
                for (int db = 0; db < 2; ++db) {
                    const LAS unsigned char* ap = Vb + (key0 + qq) * SB_PV + (32 * db + 16 * blk + 4 * pp) * 2;
                    const s16x4 lo = tr_read(ap), hi4 = tr_read(ap + 8 * SB_PV);
                    const bf16x8 va = __builtin_shufflevector(lo, hi4, 0, 1, 2, 3, 4, 5, 6, 7);
                    if (db == 0) o0 = MFMA32(va, Ap[q], o0); else o1 = MFMA32(va, Ap[q], o1);
                }
            }
            R2 += lsum + __shfl_xor(lsum, 32);
            wdone = __all(R2 < -160.0f);
        }
        if (lane == 0) doneF[(jt & 1) * 8 + wave] = wdone ? 1u : 0u;
        if (jt > 0) { *(LAS u32x4*)(lds + (cur ^ 1) * SB_BUF + kso) = kr; *(LAS u32x4*)(lds + (cur ^ 1) * SB_BUF + vso) = vr; }
        __syncthreads();
        { const LAS u32x4* df = (const LAS u32x4*)(doneF + (jt & 1) * 8); const u32x4 f0 = df[0], f1 = df[1];
          if ((f0.x & f0.y & f0.z & f0.w & f1.x & f1.y & f1.z & f1.w) != 0u) break; }
    }
    bf16* op = O + (rowbase + tq) * 1024 + h * 64 + 4 * hi;
#pragma unroll
    for (int g = 0; g < 4; ++g) {
        u32x2 w0, w1; w0.x = pk2(o0[4 * g], o0[4 * g + 1]); w0.y = pk2(o0[4 * g + 2], o0[4 * g + 3]); w1.x = pk2(o1[4 * g], o1[4 * g + 1]); w1.y = pk2(o1[4 * g + 2], o1[4 * g + 3]);
        if (!dry) { *(u32x2*)(op + 8 * g) = w0; *(u32x2*)(op + 32 + 8 * g) = w1; }
    }
}


DI void sb_attn_wave(ldsp vl  , const bf16* Q, const bf16* K, const bf16* V, bf16* O, int b, int h, int rg) {
    const int lane = threadIdx.x & 63, r32 = lane & 31, hi = lane >> 5;
    const int t0 = rg * 32, tq = t0 + r32;
    const size_t rowbase = (size_t)b * S_;
    bf16x8 qf[4];
#pragma unroll
    for (int ks = 0; ks < 4; ++ks) qf[ks] = *(const bf16x8*)(Q + (rowbase + tq) * 1024 + h * 64 + 16 * ks + 8 * hi);
    bf16x8 U0, U1, ONES;
#pragma unroll
    for (int jj = 0; jj < 8; ++jj) { const int k0 = 8 * (jj >> 2) + 4 * hi + (jj & 3); U0[jj] = (k0 >= r32) ? (short)0x3F80 : (short)0; U1[jj] = (16 + k0 >= r32) ? (short)0x3F80 : (short)0; ONES[jj] = (short)0x3F80; }
    f32x16 o0, o1;
#pragma unroll
    for (int i = 0; i < 16; ++i) { o0[i] = 0.f; o1[i] = 0.f; }
    float R2 = 0.f;
    const int jtop = (t0 + 30) >> 6;
    const bf16* kg = K + (rowbase + r32) * 1024 + h * 64 + 8 * hi;
    const bf16* vg = V + (rowbase + (lane >> 3)) * 1024 + h * 64 + (((lane & 7) ^ ((((lane >> 3) >> 1) & 1) << 2)) * 8);
    const int i16 = lane & 15, blk = (lane >> 4) & 1, qq = i16 >> 2, pp = i16 & 3;
    const int vro = (4 * hi + qq) * 128 + (((2 * blk + (pp >> 1)) ^ (((qq >> 1) & 1) << 2)) * 16) + 8 * (pp & 1);
    bf16x8 kf[8];
#pragma unroll
    for (int i = 0; i < 8; ++i) __builtin_amdgcn_global_load_lds((const unsigned*)(vg + (size_t)(64 * jtop + 8 * i) * 1024), (LAS unsigned*)(vl + i * 1024), 16, 0, 0);
#pragma unroll
    for (int i = 0; i < 8; ++i) kf[i] = *(const bf16x8*)(kg + (size_t)(64 * jtop + 32 * (i >> 2)) * 1024 + 16 * (i & 3));
    const float C2 = 0.125f * 1.4426950408889634f;
    for (int jt = jtop; jt >= 0; --jt) {
        const int cur = (jtop - jt) & 1;
        asm volatile("s_waitcnt vmcnt(0)" ::: "memory");
        f32x16 z[2];
#pragma unroll
        for (int rb = 0; rb < 2; ++rb) {
#pragma unroll
            for (int i = 0; i < 16; ++i) z[rb][i] = 0.f;
#pragma unroll
            for (int ks = 0; ks < 4; ++ks) z[rb] = MFMA32(kf[rb * 4 + ks], qf[ks], z[rb]);
        }
        if (jt > 0) {
#pragma unroll
            for (int i = 0; i < 8; ++i) __builtin_amdgcn_global_load_lds((const unsigned*)(vg + (size_t)(64 * (jt - 1) + 8 * i) * 1024), (LAS unsigned*)(vl + (cur ^ 1) * 8192 + i * 1024), 16, 0, 0);
#pragma unroll
            for (int i = 0; i < 8; ++i) kf[i] = *(const bf16x8*)(kg + (size_t)(64 * (jt - 1) + 32 * (i >> 2)) * 1024 + 16 * (i & 3));
        }
        const bool diag = (jt == jtop);
        float lsum = 0.f; f32x16 L[2];
#pragma unroll
        for (int rb = 0; rb < 2; ++rb)
#pragma unroll
            for (int i = 0; i < 16; ++i) {
                const float z2 = z[rb][i] * C2;
                const float e = __builtin_amdgcn_exp2f(-__builtin_fabsf(z2));
                L[rb][i] = -(__builtin_fmaxf(z2, 0.f) + __builtin_amdgcn_logf(1.0f + e));
                z[rb][i] = z2 + R2;
            }
        if (diag) {
#pragma unroll
            for (int rb = 0; rb < 2; ++rb)
#pragma unroll
                for (int i = 0; i < 16; ++i) { const int s = 64 * jt + 32 * rb + crow(i, hi); if (!(s < tq)) L[rb][i] = 0.f; }
        }
#pragma unroll
        for (int i = 0; i < 16; ++i) lsum += L[0][i] + L[1][i];
        bf16x8 Lp[4];
#pragma unroll
        for (int q = 0; q < 4; ++q) Lp[q] = pack_step(L[q >> 1], q & 1);
        f32x16 la0 = MFMA32(U0, Lp[0], z[0]); la0 = MFMA32(U1, Lp[1], la0); la0 = MFMA32(ONES, Lp[2], la0); la0 = MFMA32(ONES, Lp[3], la0);
        f32x16 la1 = MFMA32(U0, Lp[2], z[1]); la1 = MFMA32(U1, Lp[3], la1);
#pragma unroll
        for (int i = 0; i < 16; ++i) { la0[i] = __builtin_amdgcn_exp2f(la0[i]); la1[i] = __builtin_amdgcn_exp2f(la1[i]); }
        if (diag) {
#pragma unroll
            for (int i = 0; i < 16; ++i) { const int s = 64 * jt + crow(i, hi); if (!(s < tq)) la0[i] = 0.f; if (!(s + 32 < tq)) la1[i] = 0.f; }
        }
        bf16x8 Ap[4]; Ap[0] = pack_step(la0, 0); Ap[1] = pack_step(la0, 1); Ap[2] = pack_step(la1, 0); Ap[3] = pack_step(la1, 1);
        const LAS unsigned char* vb = vl + cur * 8192 + vro;
#pragma unroll
        for (int q = 0; q < 4; ++q) {
#pragma unroll
            for (int db = 0; db < 2; ++db) {
                const LAS unsigned char* ap = (const LAS unsigned char*)((unsigned)(size_t)(vb + 2048 * q) ^ (unsigned)(64 * db));
                const s16x4 lo = tr_read(ap), hi4 = tr_read(ap + 1024);
                const bf16x8 va = __builtin_shufflevector(lo, hi4, 0, 1, 2, 3, 4, 5, 6, 7);
                if (db == 0) o0 = MFMA32(va, Ap[q], o0); else o1 = MFMA32(va, Ap[q], o1);
            }
        }
        R2 += lsum + __shfl_xor(lsum, 32);
        if (__all(R2 < -160.0f)) break;
    }
    asm volatile("s_waitcnt vmcnt(0)" ::: "memory");
    bf16* op = O + (rowbase + tq) * 1024 + h * 64 + 4 * hi;
#pragma unroll
    for (int g = 0; g < 4; ++g) {
        u32x2 w0, w1; w0.x = pk2(o0[4 * g], o0[4 * g + 1]); w0.y = pk2(o0[4 * g + 2], o0[4 * g + 3]); w1.x = pk2(o1[4 * g], o1[4 * g + 1]); w1.y = pk2(o1[4 * g + 2], o1[4 * g + 3]);
        *(u32x2*)(op + 8 * g) = w0; *(u32x2*)(op + 32 + 8 * g) = w1;
    }
}

constexpr int RT_P = 272;
constexpr int RT_TILE = 128 * RT_P, RT_Q = 0, RT_K = RT_TILE, RT_V = 2 * RT_TILE, RT_PS = 3 * RT_TILE, RT_SS = 4 * RT_TILE;
#define RT_STAGE(dh_, withv_) do { \
    const int row_ = tid >> 4, chunk_ = tid & 15; \
    const bf16* qg_ = RQ + (rowbase + c0 + row_) * 1024 + hh * 256 + (dh_) * 128 + chunk_ * 8; \
    const bf16* kg_ = RK + (rowbase + c0 + row_) * 1024 + hh * 256 + (dh_) * 128 + chunk_ * 8; \
    const ldsp lq_ = lds + row_ * RT_P + chunk_ * 16; \
    _Pragma("unroll") for (int i_ = 0; i_ < 4; ++i_) *(LAS u32x4*)(lq_ + RT_Q + i_ * 32 * RT_P) = *(const u32x4*)(qg_ + (size_t)i_ * 32 * 1024); \
    __builtin_amdgcn_sched_barrier(0); \
    _Pragma("unroll") for (int i_ = 0; i_ < 4; ++i_) *(LAS u32x4*)(lq_ + RT_K + i_ * 32 * RT_P) = *(const u32x4*)(kg_ + (size_t)i_ * 32 * 1024); \
    __builtin_amdgcn_sched_barrier(0); \
    if (withv_) { const bf16* vg_ = RV + (rowbase + c0 + row_) * 2048 + hh * 512 + es * 128 + chunk_ * 8; \
        _Pragma("unroll") for (int i_ = 0; i_ < 4; ++i_) *(LAS u32x4*)(lq_ + RT_V + i_ * 32 * RT_P) = *(const u32x4*)(vg_ + (size_t)i_ * 32 * 2048); } \
    __builtin_amdgcn_sched_barrier(0); } while (0)
DI void retention_unit(ldsp lds, const bf16* RQ, const bf16* RK, bf16* RV, float* RS, int b, int hh, int es, int dry = 0) {
    const int tid = threadIdx.x, lane = tid & 63, w = __builtin_amdgcn_readfirstlane(tid >> 6), i16 = lane & 15, g = lane >> 4, qq = i16 >> 2, pp = i16 & 3;
    const size_t rowbase = (size_t)b * S_;
    const float g128 = exp2f(128.0f * __log2f(1.0f - exp2f(-5.0f - (float)hh)));
    f32x4 Tst[16];
#pragma unroll
    for (int i = 0; i < 16; ++i) Tst[i] = (f32x4){0.f, 0.f, 0.f, 0.f};
    for (int ch = 0; ch < 16; ++ch) {
        const int c0 = ch * 128;
        {
            f32x4 sc[8];
#pragma unroll
            for (int i = 0; i < 8; ++i) sc[i] = (f32x4){0.f, 0.f, 0.f, 0.f};
#pragma unroll
            for (int dh = 0; dh < 2; ++dh) {
                __syncthreads();
                RT_STAGE(dh, false);
                __syncthreads();
#pragma unroll
                for (int kb = 0; kb < 4; ++kb) {
                    const bf16x8 bq = *(const LAS bf16x8*)(lds + RT_Q + (16 * w + i16) * RT_P + (32 * kb + 8 * g) * 2);
#pragma unroll
                    for (int mb = 0; mb < 8; ++mb) { const bf16x8 ak = *(const LAS bf16x8*)(lds + RT_K + (16 * mb + i16) * RT_P + (32 * kb + 8 * g) * 2); sc[mb] = MFMA16(ak, bq, sc[mb]); }
                    __builtin_amdgcn_sched_barrier(0);
                }
            }
            const int c = 16 * w + i16;
#pragma unroll
            for (int mb = 0; mb < 8; ++mb) {
                const int m0 = 16 * mb + 4 * g;
                const float v0 = (m0 <= c) ? sc[mb][0] : 0.f, v1 = (m0 + 1 <= c) ? sc[mb][1] : 0.f, v2 = (m0 + 2 <= c) ? sc[mb][2] : 0.f, v3 = (m0 + 3 <= c) ? sc[mb][3] : 0.f;
                u32x2 pw; pw.x = pk2(v0, v1); pw.y = pk2(v2, v3);
                *(LAS u32x2*)(lds + RT_PS + c * RT_P + m0 * 2) = pw;
            }
        }
        __builtin_amdgcn_sched_barrier(0);
        f32x4 cr[8]; bf16x8 vf[4];
#pragma unroll
        for (int i = 0; i < 8; ++i) cr[i] = (f32x4){0.f, 0.f, 0.f, 0.f};
#pragma unroll
        for (int dh = 0; dh < 2; ++dh) {
            __syncthreads();
            RT_STAGE(dh, dh == 0);
            __syncthreads();
            if (dh == 0) {
#pragma unroll
                for (int cbk = 0; cbk < 4; ++cbk) {
                    const LAS unsigned char* ap = lds + RT_V + (32 * cbk + 8 * g + qq) * RT_P + (16 * w + 4 * pp) * 2;
                    const s16x4 lo = tr_read(ap), hi4 = tr_read(ap + 4 * RT_P);
                    vf[cbk] = __builtin_shufflevector(lo, hi4, 0, 1, 2, 3, 4, 5, 6, 7);
                }
            }
#pragma unroll
            for (int kb = 0; kb < 4; ++kb) {
                const int kbg = 4 * dh + kb;
                u32x4 tp; tp.x = pk2(Tst[2 * kbg][0], Tst[2 * kbg][1]); tp.y = pk2(Tst[2 * kbg][2], Tst[2 * kbg][3]); tp.z = pk2(Tst[2 * kbg + 1][0], Tst[2 * kbg + 1][1]); tp.w = pk2(Tst[2 * kbg + 1][2], Tst[2 * kbg + 1][3]);
                const bf16x8 tb = __builtin_bit_cast(bf16x8, tp);
#pragma unroll
                for (int cb = 0; cb < 8; ++cb) {
                    const LAS unsigned char* qp = lds + RT_Q + (16 * cb + i16) * RT_P + (32 * kb + 4 * g) * 2;
                    const s16x4 lo = *(const LAS s16x4*)qp, hi4 = *(const LAS s16x4*)(qp + 32);
                    const bf16x8 aq = __builtin_shufflevector(lo, hi4, 0, 1, 2, 3, 4, 5, 6, 7);
                    cr[cb] = MFMA16(aq, tb, cr[cb]);
                }
                __builtin_amdgcn_sched_barrier(0);
            }
#pragma unroll
            for (int dtl = 0; dtl < 8; ++dtl) {
                const int dt = 8 * dh + dtl;
                Tst[dt] = Tst[dt] * g128;
#pragma unroll
                for (int cbk = 0; cbk < 4; ++cbk) {
                    const LAS unsigned char* ap = lds + RT_K + (32 * cbk + 8 * g + qq) * RT_P + (16 * dtl + 4 * pp) * 2;
                    const s16x4 lo = tr_read(ap), hi4 = tr_read(ap + 4 * RT_P);
                    const bf16x8 ak = __builtin_shufflevector(lo, hi4, 0, 1, 2, 3, 4, 5, 6, 7);
                    Tst[dt] = MFMA16(ak, vf[cbk], Tst[dt]);
                }
                __builtin_amdgcn_sched_barrier(0);
            }
        }
#pragma unroll
        for (int cb = 0; cb < 8; ++cb) cr[cb] = cr[cb] * g128;
#pragma unroll
        for (int cb = 0; cb < 8; ++cb)
#pragma unroll
            for (int mbk = 0; mbk < 4; ++mbk) if (32 * mbk <= 16 * cb + 15) {
                const bf16x8 ap = *(const LAS bf16x8*)(lds + RT_PS + (16 * cb + i16) * RT_P + (32 * mbk + 8 * g) * 2);
                cr[cb] = MFMA16(ap, vf[mbk], cr[cb]);
            }
        LAS float* ssq = (LAS float*)(lds + RT_SS);
#pragma unroll
        for (int cb = 0; cb < 8; ++cb)
#pragma unroll
            for (int j = 0; j < 4; ++j) {
                const int c = 16 * cb + 4 * g + j;
                const unsigned short ob = (unsigned short)(pk2(cr[cb][j], 0.f) & 0xffffu);
                if (!dry) RV[(rowbase + c0 + c) * 2048 + hh * 512 + es * 128 + 16 * w + i16] = ob;
                const float of = bf2f(ob); float s = of * of;
                s += __shfl_xor(s, 1); s += __shfl_xor(s, 2); s += __shfl_xor(s, 4); s += __shfl_xor(s, 8);
                if (i16 == 0) ssq[w * 128 + c] = s;
            }
        __syncthreads();
        if (tid < 128) { float s = 0.f;
#pragma unroll
            for (int ww = 0; ww < 8; ++ww) s += ssq[ww * 128 + tid];
            if (!dry) RS[(rowbase + c0 + tid) * 16 + hh * 4 + es] = s; }
    }
    __syncthreads();
}


constexpr int SC_P = 528;
DI void ret_scores_item(ldsp lds, const bf16* RQ, const bf16* RK, bf16* PG, int item) {
    const int tid = threadIdx.x, lane = tid & 63, w = __builtin_amdgcn_readfirstlane(tid >> 6), i16 = lane & 15, g = lane >> 4;
    const int ch = item & 15, hh = (item >> 4) & 3, b = item >> 6;
    const size_t grow0 = (size_t)b * S_ + ch * 128;
    __syncthreads();
#pragma unroll
    for (int t = 0; t < 2; ++t) {
        const bf16* src = (t ? RK : RQ) + grow0 * 1024 + hh * 256;
#pragma unroll
        for (int i = 0; i < 8; ++i) { const int idx = tid + 512 * i, row = idx >> 5, chunk = idx & 31;
            *(LAS u32x4*)(lds + t * (128 * SC_P) + row * SC_P + chunk * 16) = *(const u32x4*)(src + (size_t)row * 1024 + chunk * 8); }
        __builtin_amdgcn_sched_barrier(0);
    }
    __syncthreads();
    f32x4 sc[8];
#pragma unroll
    for (int i = 0; i < 8; ++i) sc[i] = (f32x4){0.f, 0.f, 0.f, 0.f};
#pragma unroll
    for (int kb = 0; kb < 8; ++kb) {
        const bf16x8 bq = *(const LAS bf16x8*)(lds + (16 * w + i16) * SC_P + (32 * kb + 8 * g) * 2);
#pragma unroll
        for (int mb = 0; mb < 8; ++mb) { const bf16x8 ak = *(const LAS bf16x8*)(lds + 128 * SC_P + (16 * mb + i16) * SC_P + (32 * kb + 8 * g) * 2); sc[mb] = MFMA16(ak, bq, sc[mb]); }
        __builtin_amdgcn_sched_barrier(0);
    }
    const int c = 16 * w + i16;
    bf16* prow = PG + (size_t)item * 16384 + c * 128;
#pragma unroll
    for (int mb = 0; mb < 8; ++mb) {
        const int m0 = 16 * mb + 4 * g;
        const float v0 = (m0 <= c) ? sc[mb][0] : 0.f, v1 = (m0 + 1 <= c) ? sc[mb][1] : 0.f, v2 = (m0 + 2 <= c) ? sc[mb][2] : 0.f, v3 = (m0 + 3 <= c) ? sc[mb][3] : 0.f;
        u32x2 pw; pw.x = pk2(v0, v1); pw.y = pk2(v2, v3);
        *(u32x2*)(prow + m0) = pw;
    }
}

constexpr int R2_RING = 0, R2_V = 65536, R2_P = 98304, R2_SS = 131072;
#define DMA16(gp, lp) __builtin_amdgcn_global_load_lds((const unsigned*)(gp), (LAS unsigned*)(lp), 16, 0, 0)
DI void retention_unit2(ldsp lds, const bf16* RQ, const bf16* RK, bf16* RV, const bf16* PG, float* RS, int b, int hh, int es) {
    const int tid = threadIdx.x, lane = tid & 63, w = __builtin_amdgcn_readfirstlane(tid >> 6), i16 = lane & 15, g = lane >> 4, qq = i16 >> 2, pp = i16 & 3;
    const size_t rowbase = (size_t)b * S_;
    const float g128 = exp2f(128.0f * __log2f(1.0f - exp2f(-5.0f - (float)hh)));
    const int r8 = lane >> 3;
    const int fq0 = (((r8 >> 1) & 1) << 1) | ((r8 >> 2) & 1);
    const unsigned char* qsrc = (const unsigned char*)(RQ + (rowbase + 16 * w) * 1024 + hh * 256);
    const unsigned char* ksrc = (const unsigned char*)(RK + (rowbase + 16 * w) * 1024 + hh * 256);
    const unsigned qc0 = (unsigned)(r8 * 1024 + ((lane & 7) ^ fq0) * 8) * 2u, qc1 = (unsigned)((r8 + 8) * 1024 + ((lane & 7) ^ (fq0 | 4)) * 8) * 2u;
    const int r4 = lane >> 4;
    const unsigned char* vsrc = (const unsigned char*)(RV + (rowbase + 16 * w) * 2048 + hh * 512 + es * 128);
    const unsigned char* psrc = (const unsigned char*)(PG + ((size_t)((b * 4 + hh) * 16) * 128 + 16 * w) * 128);
    unsigned voff[4], poff[4];
#pragma unroll
    for (int j = 0; j < 4; ++j) { const int row = 16 * w + 4 * j + r4; const int hs = 2 * ((row & 3) | (((row >> 3) & 1) << 2));
        voff[j] = (unsigned)((4 * j + r4) * 2048 + (((lane & 15) ^ hs) * 8)) * 2u; poff[j] = (unsigned)((4 * j + r4) * 128 + (((lane & 15) ^ (row & 15)) * 8)) * 2u; }
    const int fA0 = (((i16 >> 1) & 1) << 1) | ((i16 >> 2) & 1) | (((i16 >> 3) & 1) << 2);
    const int fT0 = (((qq >> 1) & 1) << 1) | ((g & 1) << 2);
    const int hV0 = 2 * (qq | ((g & 1) << 2));
    f32x4 Tst[16];
#pragma unroll
    for (int i = 0; i < 16; ++i) Tst[i] = (f32x4){0.f, 0.f, 0.f, 0.f};
    __syncthreads();
    {
        DMA16(qsrc + qc0, lds + R2_RING + (2 * w) * 1024); DMA16(qsrc + qc1, lds + R2_RING + (2 * w + 1) * 1024);
        DMA16(ksrc + qc0, lds + R2_RING + 16384 + (2 * w) * 1024); DMA16(ksrc + qc1, lds + R2_RING + 16384 + (2 * w + 1) * 1024);
#pragma unroll
        for (int j = 0; j < 4; ++j) DMA16(vsrc + voff[j], lds + R2_V + (4 * w + j) * 1024);
    }
    asm volatile("s_waitcnt vmcnt(0)" ::: "memory");
    __syncthreads();
    for (int ch = 0; ch < 16; ++ch) {
        const int c0 = ch * 128;
        f32x4 cr[8]; bf16x8 vf[4];
#pragma unroll
        for (int i = 0; i < 8; ++i) cr[i] = (f32x4){0.f, 0.f, 0.f, 0.f};
#pragma unroll
        for (int qd = 0; qd < 4; ++qd) {
            const int cur = qd & 1;
            int fA = fA0, fT = fT0, hV = hV0, lane_ = lane;
            asm volatile("" : "+v"(fA), "+v"(fT), "+v"(hV), "+v"(lane_));
            const int i16 = lane_ & 15, g = lane_ >> 4, qq = i16 >> 2, pp = i16 & 3;
            {
                const int nch = (qd == 3) ? ch + 1 : ch, nqd = (qd + 1) & 3;
                if (nch < 16) {
                    const size_t go = ((size_t)(nch * 128) * 1024 + nqd * 64) * 2;
                    const ldsp rb = lds + R2_RING + (cur ^ 1) * 32768;
                    DMA16(qsrc + go + qc0, rb + (2 * w) * 1024); DMA16(qsrc + go + qc1, rb + (2 * w + 1) * 1024);
                    DMA16(ksrc + go + qc0, rb + 16384 + (2 * w) * 1024); DMA16(ksrc + go + qc1, rb + 16384 + (2 * w + 1) * 1024);
                }
                if (qd == 0) {
#pragma unroll
                    for (int j = 0; j < 4; ++j) DMA16(psrc + (size_t)ch * 32768 + poff[j], lds + R2_P + (4 * w + j) * 1024);
                }
                if (qd == 1 && ch + 1 < 16) {
#pragma unroll
                    for (int j = 0; j < 4; ++j) DMA16(vsrc + (size_t)((ch + 1) * 128) * 4096 + voff[j], lds + R2_V + (4 * w + j) * 1024);
                }
            }
            const LAS unsigned char* Qb = lds + R2_RING + cur * 32768; const LAS unsigned char* Kb = Qb + 16384;
            if (qd == 0) {
#pragma unroll
                for (int cbk = 0; cbk < 4; ++cbk) {
                    const LAS unsigned char* ap = lds + R2_V + (32 * cbk + 8 * g + qq) * 256 + (((2 * w + (pp >> 1)) ^ hV) * 16) + 8 * (pp & 1);
                    const s16x4 lo = tr_read(ap), hi4 = tr_read(ap + 4 * 256);
                    vf[cbk] = __builtin_shufflevector(lo, hi4, 0, 1, 2, 3, 4, 5, 6, 7);
                }
            }
#pragma unroll
            for (int kb = 0; kb < 2; ++kb) {
                const int kbg = 2 * qd + kb;
                u32x4 tp; tp.x = pk2(Tst[2 * kbg][0], Tst[2 * kbg][1]); tp.y = pk2(Tst[2 * kbg][2], Tst[2 * kbg][3]); tp.z = pk2(Tst[2 * kbg + 1][0], Tst[2 * kbg + 1][1]); tp.w = pk2(Tst[2 * kbg + 1][2], Tst[2 * kbg + 1][3]);
                const bf16x8 tb = __builtin_bit_cast(bf16x8, tp);
                const int ol = (((4 * kb + (g >> 1)) ^ fA) * 16) + 8 * (g & 1), oh = (((4 * kb + (g >> 1) + 2) ^ fA) * 16) + 8 * (g & 1);
#pragma unroll
                for (int cb = 0; cb < 8; ++cb) {
                    const LAS unsigned char* qp = Qb + (16 * cb + i16) * 128;
                    const s16x4 lo = *(const LAS s16x4*)(qp + ol), hi4 = *(const LAS s16x4*)(qp + oh);
                    const bf16x8 aq = __builtin_shufflevector(lo, hi4, 0, 1, 2, 3, 4, 5, 6, 7);
                    cr[cb] = MFMA16(aq, tb, cr[cb]);
                }
                __builtin_amdgcn_sched_barrier(0);
            }
#pragma unroll
            for (int dtl = 0; dtl < 4; ++dtl) {
                const int dt = 4 * qd + dtl;
                Tst[dt] = Tst[dt] * g128;
                const int ot = (((2 * dtl + (pp >> 1)) ^ fT) * 16) + 8 * (pp & 1);
#pragma unroll
                for (int cbk = 0; cbk < 4; ++cbk) {
                    const LAS unsigned char* ap = Kb + (32 * cbk + 8 * g + qq) * 128;
                    const s16x4 lo = tr_read(ap + ot), hi4 = tr_read(ap + 4 * 128 + (ot ^ 16));
                    const bf16x8 ak = __builtin_shufflevector(lo, hi4, 0, 1, 2, 3, 4, 5, 6, 7);
                    Tst[dt] = MFMA16(ak, vf[cbk], Tst[dt]);
                }
                __builtin_amdgcn_sched_barrier(0);
            }
            asm volatile("s_waitcnt vmcnt(0)" ::: "memory");
            __syncthreads();
        }
#pragma unroll
        for (int cb = 0; cb < 8; ++cb) cr[cb] = cr[cb] * g128;
#pragma unroll
        for (int cb = 0; cb < 8; ++cb)
#pragma unroll
            for (int mbk = 0; mbk < 4; ++mbk) if (32 * mbk <= 16 * cb + 15) {
                const bf16x8 ap = *(const LAS bf16x8*)(lds + R2_P + (16 * cb + i16) * 256 + (((4 * mbk + g) ^ i16) * 16));
                cr[cb] = MFMA16(ap, vf[mbk], cr[cb]);
            }
        __syncthreads();
        {
            const ldsp ob = lds + R2_P + (16 * w + i16) * 2;
#pragma unroll
            for (int cb = 0; cb < 8; ++cb)
#pragma unroll
                for (int j = 0; j < 4; ++j) *(LAS unsigned short*)(ob + (16 * cb + 4 * g + j) * 256) = (unsigned short)(pk2(cr[cb][j], 0.f) & 0xffffu);
        }
        __syncthreads();
        {
            const int row = tid >> 2, seg = tid & 3;
            const LAS u32x4* src = (const LAS u32x4*)(lds + R2_P + row * 256 + seg * 64);
            u32x4* dst = (u32x4*)(RV + (rowbase + c0 + row) * 2048 + hh * 512 + es * 128 + seg * 32);
            float s = 0.f;
#pragma unroll
            for (int k = 0; k < 4; ++k) { const u32x4 v = src[k]; dst[k] = v; f32x4 fa, fb; unpack8(v, fa, fb);
                s += (fa[0] * fa[0] + fa[1] * fa[1]) + (fa[2] * fa[2] + fa[3] * fa[3]) + (fb[0] * fb[0] + fb[1] * fb[1]) + (fb[2] * fb[2] + fb[3] * fb[3]); }
            s += __shfl_xor(s, 1); s += __shfl_xor(s, 2);
            if (seg == 0) RS[(rowbase + c0 + row) * 16 + hh * 4 + es] = s;
        }
        __syncthreads();
    }
    __syncthreads();
}

#define GEMM_PHASE(EpiT, E, Aptr, Bptr, N_, K_) do { pg8::Gemm g_{(const pg8::bf16_t*)(Aptr), (const pg8::bf16_t*)(Bptr), T_, (N_), (K_)}; pg8::StaticOrder S_o; S_o.init(T_, (N_), G, (int)blockIdx.x); \
    pg8::gemm_phase<EpiT, pg8::StaticOrder, true, true>(lds, g_, S_o, (E)); } while (0)
#ifndef PH_LO
#define PH_LO 0
#endif
#ifndef PH_HI
#define PH_HI 99
#endif
typedef const __attribute__((address_space(4))) Args* kargp;
#if defined(__HIP_DEVICE_COMPILE__)
DI Args load_args() { kargp kp = (kargp)__builtin_amdgcn_kernarg_segment_ptr(); asm volatile("" : "+s"(kp)); Args a;
    a.x = kp->x; a.c = kp->c; a.w_ada = kp->w_ada; a.b_ada = kp->b_ada; a.g1 = kp->g1; a.w_in = kp->w_in; a.b_branch = kp->b_branch; a.w_sb = kp->w_sb; a.w_ret = kp->w_ret; a.w_out = kp->w_out;
    a.g2 = kp->g2; a.w_ffi = kp->w_ffi; a.w_ffo = kp->w_ffo; a.gf = kp->gf; a.out = kp->out; a.ws = kp->ws; return a; }
#else
DI Args load_args() { return Args{}; }
#endif
#define PHASE_ARGS const Args A = load_args(); unsigned char* const ws = A.ws; bf16* const hmix = (bf16*)A.out; (void)ws; (void)hmix
__global__ void __launch_bounds__(NTHR, 2) fwd_megakernel(Args Aunused) {
    extern __shared__ __attribute__((aligned(16))) unsigned char lds_raw[];
    ldsp lds = (ldsp)lds_raw;
    cg::grid_group grid = cg::this_grid();
    const int G = gridDim.x;
#ifndef PHM
#define PHM 0xFFFFF
#endif
    if (PHM & 1) { PHASE_ARGS; p0_prologue(A, lds, G); }
    grid.sync();
    if (PHM & 2) { PHASE_ARGS; norm_mod_phase<true>(A, lds, G, A.x, A.g1, hmix, 0); }
    grid.sync();
    if (PHM & 4) { PHASE_ARGS; EpiInProj E{(bf16*)(ws + WS_SBQ), (bf16*)(ws + WS_SBK), (bf16*)(ws + WS_SBV), (bf16*)(ws + WS_RQ), (bf16*)(ws + WS_RK), (bf16*)(ws + WS_RV), (const float*)(ws + WS_COS), (const float*)(ws + WS_SIN)};
      GEMM_PHASE(EpiInProj, E, hmix, ws + WS_WIN, 7168, 1024); }
    grid.sync();
    if (PHM & 8) { PHASE_ARGS; for (int it = blockIdx.x; it < 1024; it += G) ret_scores_item(lds, (const bf16*)(ws + WS_RQ), (const bf16*)(ws + WS_RK), (bf16*)((unsigned char*)A.out + 64 * MiB), it); }
    __syncthreads();
    if (PHM & 16) { PHASE_ARGS;
        const int wv = __builtin_amdgcn_readfirstlane(threadIdx.x >> 6);
        for (int u = blockIdx.x * NWAVES + wv; u < 16384; u += G * NWAVES)
            sb_attn_wave(lds + wv * 16384, (const bf16*)(ws + WS_SBQ), (const bf16*)(ws + WS_SBK), (const bf16*)(ws + WS_SBV), (bf16*)(ws + WS_SBQ), u >> 10, (u >> 6) & 15, u & 63);
    }
    grid.sync();
    if (PHM & 0x2000) { PHASE_ARGS; for (int u = blockIdx.x; u < 256; u += G) retention_unit2(lds, (const bf16*)(ws + WS_RQ), (const bf16*)(ws + WS_RK), (bf16*)(ws + WS_RV), (const bf16*)((unsigned char*)A.out + 64 * MiB), (float*)(ws + WS_RS), u >> 4, (u >> 2) & 3, u & 3); }
    grid.sync();
    if (PHM & 32) { PHASE_ARGS; EpiGates E{(bf16*)(ws + WS_RV), (bf16*)(ws + WS_GATES), (const float*)(ws + WS_RS), A.b_branch};
      GEMM_PHASE(EpiGates, E, hmix, ws + WS_WIN + (size_t)7168 * 1024 * 2, 4096, 1024); }
    grid.sync();
    if (PHM & 64) { PHASE_ARGS; EpiMerge<0> E{(const bf16*)(ws + WS_GATES), nullptr, (bf16*)(ws + WS_M1)};
      GEMM_PHASE(EpiMerge<0>, E, ws + WS_SBQ, ws + WS_WSB, 1024, 1024); }
    grid.sync();
    if (PHM & 128) { PHASE_ARGS; EpiMerge<1> E{(const bf16*)(ws + WS_GATES), (const bf16*)(ws + WS_M1), (bf16*)(ws + WS_MERGED)};
      GEMM_PHASE(EpiMerge<1>, E, ws + WS_RV, ws + WS_WRET, 1024, 2048); }
    grid.sync();
    if (PHM & 256) { PHASE_ARGS; EpiResid E{A.x, A.out, (const float*)(ws + WS_MODF) + 2048};
      GEMM_PHASE(EpiResid, E, ws + WS_MERGED, ws + WS_WOUT, 1024, 1024); }
    grid.sync();
    if (PHM & 512) { PHASE_ARGS; norm_mod_phase<false>(A, lds, G, A.out, A.g2, (bf16*)(ws + WS_HFFN), 3072); }
    grid.sync();
    if (PHM & 1024) { PHASE_ARGS; EpiSwiglu E{(bf16*)(ws + WS_H)};
      GEMM_PHASE(EpiSwiglu, E, ws + WS_HFFN, ws + WS_WFFI, 2 * DFF, 1024); }
    grid.sync();
    if (PHM & 2048) { PHASE_ARGS; EpiResid E{A.out, A.out, (const float*)(ws + WS_MODF) + 5120};
      GEMM_PHASE(EpiResid, E, ws + WS_H, ws + WS_WFFO, 1024, DFF); }
    grid.sync();
    if (PHM & 4096) { PHASE_ARGS; final_norm_phase(A, G); }
}

extern "C" void kernel_launch(void* const* d_in, const int* in_sizes, int n_in, void* d_out, int out_size, void* d_ws, size_t ws_size, hipStream_t stream) {
    static int grid = 0;
    if (grid == 0) {
        if (n_in != 14 || in_sizes[0] != T_ * D_ || out_size != T_ * D_ || ws_size < WS_END) { fprintf(stderr, "kernel_launch: unexpected shapes / ws %zu\n", ws_size); grid = -1; return; }
        int dev = 0, cus = 0, per_cu = 0;
        hipGetDevice(&dev); hipDeviceGetAttribute(&cus, hipDeviceAttributeMultiprocessorCount, dev);
        if (hipFuncSetAttribute((const void*)fwd_megakernel, hipFuncAttributeMaxDynamicSharedMemorySize, LDS_BYTES) != hipSuccess) { fprintf(stderr, "hipFuncSetAttribute failed\n"); grid = -1; return; }
        if (hipOccupancyMaxActiveBlocksPerMultiprocessor(&per_cu, (const void*)fwd_megakernel, NTHR, LDS_BYTES) != hipSuccess || per_cu < 1) { fprintf(stderr, "occupancy query: %d\n", per_cu); per_cu = 1; }
        (void)hipGetLastError();
        grid = cus * per_cu;
    }
    if (grid < 0) return;
    Args a{};
    a.x = (const float*)d_in[0]; a.c = (const float*)d_in[1]; a.w_ada = (const float*)d_in[2]; a.b_ada = (const float*)d_in[3]; a.g1 = (const float*)d_in[4];
    a.w_in = (const float*)d_in[5]; a.b_branch = (const float*)d_in[6]; a.w_sb = (const float*)d_in[7]; a.w_ret = (const float*)d_in[8]; a.w_out = (const float*)d_in[9];
    a.g2 = (const float*)d_in[10]; a.w_ffi = (const float*)d_in[11]; a.w_ffo = (const float*)d_in[12]; a.gf = (const float*)d_in[13];
    a.out = (float*)d_out; a.ws = (unsigned char*)d_ws;
    void* args[] = {&a};
    hipError_t e = hipLaunchCooperativeKernel((const void*)fwd_megakernel, dim3(grid), dim3(NTHR), args, LDS_BYTES, stream);
    if (e != hipSuccess) fprintf(stderr, "cooperative launch failed: %s (grid %d)\n", hipGetErrorString(e), grid);
}
```

```cpp
#include <hip/hip_runtime.h>
#include <hip/hip_cooperative_groups.h>
#include <cstdio>
#include <cstdint>
namespace cg = cooperative_groups;
namespace pg8 {
#define PG8_LAS __attribute__((address_space(3)))
typedef unsigned short bf16_t;
typedef short bf16x8 __attribute__((ext_vector_type(8)));
typedef float f32x4 __attribute__((ext_vector_type(4)));
typedef unsigned u32x4 __attribute__((ext_vector_type(4)));
constexpr int BM = 256, BK = 64, HALF = 128, HTB = HALF * BK * 2  , STAGE_BYTES = 8 * HTB, NXCD = 8, WGM = 8;

__host__ __device__ __forceinline__ int lds_byte(int r, int c) { const int st = (r >> 4) * 2 + (c >> 5), rr = r & 15, cc = c & 31, ob = rr * 64 + cc * 2; return st * 1024 + (ob ^ (((ob >> 9) & 1) << 5)); }
__host__ __device__ __forceinline__ void stage_rc(int b, int& R, int& C) { const int st = b / 1024, sb = b % 1024, swz = sb ^ (((sb >> 9) & 1) << 5); R = (st >> 1) * 16 + swz / 64; C = (st & 1) * 32 + (swz % 64) / 2; }
__host__ __device__ __forceinline__ int perm32(int rho) { const int n = rho >> 4, i = rho & 15; return 8 * (i >> 2) + 4 * n + (i & 3); }

struct Unit { int pm, pn; };
struct Gemm { const bf16_t* A; const bf16_t* Bt; int M, N, K; };

struct StaticOrder {
    int nM, nN, nwg, G, c;
    __host__ __device__ void init(int M, int N, int G_, int c_) { nM = M / BM; nN = N / BM; nwg = nM * nN; G = G_; c = c_; }
    __host__ __device__ bool next(int i, Unit& u) const {
        const long L = (long)i * G + c; if (L >= nwg) return false;
        int wgid = (int)L; { const int q = nwg / NXCD, r = nwg % NXCD, xcd = wgid % NXCD, off = wgid / NXCD; wgid = (xcd < r ? xcd * (q + 1) : r * (q + 1) + (xcd - r) * q) + off; }
        const int nig = WGM * nN, gid = wgid / nig, fm = gid * WGM, gsz = (nM - fm) < WGM ? (nM - fm) : WGM;
        u.pm = fm + ((wgid % nig) % gsz); u.pn = (wgid % nig) / gsz; return true;
    }
    __device__ __forceinline__ void a_ready(const Unit&) const {}
    __device__ __forceinline__ void done(const Unit&) const {}
};

__device__ __forceinline__ unsigned cvt_pk_bf16(float lo, float hi) { unsigned r; asm volatile("v_cvt_pk_bf16_f32 %0, %1, %2" : "=v"(r) : "v"(lo), "v"(hi)); return r; }
template <class Epi, class Sched, bool ALIGN_EPI = false, bool SP2 = false>
__device__ __forceinline__ void gemm_phase(PG8_LAS unsigned char* lds, const Gemm g, const Sched& S, const Epi& E) {
    int tid_ = threadIdx.x; asm volatile("" : "+v"(tid_));
    const int tid = tid_, wid = __builtin_amdgcn_readfirstlane(tid >> 6), lane = tid & 63, wr = wid >> 2, wc = wid & 3, fr = lane & 15, fq = lane >> 4;
    const int K = g.K, nt = K / BK;
    unsigned voffA[2], voffB[2];
#pragma unroll
    for (int i = 0; i < 2; ++i) { int R, C; stage_rc(tid * 16 + i * 8192, R, C); const int Rb = Epi::PERM ? ((R & ~31) + perm32(R & 31)) : R;
        voffA[i] = (unsigned)(R * K + C) * 2u; voffB[i] = (unsigned)(Rb * K + C) * 2u; }
    const size_t kstep = (size_t)(BK * 2);
    const size_t hstep = (size_t)HALF * K * 2;
    const size_t tstep = 2 * hstep;
    const unsigned ldsw = (unsigned)wid * 1024u;
    const int aoff = lds_byte(wr * 64 + fr, fq * 8), boff = lds_byte(wc * 32 + fr, fq * 8);
#define PG8_SA(b, h) (((b) * 2 + (h)) * HTB)
#define PG8_SB(b, h) ((4 + (b) * 2 + (h)) * HTB)
#define PG8_STAGE(bufoff, gbase, voff) do { _Pragma("unroll") for (int _i = 0; _i < 2; ++_i) \
        __builtin_amdgcn_global_load_lds((const unsigned*)((const char*)(gbase) + (voff)[_i]), (PG8_LAS unsigned*)(lds + (bufoff) + ldsw + _i * 8192), 16, 0, 0); } while (0)
#define PG8_LDA(dst, b, h) do { _Pragma("unroll") for (int m = 0; m < 4; ++m) _Pragma("unroll") for (int k = 0; k < 2; ++k) dst[m][k] = *(const PG8_LAS bf16x8*)(lds + PG8_SA(b, h) + aoff + m * 2048 + k * 1024); } while (0)
#define PG8_LDB(dst, b, h) do { _Pragma("unroll") for (int n = 0; n < 2; ++n) _Pragma("unroll") for (int k = 0; k < 2; ++k) dst[n][k] = *(const PG8_LAS bf16x8*)(lds + PG8_SB(b, h) + boff + n * 2048 + k * 1024); } while (0)
#define PG8_MMA(ai, bj, At, Bt) do { __builtin_amdgcn_s_setprio(1); _Pragma("unroll") for (int m = 0; m < 4; ++m) _Pragma("unroll") for (int n = 0; n < 2; ++n) _Pragma("unroll") for (int k = 0; k < 2; ++k) \
        acc[ai][bj][m][n] = __builtin_amdgcn_mfma_f32_16x16x32_bf16(Bt[n][k], At[m][k], acc[ai][bj][m][n], 0, 0, 0); __builtin_amdgcn_s_setprio(0); } while (0)
#define PG8_WAIT_V(n) asm volatile("s_waitcnt vmcnt(" #n ")" ::: "memory")
#define PG8_WAIT_L(n) asm volatile("s_waitcnt lgkmcnt(" #n ")" ::: "memory")
#define PG8_BAR __builtin_amdgcn_s_barrier()
#define PG8_SCHED __builtin_amdgcn_sched_barrier(0)
    Unit cur, nxt; int ui = 0;
    if (!S.next(0, cur)) return;
    f32x4 acc[2][2][4][2];
#pragma unroll
    for (int a = 0; a < 2; ++a)
#pragma unroll
        for (int b = 0; b < 2; ++b)
#pragma unroll
            for (int m = 0; m < 4; ++m)
#pragma unroll
                for (int n = 0; n < 2; ++n) acc[a][b][m][n] = (f32x4){0.f, 0.f, 0.f, 0.f};
    bf16x8 At[4][2], B0[2][2], B1[2][2];
    const char* cA = (const char*)g.A + (size_t)cur.pm * tstep; const char* cB = (const char*)g.Bt + (size_t)cur.pn * tstep;
    S.a_ready(cur);
    if constexpr (SP2) {
        PG8_STAGE(PG8_SB(0, 0), cB, voffB); PG8_STAGE(PG8_SB(0, 1), cB + hstep, voffB); PG8_STAGE(PG8_SA(0, 0), cA, voffA); PG8_STAGE(PG8_SA(0, 1), cA + hstep, voffA);
        if (wr == 1) PG8_BAR;
        PG8_WAIT_V(2); PG8_BAR;
        PG8_STAGE(PG8_SB(1, 0), cB + kstep, voffB); PG8_STAGE(PG8_SA(1, 0), cA + kstep, voffA); PG8_STAGE(PG8_SB(1, 1), cB + hstep + kstep, voffB);
        PG8_WAIT_V(6); PG8_BAR;
    } else {
        PG8_STAGE(PG8_SB(0, 0), cB, voffB); PG8_STAGE(PG8_SA(0, 0), cA, voffA); PG8_STAGE(PG8_SB(0, 1), cB + hstep, voffB); PG8_STAGE(PG8_SA(0, 1), cA + hstep, voffA);
        if (wr == 1) PG8_BAR;
        PG8_WAIT_V(4); PG8_BAR;
        PG8_STAGE(PG8_SB(1, 0), cB + kstep, voffB); PG8_STAGE(PG8_SA(1, 0), cA + kstep, voffA); PG8_STAGE(PG8_SB(1, 1), cB + hstep + kstep, voffB);
        PG8_WAIT_V(6); PG8_BAR;
    }
    for (;;) {
        const bool has_next = S.next(ui + 1, nxt);
        const char* nA = has_next ? (const char*)g.A + (size_t)nxt.pm * tstep : cA; const char* nB = has_next ? (const char*)g.Bt + (size_t)nxt.pn * tstep : cB;
        for (int t = 0; t < nt; t += 2) {
            const bool last = (t == nt - 2);
            const char* a1 = cA + (size_t)(t + 1) * kstep;
            const char* a2 = last ? nA : cA + (size_t)(t + 2) * kstep; const char* b2 = last ? nB : cB + (size_t)(t + 2) * kstep;
            const char* a3 = a2 + kstep; const char* b3 = b2 + kstep;
            if (last && has_next) S.a_ready(nxt);
            if constexpr (SP2) {
            PG8_LDB(B0, 0, 0); PG8_LDB(B1, 0, 1); PG8_SCHED; PG8_LDA(At, 0, 0); PG8_STAGE(PG8_SA(1, 1), a1 + hstep, voffA);
            PG8_WAIT_V(8); PG8_WAIT_L(0); PG8_BAR; PG8_MMA(0, 0, At, B0); PG8_MMA(0, 1, At, B1); PG8_BAR; PG8_SCHED;
            PG8_LDA(At, 0, 1); PG8_STAGE(PG8_SB(0, 0), b2, voffB); PG8_STAGE(PG8_SB(0, 1), b2 + hstep, voffB); PG8_STAGE(PG8_SA(0, 0), a2, voffA);
            PG8_WAIT_V(8); PG8_WAIT_L(0); PG8_BAR; PG8_MMA(1, 0, At, B0); PG8_MMA(1, 1, At, B1); PG8_BAR; PG8_SCHED;
            PG8_LDB(B0, 1, 0); PG8_LDB(B1, 1, 1); PG8_SCHED; PG8_LDA(At, 1, 0); PG8_STAGE(PG8_SA(0, 1), a2 + hstep, voffA);
            PG8_WAIT_V(8); PG8_WAIT_L(0); PG8_BAR; PG8_MMA(0, 0, At, B0); PG8_MMA(0, 1, At, B1); PG8_BAR; PG8_SCHED;
            PG8_LDA(At, 1, 1); PG8_STAGE(PG8_SB(1, 0), b3, voffB); PG8_STAGE(PG8_SB(1, 1), b3 + hstep, voffB); PG8_STAGE(PG8_SA(1, 0), a3, voffA);
            PG8_WAIT_V(8); PG8_WAIT_L(0); PG8_BAR; PG8_MMA(1, 0, At, B0); PG8_MMA(1, 1, At, B1); PG8_BAR; PG8_SCHED;
            } else {
            PG8_LDB(B0, 0, 0); PG8_SCHED; PG8_LDA(At, 0, 0); PG8_STAGE(PG8_SA(1, 1), a1 + hstep, voffA);
            PG8_WAIT_L(8); PG8_BAR; PG8_WAIT_L(0); PG8_MMA(0, 0, At, B0); PG8_BAR; PG8_SCHED;
            PG8_LDB(B1, 0, 1); PG8_STAGE(PG8_SB(0, 0), b2, voffB);
            PG8_BAR; PG8_WAIT_L(0); PG8_MMA(0, 1, At, B1); PG8_BAR;
            PG8_LDA(At, 0, 1); PG8_STAGE(PG8_SA(0, 0), a2, voffA);
            PG8_BAR; PG8_WAIT_L(0); PG8_MMA(1, 0, At, B0); PG8_BAR; PG8_SCHED;
            PG8_STAGE(PG8_SB(0, 1), b2 + hstep, voffB);
            PG8_WAIT_V(6); PG8_BAR; PG8_MMA(1, 1, At, B1); PG8_BAR;
            PG8_LDB(B0, 1, 0); PG8_SCHED; PG8_LDA(At, 1, 0); PG8_STAGE(PG8_SA(0, 1), a2 + hstep, voffA);
            PG8_WAIT_L(8); PG8_BAR; PG8_WAIT_L(0); PG8_MMA(0, 0, At, B0); PG8_BAR; PG8_SCHED;
            PG8_LDB(B1, 1, 1); PG8_STAGE(PG8_SB(1, 0), b3, voffB);
            PG8_BAR; PG8_WAIT_L(0); PG8_MMA(0, 1, At, B1); PG8_BAR;
            PG8_LDA(At, 1, 1); PG8_STAGE(PG8_SA(1, 0), a3, voffA);
            PG8_BAR; PG8_WAIT_L(0); PG8_MMA(1, 0, At, B0); PG8_BAR; PG8_SCHED;
            PG8_STAGE(PG8_SB(1, 1), b3 + hstep, voffB);
            PG8_WAIT_V(6); PG8_BAR; PG8_MMA(1, 1, At, B1); PG8_BAR;
            }
        }
        if constexpr (ALIGN_EPI) { if (wr == 0) PG8_BAR; }
        if constexpr (!Epi::AFTER_DRAIN) { E(acc, cur, wr, wc, fr, fq); S.done(cur); }
        if (!has_next) break;
#pragma unroll
        for (int a = 0; a < 2; ++a)
#pragma unroll
            for (int b = 0; b < 2; ++b)
#pragma unroll
                for (int m = 0; m < 4; ++m)
#pragma unroll
                    for (int n = 0; n < 2; ++n) acc[a][b][m][n] = (f32x4){0.f, 0.f, 0.f, 0.f};
        cur = nxt; cA = nA; cB = nB; ++ui;
        if constexpr (ALIGN_EPI) { if (wr == 1) PG8_BAR; }
    }
    PG8_WAIT_V(0);
    if constexpr (!ALIGN_EPI) { if (wr == 0) PG8_BAR; }
    PG8_BAR;
    if constexpr (Epi::AFTER_DRAIN) { E.fused(acc, cur, wr, wc, fr, fq, lds, wid, lane); S.done(cur); }
#undef PG8_SA
#undef PG8_SB
#undef PG8_STAGE
#undef PG8_LDA
#undef PG8_LDB
#undef PG8_MMA
#undef PG8_WAIT_V
#undef PG8_WAIT_L
#undef PG8_BAR
#undef PG8_SCHED
}
}

#define GAS __attribute__((address_space(1)))
#define LAS __attribute__((address_space(3)))
#define DI __device__ __forceinline__
typedef unsigned short bf16;
typedef unsigned u32x4 __attribute__((ext_vector_type(4)));
typedef unsigned u32x2 __attribute__((ext_vector_type(2)));
typedef float f32x4 __attribute__((ext_vector_type(4)));
typedef float f32x16 __attribute__((ext_vector_type(16)));
typedef short bf16x8 __attribute__((ext_vector_type(8)));
typedef short s16x4 __attribute__((ext_vector_type(4)));
typedef LAS unsigned char* ldsp;

constexpr int NWAVES = 8, NTHR = 512;
constexpr int T_ = 32768, D_ = 1024, S_ = 2048, NB = 16, DFF = 2816, INW = 11264, NMOD = 6144;
constexpr float EPS_ = 1e-6f;
constexpr size_t MiB = 1u << 20;
constexpr size_t WS_SBQ = 0, WS_SBK = 64 * MiB, WS_SBV = 128 * MiB, WS_RQ = 192 * MiB, WS_RK = 256 * MiB, WS_RV = 320 * MiB;
constexpr size_t WS_WIN = 448 * MiB, WS_WSB = 470 * MiB, WS_WRET = 472 * MiB, WS_WOUT = 476 * MiB, WS_WFFI = 478 * MiB, WS_WFFO = 489 * MiB;
constexpr size_t WS_CTR = 494 * MiB + 512 * 1024;
constexpr size_t WS_MODP = 495 * MiB, WS_MODF = 498 * MiB, WS_COS = 499 * MiB, WS_SIN = 500 * MiB, WS_RS = 501 * MiB, WS_END = 512 * MiB;
constexpr size_t WS_GATES = 64 * MiB, WS_M1 = 196 * MiB, WS_MERGED = 0, WS_HFFN = 0, WS_H = 64 * MiB;
constexpr int LDG = 2080, LDM1 = 1056;
constexpr int LDS_BYTES = 147456;

DI unsigned pk2(float lo, float hi) { return pg8::cvt_pk_bf16(lo, hi); }
DI float bf2f(unsigned short v) { return __uint_as_float((unsigned)v << 16); }
DI float bflo(unsigned w) { return __uint_as_float(w << 16); }
DI float bfhi(unsigned w) { return __uint_as_float(w & 0xffff0000u); }
DI float wave_sum(float v) {
#pragma unroll
    for (int o = 1; o < 64; o <<= 1) v += __shfl_xor(v, o);
    return v;
}
DI float fsigmoid(float v) { return 1.0f / (1.0f + __expf(-v)); }
DI u32x4 pack8(f32x4 a, f32x4 b) { u32x4 w; w.x = pk2(a[0], a[1]); w.y = pk2(a[2], a[3]); w.z = pk2(b[0], b[1]); w.w = pk2(b[2], b[3]); return w; }
DI void unpack8(u32x4 w, f32x4& a, f32x4& b) { a = (f32x4){bflo(w.x), bfhi(w.x), bflo(w.y), bfhi(w.y)}; b = (f32x4){bflo(w.z), bfhi(w.z), bflo(w.w), bfhi(w.w)}; }

struct Args {
    const float *x, *c, *w_ada, *b_ada, *g1, *w_in, *b_branch, *w_sb, *w_ret, *w_out, *g2, *w_ffi, *w_ffo, *gf;
    float* out; unsigned char* ws;
};

using pg8::Unit;
#define EPI_ARGS const f32x4 (&acc)[2][2][4][2], const Unit& u, int wr, int wc, int fr, int fq
struct EpiInProj {
    static constexpr bool PERM = true, AFTER_DRAIN = false;
    bf16 *sbq, *sbk, *sbv, *rq, *rk, *rv; const float *cosT, *sinT;
    DI void operator()(EPI_ARGS) const {
        const int pn = u.pn, row0 = u.pm * 256 + wr * 64 + fr, cw = wc * 32 + 8 * fq;
        if (pn < 12 || pn >= 20) {
            bf16* base; int ld = 1024, colt;
            if (pn < 4) { base = sbq; colt = pn * 256; } else if (pn < 8) { base = sbk; colt = (pn - 4) * 256; }
            else if (pn < 12) { base = sbv; colt = (pn - 8) * 256; } else { base = rv; ld = 2048; colt = (pn - 20) * 256; }
#pragma unroll
            for (int ai = 0; ai < 2; ++ai)
#pragma unroll
                for (int m = 0; m < 4; ++m) { bf16* rowp = base + (size_t)(row0 + ai * 128 + m * 16) * ld + colt + cw;
#pragma unroll
                    for (int bj = 0; bj < 2; ++bj) *(u32x4*)(rowp + bj * 128) = pack8(acc[ai][bj][m][0], acc[ai][bj][m][1]); }
        } else {
            const bool isk = pn >= 16; const int hh = isk ? pn - 16 : pn - 12; bf16* base = (isk ? rk : rq) + hh * 256 + cw;
            const float lg = __log2f(1.0f - exp2f(-5.0f - (float)hh));
            float fj[8];
#pragma unroll
            for (int e = 0; e < 8; ++e) fj[e] = exp2f(-(float)(cw + e) * (13.287712379549449f / 128.0f)) * 0.15915494309189535f;
#pragma unroll
            for (int ai = 0; ai < 2; ++ai)
#pragma unroll
                for (int m = 0; m < 4; ++m) {
                    const int row = row0 + ai * 128 + m * 16, pos = row & 2047, c = row & 127;
                    const float f = isk ? exp2f(-(float)c * lg) * 0.0625f : exp2f((float)c * lg);
                    bf16* rowp = base + (size_t)row * 1024;
                    f32x4 o1[2], o2[2];
#pragma unroll
                    for (int n = 0; n < 2; ++n) {
                        f32x4 cs, sn;
#pragma unroll
                        for (int e = 0; e < 4; ++e) { const float rev = __builtin_amdgcn_fractf((float)pos * fj[4 * n + e]); cs[e] = __builtin_amdgcn_cosf(rev) * f; sn[e] = __builtin_amdgcn_sinf(rev) * f; }
                        const f32x4 v1 = acc[ai][0][m][n], v2 = acc[ai][1][m][n];
                        o1[n] = v1 * cs - v2 * sn; o2[n] = v1 * sn + v2 * cs;
                    }
                    *(u32x4*)rowp = pack8(o1[0], o1[1]); *(u32x4*)(rowp + 128) = pack8(o2[0], o2[1]);
                }
        }
    }
};
struct EpiGates {
    static constexpr bool PERM = true, AFTER_DRAIN = false;
    bf16 *rv, *gates; const float *rs, *bb;
    DI void operator()(EPI_ARGS) const {
        const int pn = u.pn, row0 = u.pm * 256 + wr * 64 + fr, cw = wc * 32 + 8 * fq;
        if (pn < 8) {
            const int head = pn >> 1;
#pragma unroll
            for (int ai = 0; ai < 2; ++ai) {
                f32x4 q[4]; u32x4 ov[4][2];
#pragma unroll
                for (int m = 0; m < 4; ++m) { const int row = row0 + ai * 128 + m * 16; q[m] = *(const f32x4*)(rs + (size_t)row * 16 + head * 4);
#pragma unroll
                    for (int bj = 0; bj < 2; ++bj) ov[m][bj] = *(const u32x4*)(rv + (size_t)row * 2048 + pn * 256 + bj * 128 + cw); }
#pragma unroll
                for (int m = 0; m < 4; ++m) {
                    const int row = row0 + ai * 128 + m * 16;
                    const float rsv = rsqrtf(((q[m][0] + q[m][1]) + (q[m][2] + q[m][3])) * (1.0f / 512.0f) + EPS_);
#pragma unroll
                    for (int bj = 0; bj < 2; ++bj) {
                        f32x4 oa, ob; unpack8(ov[m][bj], oa, ob);
                        f32x4 ga = acc[ai][bj][m][0], gb = acc[ai][bj][m][1];
#pragma unroll
                        for (int e = 0; e < 4; ++e) { ga[e] = ga[e] * fsigmoid(ga[e]) * oa[e] * rsv; gb[e] = gb[e] * fsigmoid(gb[e]) * ob[e] * rsv; }
                        *(u32x4*)(rv + (size_t)row * 2048 + pn * 256 + bj * 128 + cw) = pack8(ga, gb);
                    }
                }
            }
        } else {
#pragma unroll
            for (int bj = 0; bj < 2; ++bj) {
                const int col = (pn - 8) * 256 + bj * 128 + cw;
                const f32x4 b0 = *(const f32x4*)(bb + col), b1 = *(const f32x4*)(bb + col + 4);
#pragma unroll
                for (int ai = 0; ai < 2; ++ai)
#pragma unroll
                    for (int m = 0; m < 4; ++m) {
                        const int row = row0 + ai * 128 + m * 16;
                        f32x4 ga = acc[ai][bj][m][0] + b0, gb = acc[ai][bj][m][1] + b1;
#pragma unroll
                        for (int e = 0; e < 4; ++e) { ga[e] = fsigmoid(ga[e]); gb[e] = fsigmoid(gb[e]); }
                        *(u32x4*)(gates + (size_t)row * LDG + col) = pack8(ga, gb);
                    }
            }
        }
    }
};
template <int MODE> struct EpiMerge {
    static constexpr bool PERM = true, AFTER_DRAIN = false;
    const bf16* gates; const bf16* m1; bf16* outp;
    DI void operator()(EPI_ARGS) const {
        const int row0 = u.pm * 256 + wr * 64 + fr, cw = wc * 32 + 8 * fq;
#pragma unroll
        for (int ai = 0; ai < 2; ++ai)
#pragma unroll
            for (int mp = 0; mp < 2; ++mp) {
                u32x4 gv[2][2], pv[2][2];
#pragma unroll
                for (int mm = 0; mm < 2; ++mm)
#pragma unroll
                    for (int bj = 0; bj < 2; ++bj) { const int row = row0 + ai * 128 + (2 * mp + mm) * 16, col = u.pn * 256 + bj * 128 + cw;
                        gv[mm][bj] = *(const u32x4*)(gates + (size_t)row * LDG + MODE * 1024 + col);
                        if (MODE == 1) pv[mm][bj] = *(const u32x4*)(m1 + (size_t)row * LDM1 + col); }
#pragma unroll
                for (int mm = 0; mm < 2; ++mm)
#pragma unroll
                    for (int bj = 0; bj < 2; ++bj) { const int m = 2 * mp + mm, row = row0 + ai * 128 + m * 16, col = u.pn * 256 + bj * 128 + cw;
                        f32x4 ga, gb; unpack8(gv[mm][bj], ga, gb);
                        f32x4 ra = ga * acc[ai][bj][m][0], rb = gb * acc[ai][bj][m][1];
                        if (MODE == 1) { f32x4 pa, pb; unpack8(pv[mm][bj], pa, pb); ra += pa; rb += pb; }
                        *(u32x4*)(outp + (size_t)row * (MODE == 0 ? LDM1 : 1024) + col) = pack8(ra, rb); }
            }
    }
};
struct EpiResid {
    static constexpr bool PERM = true, AFTER_DRAIN = false;
    const float* base; float* outp; const float* gate;
    DI void operator()(EPI_ARGS) const {
        const int row0 = u.pm * 256 + wr * 64 + fr, cw = wc * 32 + 8 * fq, b = u.pm >> 3;
        f32x4 gt[2][2];
#pragma unroll
        for (int bj = 0; bj < 2; ++bj) { const int col = u.pn * 256 + bj * 128 + cw; gt[bj][0] = *(const f32x4*)(gate + b * NMOD + col); gt[bj][1] = *(const f32x4*)(gate + b * NMOD + col + 4); }
#pragma unroll
        for (int ai = 0; ai < 2; ++ai)
#pragma unroll
            for (int mp = 0; mp < 2; ++mp) {
                f32x4 xv[2][2][2];
#pragma unroll
                for (int mm = 0; mm < 2; ++mm)
#pragma unroll
                    for (int bj = 0; bj < 2; ++bj) { const size_t off = (size_t)(row0 + ai * 128 + (2 * mp + mm) * 16) * 1024 + u.pn * 256 + bj * 128 + cw;
                        xv[mm][bj][0] = *(const f32x4*)(base + off); xv[mm][bj][1] = *(const f32x4*)(base + off + 4); }
#pragma unroll
                for (int mm = 0; mm < 2; ++mm)
#pragma unroll
                    for (int bj = 0; bj < 2; ++bj) { const int m = 2 * mp + mm; const size_t off = (size_t)(row0 + ai * 128 + m * 16) * 1024 + u.pn * 256 + bj * 128 + cw;
                        *(f32x4*)(outp + off) = xv[mm][bj][0] + gt[bj][0] * acc[ai][bj][m][0]; *(f32x4*)(outp + off + 4) = xv[mm][bj][1] + gt[bj][1] * acc[ai][bj][m][1]; }
            }
    }
};
struct EpiSwiglu {
    static constexpr bool PERM = true, AFTER_DRAIN = false;
    bf16* H;
    DI void operator()(EPI_ARGS) const {
        const int row0 = u.pm * 256 + wr * 64 + fr, cw = wc * 32 + 8 * fq;
#pragma unroll
        for (int ai = 0; ai < 2; ++ai)
#pragma unroll
            for (int m = 0; m < 4; ++m) {
                f32x4 a0 = acc[ai][0][m][0], a1 = acc[ai][0][m][1]; const f32x4 u0 = acc[ai][1][m][0], u1 = acc[ai][1][m][1];
#pragma unroll
                for (int e = 0; e < 4; ++e) { a0[e] = a0[e] * fsigmoid(a0[e]) * u0[e]; a1[e] = a1[e] * fsigmoid(a1[e]) * u1[e]; }
                *(u32x4*)(H + (size_t)(row0 + ai * 128 + m * 16) * DFF + u.pn * 128 + cw) = pack8(a0, a1);
            }
    }
};

DI int ffi_row(int n) { return n < DFF ? 256 * (n >> 7) + (n & 127) : 256 * ((n - DFF) >> 7) + 128 + ((n - DFF) & 127); }
DI void transpose_item(const float* W, int K, int N, bf16* WT, int mode, LAS float* scr, int item, int lane) {
    const int nblk = N / 32, kb = item / nblk, nb = item % nblk, k0 = 64 * kb, n0 = 32 * nb;
    const int d0 = mode ? ffi_row(n0) : n0;
#pragma unroll 8
    for (int i = 0; i < 32; ++i) { const int kk = 2 * i + (lane >> 5); scr[kk * 33 + (lane & 31)] = W[(size_t)(k0 + kk) * N + n0 + (lane & 31)]; }
    asm volatile("s_waitcnt lgkmcnt(0)" ::: "memory");
    const int c = lane & 7;
#pragma unroll
    for (int j = 0; j < 4; ++j) { const int n = (lane >> 3) + 8 * j; const LAS float* s = scr + (8 * c) * 33 + n;
        u32x4 o; o.x = pk2(s[0 * 33], s[1 * 33]); o.y = pk2(s[2 * 33], s[3 * 33]); o.z = pk2(s[4 * 33], s[5 * 33]); o.w = pk2(s[6 * 33], s[7 * 33]);
        *(u32x4*)(WT + (size_t)(d0 + n) * K + k0 + 8 * c) = o; }
    asm volatile("s_waitcnt lgkmcnt(0)" ::: "memory");
}
DI void p0_prologue(const Args& A, ldsp lds, int G) {
    const int tid = threadIdx.x, lane = tid & 63, wave = tid >> 6;
    LAS float* scr = (LAS float*)(lds + wave * 16384);
    const int gw = blockIdx.x * NWAVES + wave, NGW = G * NWAVES;
    unsigned char* ws = A.ws;
    constexpr int I_IN = (D_ / 64) * (INW / 32), I_SB = 16 * 32, I_RET = 32 * 32, I_OUT = 16 * 32, I_FFI = 16 * (2 * DFF / 32), I_FFO = (DFF / 64) * 32;
    constexpr int I_MOD = 96 * 8, I_ROPE = 2048 * 128 / 64;
    constexpr int NIT = I_IN + I_SB + I_RET + I_OUT + I_FFI + I_FFO + I_MOD + I_ROPE;
    for (int it = gw; it < NIT; it += NGW) {
        int r = it;
        if (r < I_IN) { transpose_item(A.w_in, D_, INW, (bf16*)(ws + WS_WIN), 0, scr, r, lane); continue; } r -= I_IN;
        if (r < I_SB) { transpose_item(A.w_sb, 1024, 1024, (bf16*)(ws + WS_WSB), 0, scr, r, lane); continue; } r -= I_SB;
        if (r < I_RET) { transpose_item(A.w_ret, 2048, 1024, (bf16*)(ws + WS_WRET), 0, scr, r, lane); continue; } r -= I_RET;
        if (r < I_OUT) { transpose_item(A.w_out, 1024, 1024, (bf16*)(ws + WS_WOUT), 0, scr, r, lane); continue; } r -= I_OUT;
        if (r < I_FFI) { transpose_item(A.w_ffi, 1024, 2 * DFF, (bf16*)(ws + WS_WFFI), 1, scr, r, lane); continue; } r -= I_FFI;
        if (r < I_FFO) { transpose_item(A.w_ffo, DFF, 1024, (bf16*)(ws + WS_WFFO), 0, scr, r, lane); continue; } r -= I_FFO;
        if (r < I_MOD) {
            const int eb = r % 96, ks = r / 96, d0 = ks * 128, e = eb * 64 + lane;
#pragma unroll 4
            for (int i = 0; i < 32; ++i) { const int idx = i * 64 + lane, b = idx >> 7, dd = idx & 127; const float cv = A.c[b * 1024 + d0 + dd]; scr[idx] = cv * fsigmoid(cv); }
            asm volatile("s_waitcnt lgkmcnt(0)" ::: "memory");
            float a[16];
#pragma unroll
            for (int b = 0; b < 16; ++b) a[b] = 0.f;
            for (int dd = 0; dd < 128; ++dd) { const float w = A.w_ada[(size_t)(d0 + dd) * NMOD + e];
#pragma unroll
                for (int b = 0; b < 16; ++b) a[b] += scr[b * 128 + dd] * w; }
            float* mp = (float*)(ws + WS_MODP) + (size_t)ks * NB * NMOD + e;
#pragma unroll
            for (int b = 0; b < 16; ++b) mp[b * NMOD] = a[b];
            asm volatile("s_waitcnt lgkmcnt(0)" ::: "memory");
            continue;
        } r -= I_MOD;
        {
            const int idx = r * 64 + lane, pos = idx >> 7, j = idx & 127;
            const float inv = exp2f(-(float)j * (13.287712379549449f / 128.0f));
            const float ang = (float)pos * inv;
            const float n = rintf(ang * 0.15915494309189535f);
            float rr = __builtin_fmaf(-n, 6.28125f, ang); rr = __builtin_fmaf(-n, 0.0019353071795864769f, rr);
            ((float*)(ws + WS_COS))[idx] = cosf(rr); ((float*)(ws + WS_SIN))[idx] = sinf(rr);
        }
    }
}
template <bool FIRST> DI void norm_mod_phase(const Args& A, ldsp lds, int G, const float* src, const float* gw_, bf16* dst, int shift_off) {
    const int tid = threadIdx.x, lane = tid & 63, wave = tid >> 6;
    LAS float* modl = (LAS float*)lds;
    const float* modp = (const float*)(A.ws + WS_MODP); float* modf = (float*)(A.ws + WS_MODF);
    for (int rb = blockIdx.x; rb < 256; rb += G) {
        const int b = rb >> 4;
        __syncthreads();
        for (int i = tid; i < 2048; i += NTHR) {
            float v;
            if (FIRST) { const int e = i; v = A.b_ada[e]; for (int ks = 0; ks < 8; ++ks) v += modp[(size_t)ks * NB * NMOD + b * NMOD + e]; }
            else v = modf[b * NMOD + shift_off + i];
            modl[i] = v;
        }
        if (FIRST && tid < 384) { const int idx = rb * 384 + tid, e = idx % NMOD; float v = A.b_ada[e]; for (int ks = 0; ks < 8; ++ks) v += modp[(size_t)ks * NB * NMOD + idx]; modf[idx] = v; }
        __syncthreads();
        for (int rr = 0; rr < 16; ++rr) {
            const int row = rb * 128 + wave * 16 + rr;
            const f32x4* xr = (const f32x4*)(src + (size_t)row * 1024) + lane;
            f32x4 v[4]; float s = 0.f;
#pragma unroll
            for (int j = 0; j < 4; ++j) { v[j] = xr[64 * j]; s += (v[j][0] * v[j][0] + v[j][1] * v[j][1]) + (v[j][2] * v[j][2] + v[j][3] * v[j][3]); }
            const float rstd = rsqrtf(wave_sum(s) * (1.0f / 1024.0f) + EPS_);
            unsigned long long* o8 = (unsigned long long*)(dst + (size_t)row * 1024) + lane;
#pragma unroll
            for (int j = 0; j < 4; ++j) {
                const int col = 4 * lane + 256 * j;
                const f32x4 g = *(const f32x4*)(gw_ + col); const f32x4 sh = *(const LAS f32x4*)(modl + col), sc = *(const LAS f32x4*)(modl + 1024 + col);
                const f32x4 y = v[j] * rstd * g * (sc + 1.0f) + sh;
                o8[64 * j] = (unsigned long long)pk2(y[0], y[1]) | ((unsigned long long)pk2(y[2], y[3]) << 32);
            }
        }
    }
    __syncthreads();
}
DI void final_norm_phase(const Args& A, int G) {
    const int tid = threadIdx.x, lane = tid & 63, wave = tid >> 6;
    const int gw = blockIdx.x * NWAVES + wave, NGW = G * NWAVES;
    for (int row = gw; row < T_; row += NGW) {
        f32x4* xr = (f32x4*)(A.out + (size_t)row * 1024) + lane;
        f32x4 v[4]; float s = 0.f;
#pragma unroll
        for (int j = 0; j < 4; ++j) { v[j] = xr[64 * j]; s += (v[j][0] * v[j][0] + v[j][1] * v[j][1]) + (v[j][2] * v[j][2] + v[j][3] * v[j][3]); }
        const float rstd = rsqrtf(wave_sum(s) * (1.0f / 1024.0f) + EPS_);
#pragma unroll
        for (int j = 0; j < 4; ++j) { const f32x4 g = *(const f32x4*)(A.gf + 4 * lane + 256 * j); xr[64 * j] = v[j] * rstd * g; }
    }
}

typedef short v4i16_t __attribute__((ext_vector_type(4)));
DI s16x4 tr_read(const LAS unsigned char* p) { return __builtin_bit_cast(s16x4, __builtin_amdgcn_ds_read_tr16_b64_v4i16((LAS v4i16_t*)p)); }
#define MFMA32(a, b, c) __builtin_amdgcn_mfma_f32_32x32x16_bf16((a), (b), (c), 0, 0, 0)
#define MFMA16(a, b, c) __builtin_amdgcn_mfma_f32_16x16x32_bf16((a), (b), (c), 0, 0, 0)
DI int crow(int r, int hi) { return (r & 3) + 8 * (r >> 2) + 4 * hi; }
DI bf16x8 pack_step(const f32x16& x, int s) {
    u32x4 p; p.x = pk2(x[8 * s], x[8 * s + 1]); p.y = pk2(x[8 * s + 2], x[8 * s + 3]); p.z = pk2(x[8 * s + 4], x[8 * s + 5]); p.w = pk2(x[8 * s + 6], x[8 * s + 7]);
    return __builtin_bit_cast(bf16x8, p);
}
constexpr int SB_PK = 144, SB_PV = 192;
constexpr int SB_KBYTES = 64 * SB_PK, SB_VBYTES = 64 * SB_PV, SB_BUF = SB_KBYTES + SB_VBYTES;
DI void sb_attn_unit(ldsp lds, const bf16* Q, const bf16* K, const bf16* V, bf16* O, int b, int h, int qb, int dry = 0) {
    const int tid = threadIdx.x, lane = tid & 63, wave = __builtin_amdgcn_readfirstlane(tid >> 6), r32 = lane & 31, hi = lane >> 5;
    const int t0 = qb * 256 + wave * 32, tq = t0 + r32;
    const size_t rowbase = (size_t)b * S_;
    bf16x8 qf[4];
#pragma unroll
    for (int ks = 0; ks < 4; ++ks) qf[ks] = *(const bf16x8*)(Q + (rowbase + tq) * 1024 + h * 64 + 16 * ks + 8 * hi);
    bf16x8 U0, U1, ONES;
#pragma unroll
    for (int jj = 0; jj < 8; ++jj) { const int k0 = 8 * (jj >> 2) + 4 * hi + (jj & 3); U0[jj] = (k0 >= r32) ? (short)0x3F80 : (short)0; U1[jj] = (16 + k0 >= r32) ? (short)0x3F80 : (short)0; ONES[jj] = (short)0x3F80; }
    f32x16 o0, o1;
#pragma unroll
    for (int i = 0; i < 16; ++i) { o0[i] = 0.f; o1[i] = 0.f; }
    float R2 = 0.f;
    const int ntiles = qb * 4 + 4;
    const int srow = tid >> 3, schunk = tid & 7;
    const bf16* kg = K + (rowbase + srow) * 1024 + h * 64 + schunk * 8; const bf16* vg = V + (rowbase + srow) * 1024 + h * 64 + schunk * 8;
    const int kso = srow * SB_PK + schunk * 16, vso = SB_KBYTES + srow * SB_PV + schunk * 16;
    LAS unsigned* doneF = (LAS unsigned*)(lds + 2 * SB_BUF);
    bool wdone = false;
    __syncthreads();
    { const int jt = ntiles - 1; const u32x4 kr = *(const u32x4*)(kg + (size_t)jt * 64 * 1024), vr = *(const u32x4*)(vg + (size_t)jt * 64 * 1024);
      *(LAS u32x4*)(lds + kso) = kr; *(LAS u32x4*)(lds + vso) = vr; }
    __syncthreads();
    const float C2 = 0.125f * 1.4426950408889634f;
    const int i16 = lane & 15, blk = (lane >> 4) & 1, qq = i16 >> 2, pp = i16 & 3;
    for (int jt = ntiles - 1; jt >= 0; --jt) {
        const int cur = (ntiles - 1 - jt) & 1;
        u32x4 kr, vr;
        if (jt > 0) { kr = *(const u32x4*)(kg + (size_t)(jt - 1) * 64 * 1024); vr = *(const u32x4*)(vg + (size_t)(jt - 1) * 64 * 1024); }
        if (!wdone && 64 * jt < t0 + 31) {
            const LAS unsigned char* Kb = lds + cur * SB_BUF; const LAS unsigned char* Vb = Kb + SB_KBYTES;
            const bool diag = (64 * jt + 63 >= t0);
            f32x16 z[2];
#pragma unroll
            for (int rb = 0; rb < 2; ++rb) {
#pragma unroll
                for (int i = 0; i < 16; ++i) z[rb][i] = 0.f;
#pragma unroll
                for (int ks = 0; ks < 4; ++ks) { const bf16x8 a = *(const LAS bf16x8*)(Kb + (32 * rb + r32) * SB_PK + (16 * ks + 8 * hi) * 2); z[rb] = MFMA32(a, qf[ks], z[rb]); }
            }
            float lsum = 0.f; f32x16 L[2];
#pragma unroll
            for (int rb = 0; rb < 2; ++rb)
#pragma unroll
                for (int i = 0; i < 16; ++i) {
                    const float z2 = z[rb][i] * C2;
                    const float e = __builtin_amdgcn_exp2f(-__builtin_fabsf(z2));
                    float l = -(__builtin_fmaxf(z2, 0.f) + __builtin_amdgcn_logf(1.0f + e));
                    if (diag) { const int s = 64 * jt + 32 * rb + crow(i, hi); if (!(s < tq)) l = 0.f; }
                    L[rb][i] = l; lsum += l; z[rb][i] = z2 + R2;
                }
            bf16x8 Lp[4];
#pragma unroll
            for (int q = 0; q < 4; ++q) Lp[q] = pack_step(L[q >> 1], q & 1);
            f32x16 la0 = MFMA32(U0, Lp[0], z[0]); la0 = MFMA32(U1, Lp[1], la0); la0 = MFMA32(ONES, Lp[2], la0); la0 = MFMA32(ONES, Lp[3], la0);
            f32x16 la1 = MFMA32(U0, Lp[2], z[1]); la1 = MFMA32(U1, Lp[3], la1);
#pragma unroll
            for (int i = 0; i < 16; ++i) {
                float a0 = __builtin_amdgcn_exp2f(la0[i]), a1 = __builtin_amdgcn_exp2f(la1[i]);
                if (diag) { const int s = 64 * jt + crow(i, hi); if (!(s < tq)) a0 = 0.f; if (!(s + 32 < tq)) a1 = 0.f; }
                la0[i] = a0; la1[i] = a1;
            }
            bf16x8 Ap[4]; Ap[0] = pack_step(la0, 0); Ap[1] = pack_step(la0, 1); Ap[2] = pack_step(la1, 0); Ap[3] = pack_step(la1, 1);
#pragma unroll
            for (int q = 0; q < 4; ++q) {
                const int key0 = 16 * q + 4 * hi;
#pragma unroll
                for (int db = 0; db < 2; ++db) {
                    const LAS unsigned char* ap = Vb + (key0 + qq) * SB_PV + (32 * db + 16 * blk + 4 * pp) * 2;
                    const s16x4 lo = tr_read(ap), hi4 = tr_read(ap + 8 * SB_PV);
                    const bf16x8 va = __builtin_shufflevector(lo, hi4, 0, 1, 2, 3, 4, 5, 6, 7);
                    if (db == 0) o0 = MFMA32(va, Ap[q], o0); else o1 = MFMA32(va, Ap[q], o1);
                }
            }
            R2 += lsum + __shfl_xor(lsum, 32);
            wdone = __all(R2 < -160.0f);
        }
        if (lane == 0) doneF[(jt & 1) * 8 + wave] = wdone ? 1u : 0u;
        if (jt > 0) { *(LAS u32x4*)(lds + (cur ^ 1) * SB_BUF + kso) = kr; *(LAS u32x4*)(lds + (cur ^ 1) * SB_BUF + vso) = vr; }
        __syncthreads();
        { const LAS u32x4* df = (const LAS u32x4*)(doneF + (jt & 1) * 8); const u32x4 f0 = df[0], f1 = df[1];
          if ((f0.x & f0.y & f0.z & f0.w & f1.x & f1.y & f1.z & f1.w) != 0u) break; }
    }
    bf16* op = O + (rowbase + tq) * 1024 + h * 64 + 4 * hi;
#pragma unroll
    for (int g = 0; g < 4; ++g) {
        u32x2 w0, w1; w0.x = pk2(o0[4 * g], o0[4 * g + 1]); w0.y = pk2(o0[4 * g + 2], o0[4 * g + 3]); w1.x = pk2(o1[4 * g], o1[4 * g + 1]); w1.y = pk2(o1[4 * g + 2], o1[4 * g + 3]);
        if (!dry) { *(u32x2*)(op + 8 * g) = w0; *(u32x2*)(op + 32 + 8 * g) = w1; }
    }
}


DI void sb_attn_wave(ldsp vl  , const bf16* Q, const bf16* K, const bf16* V, bf16* O, int b, int h, int rg) {
    const int lane = threadIdx.x & 63, r32 = lane & 31, hi = lane >> 5;
    const int t0 = rg * 32, tq = t0 + r32;
    const size_t rowbase = (size_t)b * S_;
    bf16x8 qf[4];
#pragma unroll
    for (int ks = 0; ks < 4; ++ks) qf[ks] = *(const bf16x8*)(Q + (rowbase + tq) * 1024 + h * 64 + 16 * ks + 8 * hi);
    bf16x8 U0, U1, ONES;
#pragma unroll
    for (int jj = 0; jj < 8; ++jj) { const int k0 = 8 * (jj >> 2) + 4 * hi + (jj & 3); U0[jj] = (k0 >= r32) ? (short)0x3F80 : (short)0; U1[jj] = (16 + k0 >= r32) ? (short)0x3F80 : (short)0; ONES[jj] = (short)0x3F80; }
    f32x16 o0, o1;
#pragma unroll
    for (int i = 0; i < 16; ++i) { o0[i] = 0.f; o1[i] = 0.f; }
    float R2 = 0.f;
    const int jtop = (t0 + 30) >> 6;
    const bf16* kg = K + (rowbase + r32) * 1024 + h * 64 + 8 * hi;
    const bf16* vg = V + (rowbase + (lane >> 3)) * 1024 + h * 64 + (((lane & 7) ^ ((((lane >> 3) >> 1) & 1) << 2)) * 8);
    const int i16 = lane & 15, blk = (lane >> 4) & 1, qq = i16 >> 2, pp = i16 & 3;
    const int vro = (4 * hi + qq) * 128 + (((2 * blk + (pp >> 1)) ^ (((qq >> 1) & 1) << 2)) * 16) + 8 * (pp & 1);
    bf16x8 kf[8];
#pragma unroll
    for (int i = 0; i < 8; ++i) __builtin_amdgcn_global_load_lds((const unsigned*)(vg + (size_t)(64 * jtop + 8 * i) * 1024), (LAS unsigned*)(vl + i * 1024), 16, 0, 0);
#pragma unroll
    for (int i = 0; i < 8; ++i) kf[i] = *(const bf16x8*)(kg + (size_t)(64 * jtop + 32 * (i >> 2)) * 1024 + 16 * (i & 3));
    const float C2 = 0.125f * 1.4426950408889634f;
    for (int jt = jtop; jt >= 0; --jt) {
        const int cur = (jtop - jt) & 1;
        asm volatile("s_waitcnt vmcnt(0)" ::: "memory");
        f32x16 z[2];
#pragma unroll
        for (int rb = 0; rb < 2; ++rb) {
#pragma unroll
            for (int i = 0; i < 16; ++i) z[rb][i] = 0.f;
#pragma unroll
            for (int ks = 0; ks < 4; ++ks) z[rb] = MFMA32(kf[rb * 4 + ks], qf[ks], z[rb]);
        }
        if (jt > 0) {
#pragma unroll
            for (int i = 0; i < 8; ++i) __builtin_amdgcn_global_load_lds((const unsigned*)(vg + (size_t)(64 * (jt - 1) + 8 * i) * 1024), (LAS unsigned*)(vl + (cur ^ 1) * 8192 + i * 1024), 16, 0, 0);
#pragma unroll
            for (int i = 0; i < 8; ++i) kf[i] = *(const bf16x8*)(kg + (size_t)(64 * (jt - 1) + 32 * (i >> 2)) * 1024 + 16 * (i & 3));
        }
        const bool diag = (jt == jtop);
        float lsum = 0.f; f32x16 L[2];
#pragma unroll
        for (int rb = 0; rb < 2; ++rb)
#pragma unroll
            for (int i = 0; i < 16; ++i) {
                const float z2 = z[rb][i] * C2;
                const float e = __builtin_amdgcn_exp2f(-__builtin_fabsf(z2));
                L[rb][i] = -(__builtin_fmaxf(z2, 0.f) + __builtin_amdgcn_logf(1.0f + e));
                z[rb][i] = z2 + R2;
            }
        if (diag) {
#pragma unroll
            for (int rb = 0; rb < 2; ++rb)
#pragma unroll
                for (int i = 0; i < 16; ++i) { const int s = 64 * jt + 32 * rb + crow(i, hi); if (!(s < tq)) L[rb][i] = 0.f; }
        }
#pragma unroll
        for (int i = 0; i < 16; ++i) lsum += L[0][i] + L[1][i];
        bf16x8 Lp[4];
#pragma unroll
        for (int q = 0; q < 4; ++q) Lp[q] = pack_step(L[q >> 1], q & 1);
        f32x16 la0 = MFMA32(U0, Lp[0], z[0]); la0 = MFMA32(U1, Lp[1], la0); la0 = MFMA32(ONES, Lp[2], la0); la0 = MFMA32(ONES, Lp[3], la0);
        f32x16 la1 = MFMA32(U0, Lp[2], z[1]); la1 = MFMA32(U1, Lp[3], la1);
#pragma unroll
        for (int i = 0; i < 16; ++i) { la0[i] = __builtin_amdgcn_exp2f(la0[i]); la1[i] = __builtin_amdgcn_exp2f(la1[i]); }
        if (diag) {
#pragma unroll
            for (int i = 0; i < 16; ++i) { const int s = 64 * jt + crow(i, hi); if (!(s < tq)) la0[i] = 0.f; if (!(s + 32 < tq)) la1[i] = 0.f; }
        }
        bf16x8 Ap[4]; Ap[0] = pack_step(la0, 0); Ap[1] = pack_step(la0, 1); Ap[2] = pack_step(la1, 0); Ap[3] = pack_step(la1, 1);
        const LAS unsigned char* vb = vl + cur * 8192 + vro;
#pragma unroll
        for (int q = 0; q < 4; ++q) {
#pragma unroll
            for (int db = 0; db < 2; ++db) {
                const LAS unsigned char* ap = (const LAS unsigned char*)((unsigned)(size_t)(vb + 2048 * q) ^ (unsigned)(64 * db));
                const s16x4 lo = tr_read(ap), hi4 = tr_read(ap + 1024);
                const bf16x8 va = __builtin_shufflevector(lo, hi4, 0, 1, 2, 3, 4, 5, 6, 7);
                if (db == 0) o0 = MFMA32(va, Ap[q], o0); else o1 = MFMA32(va, Ap[q], o1);
            }
        }
        R2 += lsum + __shfl_xor(lsum, 32);
        if (__all(R2 < -152.0f)) break;
    }
    asm volatile("s_waitcnt vmcnt(0)" ::: "memory");
    bf16* op = O + (rowbase + tq) * 1024 + h * 64 + 4 * hi;
#pragma unroll
    for (int g = 0; g < 4; ++g) {
        u32x2 w0, w1; w0.x = pk2(o0[4 * g], o0[4 * g + 1]); w0.y = pk2(o0[4 * g + 2], o0[4 * g + 3]); w1.x = pk2(o1[4 * g], o1[4 * g + 1]); w1.y = pk2(o1[4 * g + 2], o1[4 * g + 3]);
        *(u32x2*)(op + 8 * g) = w0; *(u32x2*)(op + 32 + 8 * g) = w1;
    }
}

constexpr int RT_P = 272;
constexpr int RT_TILE = 128 * RT_P, RT_Q = 0, RT_K = RT_TILE, RT_V = 2 * RT_TILE, RT_PS = 3 * RT_TILE, RT_SS = 4 * RT_TILE;
#define RT_STAGE(dh_, withv_) do { \
    const int row_ = tid >> 4, chunk_ = tid & 15; \
    const bf16* qg_ = RQ + (rowbase + c0 + row_) * 1024 + hh * 256 + (dh_) * 128 + chunk_ * 8; \
    const bf16* kg_ = RK + (rowbase + c0 + row_) * 1024 + hh * 256 + (dh_) * 128 + chunk_ * 8; \
    const ldsp lq_ = lds + row_ * RT_P + chunk_ * 16; \
    _Pragma("unroll") for (int i_ = 0; i_ < 4; ++i_) *(LAS u32x4*)(lq_ + RT_Q + i_ * 32 * RT_P) = *(const u32x4*)(qg_ + (size_t)i_ * 32 * 1024); \
    __builtin_amdgcn_sched_barrier(0); \
    _Pragma("unroll") for (int i_ = 0; i_ < 4; ++i_) *(LAS u32x4*)(lq_ + RT_K + i_ * 32 * RT_P) = *(const u32x4*)(kg_ + (size_t)i_ * 32 * 1024); \
    __builtin_amdgcn_sched_barrier(0); \
    if (withv_) { const bf16* vg_ = RV + (rowbase + c0 + row_) * 2048 + hh * 512 + es * 128 + chunk_ * 8; \
        _Pragma("unroll") for (int i_ = 0; i_ < 4; ++i_) *(LAS u32x4*)(lq_ + RT_V + i_ * 32 * RT_P) = *(const u32x4*)(vg_ + (size_t)i_ * 32 * 2048); } \
    __builtin_amdgcn_sched_barrier(0); } while (0)
DI void retention_unit(ldsp lds, const bf16* RQ, const bf16* RK, bf16* RV, float* RS, int b, int hh, int es, int dry = 0) {
    const int tid = threadIdx.x, lane = tid & 63, w = __builtin_amdgcn_readfirstlane(tid >> 6), i16 = lane & 15, g = lane >> 4, qq = i16 >> 2, pp = i16 & 3;
    const size_t rowbase = (size_t)b * S_;
    const float g128 = exp2f(128.0f * __log2f(1.0f - exp2f(-5.0f - (float)hh)));
    f32x4 Tst[16];
#pragma unroll
    for (int i = 0; i < 16; ++i) Tst[i] = (f32x4){0.f, 0.f, 0.f, 0.f};
    for (int ch = 0; ch < 16; ++ch) {
        const int c0 = ch * 128;
        {
            f32x4 sc[8];
#pragma unroll
            for (int i = 0; i < 8; ++i) sc[i] = (f32x4){0.f, 0.f, 0.f, 0.f};
#pragma unroll
            for (int dh = 0; dh < 2; ++dh) {
                __syncthreads();
                RT_STAGE(dh, false);
                __syncthreads();
#pragma unroll
                for (int kb = 0; kb < 4; ++kb) {
                    const bf16x8 bq = *(const LAS bf16x8*)(lds + RT_Q + (16 * w + i16) * RT_P + (32 * kb + 8 * g) * 2);
#pragma unroll
                    for (int mb = 0; mb < 8; ++mb) { const bf16x8 ak = *(const LAS bf16x8*)(lds + RT_K + (16 * mb + i16) * RT_P + (32 * kb + 8 * g) * 2); sc[mb] = MFMA16(ak, bq, sc[mb]); }
                    __builtin_amdgcn_sched_barrier(0);
                }
            }
            const int c = 16 * w + i16;
#pragma unroll
            for (int mb = 0; mb < 8; ++mb) {
                const int m0 = 16 * mb + 4 * g;
                const float v0 = (m0 <= c) ? sc[mb][0] : 0.f, v1 = (m0 + 1 <= c) ? sc[mb][1] : 0.f, v2 = (m0 + 2 <= c) ? sc[mb][2] : 0.f, v3 = (m0 + 3 <= c) ? sc[mb][3] : 0.f;
                u32x2 pw; pw.x = pk2(v0, v1); pw.y = pk2(v2, v3);
                *(LAS u32x2*)(lds + RT_PS + c * RT_P + m0 * 2) = pw;
            }
        }
        __builtin_amdgcn_sched_barrier(0);
        f32x4 cr[8]; bf16x8 vf[4];
#pragma unroll
        for (int i = 0; i < 8; ++i) cr[i] = (f32x4){0.f, 0.f, 0.f, 0.f};
#pragma unroll
        for (int dh = 0; dh < 2; ++dh) {
            __syncthreads();
            RT_STAGE(dh, dh == 0);
            __syncthreads();
            if (dh == 0) {
#pragma unroll
                for (int cbk = 0; cbk < 4; ++cbk) {
                    const LAS unsigned char* ap = lds + RT_V + (32 * cbk + 8 * g + qq) * RT_P + (16 * w + 4 * pp) * 2;
                    const s16x4 lo = tr_read(ap), hi4 = tr_read(ap + 4 * RT_P);
                    vf[cbk] = __builtin_shufflevector(lo, hi4, 0, 1, 2, 3, 4, 5, 6, 7);
                }
            }
#pragma unroll
            for (int kb = 0; kb < 4; ++kb) {
                const int kbg = 4 * dh + kb;
                u32x4 tp; tp.x = pk2(Tst[2 * kbg][0], Tst[2 * kbg][1]); tp.y = pk2(Tst[2 * kbg][2], Tst[2 * kbg][3]); tp.z = pk2(Tst[2 * kbg + 1][0], Tst[2 * kbg + 1][1]); tp.w = pk2(Tst[2 * kbg + 1][2], Tst[2 * kbg + 1][3]);
                const bf16x8 tb = __builtin_bit_cast(bf16x8, tp);
#pragma unroll
                for (int cb = 0; cb < 8; ++cb) {
                    const LAS unsigned char* qp = lds + RT_Q + (16 * cb + i16) * RT_P + (32 * kb + 4 * g) * 2;
                    const s16x4 lo = *(const LAS s16x4*)qp, hi4 = *(const LAS s16x4*)(qp + 32);
                    const bf16x8 aq = __builtin_shufflevector(lo, hi4, 0, 1, 2, 3, 4, 5, 6, 7);
                    cr[cb] = MFMA16(aq, tb, cr[cb]);
                }
                __builtin_amdgcn_sched_barrier(0);
            }
#pragma unroll
            for (int dtl = 0; dtl < 8; ++dtl) {
                const int dt = 8 * dh + dtl;
                Tst[dt] = Tst[dt] * g128;
#pragma unroll
                for (int cbk = 0; cbk < 4; ++cbk) {
                    const LAS unsigned char* ap = lds + RT_K + (32 * cbk + 8 * g + qq) * RT_P + (16 * dtl + 4 * pp) * 2;
                    const s16x4 lo = tr_read(ap), hi4 = tr_read(ap + 4 * RT_P);
                    const bf16x8 ak = __builtin_shufflevector(lo, hi4, 0, 1, 2, 3, 4, 5, 6, 7);
                    Tst[dt] = MFMA16(ak, vf[cbk], Tst[dt]);
                }
                __builtin_amdgcn_sched_barrier(0);
            }
        }
#pragma unroll
        for (int cb = 0; cb < 8; ++cb) cr[cb] = cr[cb] * g128;
#pragma unroll
        for (int cb = 0; cb < 8; ++cb)
#pragma unroll
            for (int mbk = 0; mbk < 4; ++mbk) if (32 * mbk <= 16 * cb + 15) {
                const bf16x8 ap = *(const LAS bf16x8*)(lds + RT_PS + (16 * cb + i16) * RT_P + (32 * mbk + 8 * g) * 2);
                cr[cb] = MFMA16(ap, vf[mbk], cr[cb]);
            }
        LAS float* ssq = (LAS float*)(lds + RT_SS);
#pragma unroll
        for (int cb = 0; cb < 8; ++cb)
#pragma unroll
            for (int j = 0; j < 4; ++j) {
                const int c = 16 * cb + 4 * g + j;
                const unsigned short ob = (unsigned short)(pk2(cr[cb][j], 0.f) & 0xffffu);
                if (!dry) RV[(rowbase + c0 + c) * 2048 + hh * 512 + es * 128 + 16 * w + i16] = ob;
                const float of = bf2f(ob); float s = of * of;
                s += __shfl_xor(s, 1); s += __shfl_xor(s, 2); s += __shfl_xor(s, 4); s += __shfl_xor(s, 8);
                if (i16 == 0) ssq[w * 128 + c] = s;
            }
        __syncthreads();
        if (tid < 128) { float s = 0.f;
#pragma unroll
            for (int ww = 0; ww < 8; ++ww) s += ssq[ww * 128 + tid];
            if (!dry) RS[(rowbase + c0 + tid) * 16 + hh * 4 + es] = s; }
    }
    __syncthreads();
}


constexpr int SC_P = 528;
DI void ret_scores_item(ldsp lds, const bf16* RQ, const bf16* RK, bf16* PG, int item) {
    const int tid = threadIdx.x, lane = tid & 63, w = __builtin_amdgcn_readfirstlane(tid >> 6), i16 = lane & 15, g = lane >> 4;
    const int ch = item & 15, hh = (item >> 4) & 3, b = item >> 6;
    const size_t grow0 = (size_t)b * S_ + ch * 128;
    __syncthreads();
#pragma unroll
    for (int t = 0; t < 2; ++t) {
        const bf16* src = (t ? RK : RQ) + grow0 * 1024 + hh * 256;
#pragma unroll
        for (int i = 0; i < 8; ++i) { const int idx = tid + 512 * i, row = idx >> 5, chunk = idx & 31;
            *(LAS u32x4*)(lds + t * (128 * SC_P) + row * SC_P + chunk * 16) = *(const u32x4*)(src + (size_t)row * 1024 + chunk * 8); }
        __builtin_amdgcn_sched_barrier(0);
    }
    __syncthreads();
    f32x4 sc[8];
#pragma unroll
    for (int i = 0; i < 8; ++i) sc[i] = (f32x4){0.f, 0.f, 0.f, 0.f};
#pragma unroll
    for (int kb = 0; kb < 8; ++kb) {
        const bf16x8 bq = *(const LAS bf16x8*)(lds + (16 * w + i16) * SC_P + (32 * kb + 8 * g) * 2);
#pragma unroll
        for (int mb = 0; mb < 8; ++mb) { const bf16x8 ak = *(const LAS bf16x8*)(lds + 128 * SC_P + (16 * mb + i16) * SC_P + (32 * kb + 8 * g) * 2); sc[mb] = MFMA16(ak, bq, sc[mb]); }
        __builtin_amdgcn_sched_barrier(0);
    }
    const int c = 16 * w + i16;
    bf16* prow = PG + (size_t)item * 16384 + c * 128;
#pragma unroll
    for (int mb = 0; mb < 8; ++mb) {
        const int m0 = 16 * mb + 4 * g;
        const float v0 = (m0 <= c) ? sc[mb][0] : 0.f, v1 = (m0 + 1 <= c) ? sc[mb][1] : 0.f, v2 = (m0 + 2 <= c) ? sc[mb][2] : 0.f, v3 = (m0 + 3 <= c) ? sc[mb][3] : 0.f;
        u32x2 pw; pw.x = pk2(v0, v1); pw.y = pk2(v2, v3);
        *(u32x2*)(prow + m0) = pw;
    }
}

constexpr int R2_RING = 0, R2_V = 65536, R2_P = 98304, R2_SS = 131072;
#define DMA16(gp, lp) __builtin_amdgcn_global_load_lds((const unsigned*)(gp), (LAS unsigned*)(lp), 16, 0, 0)
DI void retention_unit2(ldsp lds, const bf16* RQ, const bf16* RK, bf16* RV, const bf16* PG, float* RS, int b, int hh, int es) {
    const int tid = threadIdx.x, lane = tid & 63, w = __builtin_amdgcn_readfirstlane(tid >> 6), i16 = lane & 15, g = lane >> 4, qq = i16 >> 2, pp = i16 & 3;
    const size_t rowbase = (size_t)b * S_;
    const float g128 = exp2f(128.0f * __log2f(1.0f - exp2f(-5.0f - (float)hh)));
    const int r8 = lane >> 3;
    const int fq0 = (((r8 >> 1) & 1) << 1) | ((r8 >> 2) & 1);
    const unsigned char* qsrc = (const unsigned char*)(RQ + (rowbase + 16 * w) * 1024 + hh * 256);
    const unsigned char* ksrc = (const unsigned char*)(RK + (rowbase + 16 * w) * 1024 + hh * 256);
    const unsigned qc0 = (unsigned)(r8 * 1024 + ((lane & 7) ^ fq0) * 8) * 2u, qc1 = (unsigned)((r8 + 8) * 1024 + ((lane & 7) ^ (fq0 | 4)) * 8) * 2u;
    const int r4 = lane >> 4;
    const unsigned char* vsrc = (const unsigned char*)(RV + (rowbase + 16 * w) * 2048 + hh * 512 + es * 128);
    const unsigned char* psrc = (const unsigned char*)(PG + ((size_t)((b * 4 + hh) * 16) * 128 + 16 * w) * 128);
    unsigned voff[4], poff[4];
#pragma unroll
    for (int j = 0; j < 4; ++j) { const int row = 16 * w + 4 * j + r4; const int hs = 2 * ((row & 3) | (((row >> 3) & 1) << 2));
        voff[j] = (unsigned)((4 * j + r4) * 2048 + (((lane & 15) ^ hs) * 8)) * 2u; poff[j] = (unsigned)((4 * j + r4) * 128 + (((lane & 15) ^ (row & 15)) * 8)) * 2u; }
    const int fA0 = (((i16 >> 1) & 1) << 1) | ((i16 >> 2) & 1) | (((i16 >> 3) & 1) << 2);
    const int fT0 = (((qq >> 1) & 1) << 1) | ((g & 1) << 2);
    const int hV0 = 2 * (qq | ((g & 1) << 2));
    f32x4 Tst[16];
#pragma unroll
    for (int i = 0; i < 16; ++i) Tst[i] = (f32x4){0.f, 0.f, 0.f, 0.f};
    __syncthreads();
    {
        DMA16(qsrc + qc0, lds + R2_RING + (2 * w) * 1024); DMA16(qsrc + qc1, lds + R2_RING + (2 * w + 1) * 1024);
        DMA16(ksrc + qc0, lds + R2_RING + 16384 + (2 * w) * 1024); DMA16(ksrc + qc1, lds + R2_RING + 16384 + (2 * w + 1) * 1024);
#pragma unroll
        for (int j = 0; j < 4; ++j) DMA16(vsrc + voff[j], lds + R2_V + (4 * w + j) * 1024);
    }
    asm volatile("s_waitcnt vmcnt(0)" ::: "memory");
    __syncthreads();
    for (int ch = 0; ch < 16; ++ch) {
        const int c0 = ch * 128;
        f32x4 cr[8]; bf16x8 vf[4];
#pragma unroll
        for (int i = 0; i < 8; ++i) cr[i] = (f32x4){0.f, 0.f, 0.f, 0.f};
#pragma unroll
        for (int qd = 0; qd < 4; ++qd) {
            const int cur = qd & 1;
            int fA = fA0, fT = fT0, hV = hV0, lane_ = lane;
            asm volatile("" : "+v"(fA), "+v"(fT), "+v"(hV), "+v"(lane_));
            const int i16 = lane_ & 15, g = lane_ >> 4, qq = i16 >> 2, pp = i16 & 3;
            {
                const int nch = (qd == 3) ? ch + 1 : ch, nqd = (qd + 1) & 3;
                if (nch < 16) {
                    const size_t go = ((size_t)(nch * 128) * 1024 + nqd * 64) * 2;
                    const ldsp rb = lds + R2_RING + (cur ^ 1) * 32768;
                    DMA16(qsrc + go + qc0, rb + (2 * w) * 1024); DMA16(qsrc + go + qc1, rb + (2 * w + 1) * 1024);
                    DMA16(ksrc + go + qc0, rb + 16384 + (2 * w) * 1024); DMA16(ksrc + go + qc1, rb + 16384 + (2 * w + 1) * 1024);
                }
                if (qd == 0) {
#pragma unroll
                    for (int j = 0; j < 4; ++j) DMA16(psrc + (size_t)ch * 32768 + poff[j], lds + R2_P + (4 * w + j) * 1024);
                }
                if (qd == 1 && ch + 1 < 16) {
#pragma unroll
                    for (int j = 0; j < 4; ++j) DMA16(vsrc + (size_t)((ch + 1) * 128) * 4096 + voff[j], lds + R2_V + (4 * w + j) * 1024);
                }
            }
            const LAS unsigned char* Qb = lds + R2_RING + cur * 32768; const LAS unsigned char* Kb = Qb + 16384;
            if (qd == 0) {
#pragma unroll
                for (int cbk = 0; cbk < 4; ++cbk) {
                    const LAS unsigned char* ap = lds + R2_V + (32 * cbk + 8 * g + qq) * 256 + (((2 * w + (pp >> 1)) ^ hV) * 16) + 8 * (pp & 1);
                    const s16x4 lo = tr_read(ap), hi4 = tr_read(ap + 4 * 256);
                    vf[cbk] = __builtin_shufflevector(lo, hi4, 0, 1, 2, 3, 4, 5, 6, 7);
                }
            }
#pragma unroll
            for (int kb = 0; kb < 2; ++kb) {
                const int kbg = 2 * qd + kb;
                u32x4 tp; tp.x = pk2(Tst[2 * kbg][0], Tst[2 * kbg][1]); tp.y = pk2(Tst[2 * kbg][2], Tst[2 * kbg][3]); tp.z = pk2(Tst[2 * kbg + 1][0], Tst[2 * kbg + 1][1]); tp.w = pk2(Tst[2 * kbg + 1][2], Tst[2 * kbg + 1][3]);
                const bf16x8 tb = __builtin_bit_cast(bf16x8, tp);
                const int ol = (((4 * kb + (g >> 1)) ^ fA) * 16) + 8 * (g & 1), oh = (((4 * kb + (g >> 1) + 2) ^ fA) * 16) + 8 * (g & 1);
#pragma unroll
                for (int cb = 0; cb < 8; ++cb) {
                    const LAS unsigned char* qp = Qb + (16 * cb + i16) * 128;
                    const s16x4 lo = *(const LAS s16x4*)(qp + ol), hi4 = *(const LAS s16x4*)(qp + oh);
                    const bf16x8 aq = __builtin_shufflevector(lo, hi4, 0, 1, 2, 3, 4, 5, 6, 7);
                    cr[cb] = MFMA16(aq, tb, cr[cb]);
                }
                __builtin_amdgcn_sched_barrier(0);
            }
#pragma unroll
            for (int dtl = 0; dtl < 4; ++dtl) {
                const int dt = 4 * qd + dtl;
                Tst[dt] = Tst[dt] * g128;
                const int ot = (((2 * dtl + (pp >> 1)) ^ fT) * 16) + 8 * (pp & 1);
#pragma unroll
                for (int cbk = 0; cbk < 4; ++cbk) {
                    const LAS unsigned char* ap = Kb + (32 * cbk + 8 * g + qq) * 128;
                    const s16x4 lo = tr_read(ap + ot), hi4 = tr_read(ap + 4 * 128 + (ot ^ 16));
                    const bf16x8 ak = __builtin_shufflevector(lo, hi4, 0, 1, 2, 3, 4, 5, 6, 7);
                    Tst[dt] = MFMA16(ak, vf[cbk], Tst[dt]);
                }
                __builtin_amdgcn_sched_barrier(0);
            }
            asm volatile("s_waitcnt vmcnt(0)" ::: "memory");
            __syncthreads();
        }
#pragma unroll
        for (int cb = 0; cb < 8; ++cb) cr[cb] = cr[cb] * g128;
#pragma unroll
        for (int cb = 0; cb < 8; ++cb)
#pragma unroll
            for (int mbk = 0; mbk < 4; ++mbk) if (32 * mbk <= 16 * cb + 15) {
                const bf16x8 ap = *(const LAS bf16x8*)(lds + R2_P + (16 * cb + i16) * 256 + (((4 * mbk + g) ^ i16) * 16));
                cr[cb] = MFMA16(ap, vf[mbk], cr[cb]);
            }
        __syncthreads();
        {
            const ldsp ob = lds + R2_P + (16 * w + i16) * 2;
#pragma unroll
            for (int cb = 0; cb < 8; ++cb)
#pragma unroll
                for (int j = 0; j < 4; ++j) *(LAS unsigned short*)(ob + (16 * cb + 4 * g + j) * 256) = (unsigned short)(pk2(cr[cb][j], 0.f) & 0xffffu);
        }
        __syncthreads();
        {
            const int row = tid >> 2, seg = tid & 3;
            const LAS u32x4* src = (const LAS u32x4*)(lds + R2_P + row * 256 + seg * 64);
            u32x4* dst = (u32x4*)(RV + (rowbase + c0 + row) * 2048 + hh * 512 + es * 128 + seg * 32);
            float s = 0.f;
#pragma unroll
            for (int k = 0; k < 4; ++k) { const u32x4 v = src[k]; dst[k] = v; f32x4 fa, fb; unpack8(v, fa, fb);
                s += (fa[0] * fa[0] + fa[1] * fa[1]) + (fa[2] * fa[2] + fa[3] * fa[3]) + (fb[0] * fb[0] + fb[1] * fb[1]) + (fb[2] * fb[2] + fb[3] * fb[3]); }
            s += __shfl_xor(s, 1); s += __shfl_xor(s, 2);
            if (seg == 0) RS[(rowbase + c0 + row) * 16 + hh * 4 + es] = s;
        }
        __syncthreads();
    }
    __syncthreads();
}

#define GEMM_PHASE(EpiT, E, Aptr, Bptr, N_, K_) do { pg8::Gemm g_{(const pg8::bf16_t*)(Aptr), (const pg8::bf16_t*)(Bptr), T_, (N_), (K_)}; pg8::StaticOrder S_o; S_o.init(T_, (N_), G, (int)blockIdx.x); \
    pg8::gemm_phase<EpiT, pg8::StaticOrder, true, true>(lds, g_, S_o, (E)); } while (0)
#ifndef PH_LO
#define PH_LO 0
#endif
#ifndef PH_HI
#define PH_HI 99
#endif
typedef const __attribute__((address_space(4))) Args* kargp;
#if defined(__HIP_DEVICE_COMPILE__)
DI Args load_args() { kargp kp = (kargp)__builtin_amdgcn_kernarg_segment_ptr(); asm volatile("" : "+s"(kp)); Args a;
    a.x = kp->x; a.c = kp->c; a.w_ada = kp->w_ada; a.b_ada = kp->b_ada; a.g1 = kp->g1; a.w_in = kp->w_in; a.b_branch = kp->b_branch; a.w_sb = kp->w_sb; a.w_ret = kp->w_ret; a.w_out = kp->w_out;
    a.g2 = kp->g2; a.w_ffi = kp->w_ffi; a.w_ffo = kp->w_ffo; a.gf = kp->gf; a.out = kp->out; a.ws = kp->ws; return a; }
#else
DI Args load_args() { return Args{}; }
#endif
#define PHASE_ARGS const Args A = load_args(); unsigned char* const ws = A.ws; bf16* const hmix = (bf16*)A.out; (void)ws; (void)hmix
__global__ void __launch_bounds__(NTHR, 2) fwd_megakernel(Args Aunused) {
    extern __shared__ __attribute__((aligned(16))) unsigned char lds_raw[];
    ldsp lds = (ldsp)lds_raw;
    cg::grid_group grid = cg::this_grid();
    const int G = gridDim.x;
#ifndef PHM
#define PHM 0xFFFFF
#endif
    if (PHM & 1) { PHASE_ARGS; if (blockIdx.x == 0 && threadIdx.x == 0) __hip_atomic_store((unsigned*)(ws + WS_CTR), 0u, __ATOMIC_RELAXED, __HIP_MEMORY_SCOPE_AGENT); p0_prologue(A, lds, G); }
    grid.sync();
    if (PHM & 2) { PHASE_ARGS; norm_mod_phase<true>(A, lds, G, A.x, A.g1, hmix, 0); }
    grid.sync();
    if (PHM & 4) { PHASE_ARGS; EpiInProj E{(bf16*)(ws + WS_SBQ), (bf16*)(ws + WS_SBK), (bf16*)(ws + WS_SBV), (bf16*)(ws + WS_RQ), (bf16*)(ws + WS_RK), (bf16*)(ws + WS_RV), (const float*)(ws + WS_COS), (const float*)(ws + WS_SIN)};
      GEMM_PHASE(EpiInProj, E, hmix, ws + WS_WIN, 7168, 1024); }
    grid.sync();
    if (PHM & 8) { PHASE_ARGS; for (int it = blockIdx.x; it < 1024; it += G) ret_scores_item(lds, (const bf16*)(ws + WS_RQ), (const bf16*)(ws + WS_RK), (bf16*)((unsigned char*)A.out + 64 * MiB), it); }
    __syncthreads();
    if (PHM & 16) { PHASE_ARGS;
        const int wv = __builtin_amdgcn_readfirstlane(threadIdx.x >> 6);
        unsigned* ctr = (unsigned*)(ws + WS_CTR);
        for (;;) {
            unsigned uu = 0u;
            if ((threadIdx.x & 63) == 0) uu = __hip_atomic_fetch_add(ctr, 1u, __ATOMIC_RELAXED, __HIP_MEMORY_SCOPE_AGENT);
            const int u = __builtin_amdgcn_readfirstlane((int)uu);
            if (u >= 16384) break;
            sb_attn_wave(lds + wv * 16384, (const bf16*)(ws + WS_SBQ), (const bf16*)(ws + WS_SBK), (const bf16*)(ws + WS_SBV), (bf16*)(ws + WS_SBQ), u >> 10, (u >> 6) & 15, 63 - (u & 63));
        }
    }
    grid.sync();
    if (PHM & 0x2000) { PHASE_ARGS; for (int u = blockIdx.x; u < 256; u += G) retention_unit2(lds, (const bf16*)(ws + WS_RQ), (const bf16*)(ws + WS_RK), (bf16*)(ws + WS_RV), (const bf16*)((unsigned char*)A.out + 64 * MiB), (float*)(ws + WS_RS), u >> 4, (u >> 2) & 3, u & 3); }
    grid.sync();
    if (PHM & 32) { PHASE_ARGS; EpiGates E{(bf16*)(ws + WS_RV), (bf16*)(ws + WS_GATES), (const float*)(ws + WS_RS), A.b_branch};
      GEMM_PHASE(EpiGates, E, hmix, ws + WS_WIN + (size_t)7168 * 1024 * 2, 4096, 1024); }
    grid.sync();
    if (PHM & 64) { PHASE_ARGS; EpiMerge<0> E{(const bf16*)(ws + WS_GATES), nullptr, (bf16*)(ws + WS_M1)};
      GEMM_PHASE(EpiMerge<0>, E, ws + WS_SBQ, ws + WS_WSB, 1024, 1024); }
    grid.sync();
    if (PHM & 128) { PHASE_ARGS; EpiMerge<1> E{(const bf16*)(ws + WS_GATES), (const bf16*)(ws + WS_M1), (bf16*)(ws + WS_MERGED)};
      GEMM_PHASE(EpiMerge<1>, E, ws + WS_RV, ws + WS_WRET, 1024, 2048); }
    grid.sync();
    if (PHM & 256) { PHASE_ARGS; EpiResid E{A.x, A.out, (const float*)(ws + WS_MODF) + 2048};
      GEMM_PHASE(EpiResid, E, ws + WS_MERGED, ws + WS_WOUT, 1024, 1024); }
    grid.sync();
    if (PHM & 512) { PHASE_ARGS; norm_mod_phase<false>(A, lds, G, A.out, A.g2, (bf16*)(ws + WS_HFFN), 3072); }
    grid.sync();
    if (PHM & 1024) { PHASE_ARGS; EpiSwiglu E{(bf16*)(ws + WS_H)};
      GEMM_PHASE(EpiSwiglu, E, ws + WS_HFFN, ws + WS_WFFI, 2 * DFF, 1024); }
    grid.sync();
    if (PHM & 2048) { PHASE_ARGS; EpiResid E{A.out, A.out, (const float*)(ws + WS_MODF) + 5120};
      GEMM_PHASE(EpiResid, E, ws + WS_H, ws + WS_WFFO, 1024, DFF); }
    grid.sync();
    if (PHM & 4096) { PHASE_ARGS; final_norm_phase(A, G); }
}

extern "C" void kernel_launch(void* const* d_in, const int* in_sizes, int n_in, void* d_out, int out_size, void* d_ws, size_t ws_size, hipStream_t stream) {
    static int grid = 0;
    if (grid == 0) {
        if (n_in != 14 || in_sizes[0] != T_ * D_ || out_size != T_ * D_ || ws_size < WS_END) { fprintf(stderr, "kernel_launch: unexpected shapes / ws %zu\n", ws_size); grid = -1; return; }
        int dev = 0, cus = 0, per_cu = 0;
        hipGetDevice(&dev); hipDeviceGetAttribute(&cus, hipDeviceAttributeMultiprocessorCount, dev);
        if (hipFuncSetAttribute((const void*)fwd_megakernel, hipFuncAttributeMaxDynamicSharedMemorySize, LDS_BYTES) != hipSuccess) { fprintf(stderr, "hipFuncSetAttribute failed\n"); grid = -1; return; }
        if (hipOccupancyMaxActiveBlocksPerMultiprocessor(&per_cu, (const void*)fwd_megakernel, NTHR, LDS_BYTES) != hipSuccess || per_cu < 1) { fprintf(stderr, "occupancy query: %d\n", per_cu); per_cu = 1; }
        (void)hipGetLastError();
        grid = cus * per_cu;
    }
    if (grid < 0) return;
    Args a{};
    a.x = (const float*)d_in[0]; a.c = (const float*)d_in[1]; a.w_ada = (const float*)d_in[2]; a.b_ada = (const float*)d_in[3]; a.g1 = (const float*)d_in[4];
    a.w_in = (const float*)d_in[5]; a.b_branch = (const float*)d_in[6]; a.w_sb = (const float*)d_in[7]; a.w_ret = (const float*)d_in[8]; a.w_out = (const float*)d_in[9];
    a.g2 = (const float*)d_in[10]; a.w_ffi = (const float*)d_in[11]; a.w_ffo = (const float*)d_in[12]; a.gf = (const float*)d_in[13];
    a.out = (float*)d_out; a.ws = (unsigned char*)d_ws;
    void* args[] = {&a};
    hipError_t e = hipLaunchCooperativeKernel((const void*)fwd_megakernel, dim3(grid), dim3(NTHR), args, LDS_BYTES, stream);
    if (e != hipSuccess) fprintf(stderr, "cooperative launch failed: %s (grid %d)\n", hipGetErrorString(e), grid);
}
```

```cpp
#include <hip/hip_runtime.h>
#include <hip/hip_cooperative_groups.h>
#include <cstdio>
#include <cstdint>
namespace cg = cooperative_groups;
namespace pg8 {
#define PG8_LAS __attribute__((address_space(3)))
typedef unsigned short bf16_t;
typedef short bf16x8 __attribute__((ext_vector_type(8)));
typedef float f32x4 __attribute__((ext_vector_type(4)));
typedef unsigned u32x4 __attribute__((ext_vector_type(4)));
constexpr int BM = 256, BK = 64, HALF = 128, HTB = HALF * BK * 2  , STAGE_BYTES = 8 * HTB, NXCD = 8, WGM = 8;

__host__ __device__ __forceinline__ int lds_byte(int r, int c) { const int st = (r >> 4) * 2 + (c >> 5), rr = r & 15, cc = c & 31, ob = rr * 64 + cc * 2; return st * 1024 + (ob ^ (((ob >> 9) & 1) << 5)); }
__host__ __device__ __forceinline__ void stage_rc(int b, int& R, int& C) { const int st = b / 1024, sb = b % 1024, swz = sb ^ (((sb >> 9) & 1) << 5); R = (st >> 1) * 16 + swz / 64; C = (st & 1) * 32 + (swz % 64) / 2; }
__host__ __device__ __forceinline__ int perm32(int rho) { const int n = rho >> 4, i = rho & 15; return 8 * (i >> 2) + 4 * n + (i & 3); }

struct Unit { int pm, pn; };
struct Gemm { const bf16_t* A; const bf16_t* Bt; int M, N, K; const bf16_t* A2; int pn_split; };

struct StaticOrder {
    int nM, nN, nwg, G, c;
    __host__ __device__ void init(int M, int N, int G_, int c_) { nM = M / BM; nN = N / BM; nwg = nM * nN; G = G_; c = c_; }
    __host__ __device__ bool next(int i, Unit& u) const {
        const long L = (long)i * G + c; if (L >= nwg) return false;
        int wgid = (int)L; { const int q = nwg / NXCD, r = nwg % NXCD, xcd = wgid % NXCD, off = wgid / NXCD; wgid = (xcd < r ? xcd * (q + 1) : r * (q + 1) + (xcd - r) * q) + off; }
        const int nig = WGM * nN, gid = wgid / nig, fm = gid * WGM, gsz = (nM - fm) < WGM ? (nM - fm) : WGM;
        u.pm = fm + ((wgid % nig) % gsz); u.pn = (wgid % nig) / gsz; return true;
    }
    __device__ __forceinline__ void a_ready(const Unit&) const {}
    __device__ __forceinline__ void done(const Unit&) const {}
};

__device__ __forceinline__ unsigned cvt_pk_bf16(float lo, float hi) { unsigned r; asm volatile("v_cvt_pk_bf16_f32 %0, %1, %2" : "=v"(r) : "v"(lo), "v"(hi)); return r; }
template <class Epi, class Sched, bool ALIGN_EPI = false, bool SP2 = false>
__device__ __forceinline__ void gemm_phase(PG8_LAS unsigned char* lds, const Gemm g, const Sched& S, const Epi& E) {
    int tid_ = threadIdx.x; asm volatile("" : "+v"(tid_));
    const int tid = tid_, wid = __builtin_amdgcn_readfirstlane(tid >> 6), lane = tid & 63, wr = wid >> 2, wc = wid & 3, fr = lane & 15, fq = lane >> 4;
    const int K = g.K, nt = K / BK;
    unsigned voffA[2], voffB[2];
#pragma unroll
    for (int i = 0; i < 2; ++i) { int R, C; stage_rc(tid * 16 + i * 8192, R, C); const int Rb = Epi::PERM ? ((R & ~31) + perm32(R & 31)) : R;
        voffA[i] = (unsigned)(R * K + C) * 2u; voffB[i] = (unsigned)(Rb * K + C) * 2u; }
    const size_t kstep = (size_t)(BK * 2);
    const size_t hstep = (size_t)HALF * K * 2;
    const size_t tstep = 2 * hstep;
    const unsigned ldsw = (unsigned)wid * 1024u;
    const int aoff = lds_byte(wr * 64 + fr, fq * 8), boff = lds_byte(wc * 32 + fr, fq * 8);
#define PG8_SA(b, h) (((b) * 2 + (h)) * HTB)
#define PG8_SB(b, h) ((4 + (b) * 2 + (h)) * HTB)
#define PG8_STAGE(bufoff, gbase, voff) do { _Pragma("unroll") for (int _i = 0; _i < 2; ++_i) \
        __builtin_amdgcn_global_load_lds((const unsigned*)((const char*)(gbase) + (voff)[_i]), (PG8_LAS unsigned*)(lds + (bufoff) + ldsw + _i * 8192), 16, 0, 0); } while (0)
#define PG8_LDA(dst, b, h) do { _Pragma("unroll") for (int m = 0; m < 4; ++m) _Pragma("unroll") for (int k = 0; k < 2; ++k) dst[m][k] = *(const PG8_LAS bf16x8*)(lds + PG8_SA(b, h) + aoff + m * 2048 + k * 1024); } while (0)
#define PG8_LDB(dst, b, h) do { _Pragma("unroll") for (int n = 0; n < 2; ++n) _Pragma("unroll") for (int k = 0; k < 2; ++k) dst[n][k] = *(const PG8_LAS bf16x8*)(lds + PG8_SB(b, h) + boff + n * 2048 + k * 1024); } while (0)
#define PG8_MMA(ai, bj, At, Bt) do { __builtin_amdgcn_s_setprio(1); _Pragma("unroll") for (int m = 0; m < 4; ++m) _Pragma("unroll") for (int n = 0; n < 2; ++n) _Pragma("unroll") for (int k = 0; k < 2; ++k) \
        acc[ai][bj][m][n] = __builtin_amdgcn_mfma_f32_16x16x32_bf16(Bt[n][k], At[m][k], acc[ai][bj][m][n], 0, 0, 0); __builtin_amdgcn_s_setprio(0); } while (0)
#define PG8_WAIT_V(n) asm volatile("s_waitcnt vmcnt(" #n ")" ::: "memory")
#define PG8_WAIT_L(n) asm volatile("s_waitcnt lgkmcnt(" #n ")" ::: "memory")
#define PG8_BAR __builtin_amdgcn_s_barrier()
#define PG8_SCHED __builtin_amdgcn_sched_barrier(0)
    Unit cur, nxt; int ui = 0;
    if (!S.next(0, cur)) return;
    f32x4 acc[2][2][4][2];
#pragma unroll
    for (int a = 0; a < 2; ++a)
#pragma unroll
        for (int b = 0; b < 2; ++b)
#pragma unroll
            for (int m = 0; m < 4; ++m)
#pragma unroll
                for (int n = 0; n < 2; ++n) acc[a][b][m][n] = (f32x4){0.f, 0.f, 0.f, 0.f};
    bf16x8 At[4][2], B0[2][2], B1[2][2];
    const char* cA = (const char*)(cur.pn >= g.pn_split ? g.A2 : g.A) + (size_t)cur.pm * tstep; const char* cB = (const char*)g.Bt + (size_t)cur.pn * tstep;
    S.a_ready(cur);
    if constexpr (SP2) {
        PG8_STAGE(PG8_SB(0, 0), cB, voffB); PG8_STAGE(PG8_SB(0, 1), cB + hstep, voffB); PG8_STAGE(PG8_SA(0, 0), cA, voffA); PG8_STAGE(PG8_SA(0, 1), cA + hstep, voffA);
        if (wr == 1) PG8_BAR;
        PG8_WAIT_V(2); PG8_BAR;
        PG8_STAGE(PG8_SB(1, 0), cB + kstep, voffB); PG8_STAGE(PG8_SA(1, 0), cA + kstep, voffA); PG8_STAGE(PG8_SB(1, 1), cB + hstep + kstep, voffB);
        PG8_WAIT_V(6); PG8_BAR;
    } else {
        PG8_STAGE(PG8_SB(0, 0), cB, voffB); PG8_STAGE(PG8_SA(0, 0), cA, voffA); PG8_STAGE(PG8_SB(0, 1), cB + hstep, voffB); PG8_STAGE(PG8_SA(0, 1), cA + hstep, voffA);
        if (wr == 1) PG8_BAR;
        PG8_WAIT_V(4); PG8_BAR;
        PG8_STAGE(PG8_SB(1, 0), cB + kstep, voffB); PG8_STAGE(PG8_SA(1, 0), cA + kstep, voffA); PG8_STAGE(PG8_SB(1, 1), cB + hstep + kstep, voffB);
        PG8_WAIT_V(6); PG8_BAR;
    }
    for (;;) {
        const bool has_next = S.next(ui + 1, nxt);
        const char* nA = has_next ? (const char*)(nxt.pn >= g.pn_split ? g.A2 : g.A) + (size_t)nxt.pm * tstep : cA; const char* nB = has_next ? (const char*)g.Bt + (size_t)nxt.pn * tstep : cB;
        for (int t = 0; t < nt; t += 2) {
            const bool last = (t == nt - 2);
            const char* a1 = cA + (size_t)(t + 1) * kstep;
            const char* a2 = last ? nA : cA + (size_t)(t + 2) * kstep; const char* b2 = last ? nB : cB + (size_t)(t + 2) * kstep;
            const char* a3 = a2 + kstep; const char* b3 = b2 + kstep;
            if (last && has_next) S.a_ready(nxt);
            if constexpr (SP2) {
            PG8_LDB(B0, 0, 0); PG8_LDB(B1, 0, 1); PG8_SCHED; PG8_LDA(At, 0, 0); PG8_STAGE(PG8_SA(1, 1), a1 + hstep, voffA);
            PG8_WAIT_V(8); PG8_WAIT_L(0); PG8_BAR; PG8_MMA(0, 0, At, B0); PG8_MMA(0, 1, At, B1); PG8_BAR; PG8_SCHED;
            PG8_LDA(At, 0, 1); PG8_STAGE(PG8_SB(0, 0), b2, voffB); PG8_STAGE(PG8_SB(0, 1), b2 + hstep, voffB); PG8_STAGE(PG8_SA(0, 0), a2, voffA);
            PG8_WAIT_V(8); PG8_WAIT_L(0); PG8_BAR; PG8_MMA(1, 0, At, B0); PG8_MMA(1, 1, At, B1); PG8_BAR; PG8_SCHED;
            PG8_LDB(B0, 1, 0); PG8_LDB(B1, 1, 1); PG8_SCHED; PG8_LDA(At, 1, 0); PG8_STAGE(PG8_SA(0, 1), a2 + hstep, voffA);
            PG8_WAIT_V(8); PG8_WAIT_L(0); PG8_BAR; PG8_MMA(0, 0, At, B0); PG8_MMA(0, 1, At, B1); PG8_BAR; PG8_SCHED;
            PG8_LDA(At, 1, 1); PG8_STAGE(PG8_SB(1, 0), b3, voffB); PG8_STAGE(PG8_SB(1, 1), b3 + hstep, voffB); PG8_STAGE(PG8_SA(1, 0), a3, voffA);
            PG8_WAIT_V(8); PG8_WAIT_L(0); PG8_BAR; PG8_MMA(1, 0, At, B0); PG8_MMA(1, 1, At, B1); PG8_BAR; PG8_SCHED;
            } else {
            PG8_LDB(B0, 0, 0); PG8_SCHED; PG8_LDA(At, 0, 0); PG8_STAGE(PG8_SA(1, 1), a1 + hstep, voffA);
            PG8_WAIT_L(8); PG8_BAR; PG8_WAIT_L(0); PG8_MMA(0, 0, At, B0); PG8_BAR; PG8_SCHED;
            PG8_LDB(B1, 0, 1); PG8_STAGE(PG8_SB(0, 0), b2, voffB);
            PG8_BAR; PG8_WAIT_L(0); PG8_MMA(0, 1, At, B1); PG8_BAR;
            PG8_LDA(At, 0, 1); PG8_STAGE(PG8_SA(0, 0), a2, voffA);
            PG8_BAR; PG8_WAIT_L(0); PG8_MMA(1, 0, At, B0); PG8_BAR; PG8_SCHED;
            PG8_STAGE(PG8_SB(0, 1), b2 + hstep, voffB);
            PG8_WAIT_V(6); PG8_BAR; PG8_MMA(1, 1, At, B1); PG8_BAR;
            PG8_LDB(B0, 1, 0); PG8_SCHED; PG8_LDA(At, 1, 0); PG8_STAGE(PG8_SA(0, 1), a2 + hstep, voffA);
            PG8_WAIT_L(8); PG8_BAR; PG8_WAIT_L(0); PG8_MMA(0, 0, At, B0); PG8_BAR; PG8_SCHED;
            PG8_LDB(B1, 1, 1); PG8_STAGE(PG8_SB(1, 0), b3, voffB);
            PG8_BAR; PG8_WAIT_L(0); PG8_MMA(0, 1, At, B1); PG8_BAR;
            PG8_LDA(At, 1, 1); PG8_STAGE(PG8_SA(1, 0), a3, voffA);
            PG8_BAR; PG8_WAIT_L(0); PG8_MMA(1, 0, At, B0); PG8_BAR; PG8_SCHED;
            PG8_STAGE(PG8_SB(1, 1), b3 + hstep, voffB);
            PG8_WAIT_V(6); PG8_BAR; PG8_MMA(1, 1, At, B1); PG8_BAR;
            }
        }
        if constexpr (ALIGN_EPI) { if (wr == 0) PG8_BAR; }
        if constexpr (!Epi::AFTER_DRAIN) { E(acc, cur, wr, wc, fr, fq); S.done(cur); }
        if (!has_next) break;
#pragma unroll
        for (int a = 0; a < 2; ++a)
#pragma unroll
            for (int b = 0; b < 2; ++b)
#pragma unroll
                for (int m = 0; m < 4; ++m)
#pragma unroll
                    for (int n = 0; n < 2; ++n) acc[a][b][m][n] = (f32x4){0.f, 0.f, 0.f, 0.f};
        cur = nxt; cA = nA; cB = nB; ++ui;
        if constexpr (ALIGN_EPI) { if (wr == 1) PG8_BAR; }
    }
    PG8_WAIT_V(0);
    if constexpr (!ALIGN_EPI) { if (wr == 0) PG8_BAR; }
    PG8_BAR;
    if constexpr (Epi::AFTER_DRAIN) { E.fused(acc, cur, wr, wc, fr, fq, lds, wid, lane); S.done(cur); }
#undef PG8_SA
#undef PG8_SB
#undef PG8_STAGE
#undef PG8_LDA
#undef PG8_LDB
#undef PG8_MMA
#undef PG8_WAIT_V
#undef PG8_WAIT_L
#undef PG8_BAR
#undef PG8_SCHED
}
}

#define GAS __attribute__((address_space(1)))
#define LAS __attribute__((address_space(3)))
#define DI __device__ __forceinline__
typedef unsigned short bf16;
typedef unsigned u32x4 __attribute__((ext_vector_type(4)));
typedef unsigned u32x2 __attribute__((ext_vector_type(2)));
typedef float f32x4 __attribute__((ext_vector_type(4)));
typedef float f32x16 __attribute__((ext_vector_type(16)));
typedef short bf16x8 __attribute__((ext_vector_type(8)));
typedef short s16x4 __attribute__((ext_vector_type(4)));
typedef LAS unsigned char* ldsp;

constexpr int NWAVES = 8, NTHR = 512;
constexpr int T_ = 32768, D_ = 1024, S_ = 2048, NB = 16, DFF = 2816, INW = 11264, NMOD = 6144;
constexpr float EPS_ = 1e-6f;
constexpr size_t MiB = 1u << 20;
constexpr size_t WS_SBQ = 0, WS_SBK = 64 * MiB, WS_SBV = 128 * MiB, WS_RQ = 192 * MiB, WS_RK = 256 * MiB, WS_RV = 320 * MiB;
constexpr size_t WS_WIN = 448 * MiB, WS_WSB = 470 * MiB, WS_WRET = 472 * MiB, WS_WOUT = 476 * MiB, WS_WFFI = 478 * MiB, WS_WFFO = 489 * MiB;
constexpr size_t WS_CTR = 494 * MiB + 512 * 1024;
constexpr size_t WS_MODP = 495 * MiB, WS_MODF = 498 * MiB, WS_COS = 499 * MiB, WS_SIN = 500 * MiB, WS_RS = 501 * MiB, WS_END = 512 * MiB;
constexpr size_t WS_GATES = 64 * MiB, WS_M1 = 196 * MiB, WS_MERGED = 0, WS_HFFN = 0, WS_H = 64 * MiB;
constexpr int LDG = 2080, LDM1 = 1056;
constexpr int LDS_BYTES = 147456;

DI unsigned pk2(float lo, float hi) { return pg8::cvt_pk_bf16(lo, hi); }
DI float bf2f(unsigned short v) { return __uint_as_float((unsigned)v << 16); }
DI float bflo(unsigned w) { return __uint_as_float(w << 16); }
DI float bfhi(unsigned w) { return __uint_as_float(w & 0xffff0000u); }
DI float wave_sum(float v) {
#pragma unroll
    for (int o = 1; o < 64; o <<= 1) v += __shfl_xor(v, o);
    return v;
}
DI float fsigmoid(float v) { return 1.0f / (1.0f + __expf(-v)); }
DI u32x4 pack8(f32x4 a, f32x4 b) { u32x4 w; w.x = pk2(a[0], a[1]); w.y = pk2(a[2], a[3]); w.z = pk2(b[0], b[1]); w.w = pk2(b[2], b[3]); return w; }
DI void unpack8(u32x4 w, f32x4& a, f32x4& b) { a = (f32x4){bflo(w.x), bfhi(w.x), bflo(w.y), bfhi(w.y)}; b = (f32x4){bflo(w.z), bfhi(w.z), bflo(w.w), bfhi(w.w)}; }

struct Args {
    const float *x, *c, *w_ada, *b_ada, *g1, *w_in, *b_branch, *w_sb, *w_ret, *w_out, *g2, *w_ffi, *w_ffo, *gf;
    float* out; unsigned char* ws;
};

using pg8::Unit;
#define EPI_ARGS const f32x4 (&acc)[2][2][4][2], const Unit& u, int wr, int wc, int fr, int fq
struct EpiInProj {
    static constexpr bool PERM = true, AFTER_DRAIN = false;
    bf16 *sbq, *sbk, *sbv, *rq, *rk, *rv; const float *cosT, *sinT;
    DI void operator()(EPI_ARGS) const {
        const int pn = u.pn, row0 = u.pm * 256 + wr * 64 + fr, cw = wc * 32 + 8 * fq;
        if (pn < 12 || pn >= 20) {
            bf16* base; int ld = 1024, colt;
            if (pn < 4) { base = sbq; colt = pn * 256; } else if (pn < 8) { base = sbk; colt = (pn - 4) * 256; }
            else if (pn < 12) { base = sbv; colt = (pn - 8) * 256; } else { base = rv; ld = 2048; colt = (pn - 20) * 256; }
#pragma unroll
            for (int ai = 0; ai < 2; ++ai)
#pragma unroll
                for (int m = 0; m < 4; ++m) { bf16* rowp = base + (size_t)(row0 + ai * 128 + m * 16) * ld + colt + cw;
#pragma unroll
                    for (int bj = 0; bj < 2; ++bj) *(u32x4*)(rowp + bj * 128) = pack8(acc[ai][bj][m][0], acc[ai][bj][m][1]); }
        } else {
            const bool isk = pn >= 16; const int hh = isk ? pn - 16 : pn - 12; bf16* base = (isk ? rk : rq) + hh * 256 + cw;
            const float lg = __log2f(1.0f - exp2f(-5.0f - (float)hh));
            float fj[8];
#pragma unroll
            for (int e = 0; e < 8; ++e) fj[e] = exp2f(-(float)(cw + e) * (13.287712379549449f / 128.0f)) * 0.15915494309189535f;
#pragma unroll
            for (int ai = 0; ai < 2; ++ai)
#pragma unroll
                for (int m = 0; m < 4; ++m) {
                    const int row = row0 + ai * 128 + m * 16, pos = row & 2047, c = row & 127;
                    const float f = isk ? exp2f(-(float)c * lg) * 0.0625f : exp2f((float)c * lg);
                    bf16* rowp = base + (size_t)row * 1024;
                    f32x4 o1[2], o2[2];
#pragma unroll
                    for (int n = 0; n < 2; ++n) {
                        f32x4 cs, sn;
#pragma unroll
                        for (int e = 0; e < 4; ++e) { const float rev = __builtin_amdgcn_fractf((float)pos * fj[4 * n + e]); cs[e] = __builtin_amdgcn_cosf(rev) * f; sn[e] = __builtin_amdgcn_sinf(rev) * f; }
                        const f32x4 v1 = acc[ai][0][m][n], v2 = acc[ai][1][m][n];
                        o1[n] = v1 * cs - v2 * sn; o2[n] = v1 * sn + v2 * cs;
                    }
                    *(u32x4*)rowp = pack8(o1[0], o1[1]); *(u32x4*)(rowp + 128) = pack8(o2[0], o2[1]);
                }
        }
    }
};
struct EpiGates {
    static constexpr bool PERM = true, AFTER_DRAIN = false;
    bf16 *rv, *gates; const float *rs, *bb; bf16* m1;
    DI void operator()(EPI_ARGS) const {
        const int pn = u.pn, row0 = u.pm * 256 + wr * 64 + fr, cw = wc * 32 + 8 * fq;
        if (pn < 8) {
            const int head = pn >> 1;
#pragma unroll
            for (int ai = 0; ai < 2; ++ai) {
                f32x4 q[4]; u32x4 ov[4][2];
#pragma unroll
                for (int m = 0; m < 4; ++m) { const int row = row0 + ai * 128 + m * 16; q[m] = *(const f32x4*)(rs + (size_t)row * 16 + head * 4);
#pragma unroll
                    for (int bj = 0; bj < 2; ++bj) ov[m][bj] = *(const u32x4*)(rv + (size_t)row * 2048 + pn * 256 + bj * 128 + cw); }
#pragma unroll
                for (int m = 0; m < 4; ++m) {
                    const int row = row0 + ai * 128 + m * 16;
                    const float rsv = rsqrtf(((q[m][0] + q[m][1]) + (q[m][2] + q[m][3])) * (1.0f / 512.0f) + EPS_);
#pragma unroll
                    for (int bj = 0; bj < 2; ++bj) {
                        f32x4 oa, ob; unpack8(ov[m][bj], oa, ob);
                        f32x4 ga = acc[ai][bj][m][0], gb = acc[ai][bj][m][1];
#pragma unroll
                        for (int e = 0; e < 4; ++e) { ga[e] = ga[e] * fsigmoid(ga[e]) * oa[e] * rsv; gb[e] = gb[e] * fsigmoid(gb[e]) * ob[e] * rsv; }
                        *(u32x4*)(rv + (size_t)row * 2048 + pn * 256 + bj * 128 + cw) = pack8(ga, gb);
                    }
                }
            }
        } else if (pn < 16) {
#pragma unroll
            for (int bj = 0; bj < 2; ++bj) {
                const int col = (pn - 8) * 256 + bj * 128 + cw;
                const f32x4 b0 = *(const f32x4*)(bb + col), b1 = *(const f32x4*)(bb + col + 4);
#pragma unroll
                for (int ai = 0; ai < 2; ++ai)
#pragma unroll
                    for (int m = 0; m < 4; ++m) {
                        const int row = row0 + ai * 128 + m * 16;
                        f32x4 ga = acc[ai][bj][m][0] + b0, gb = acc[ai][bj][m][1] + b1;
#pragma unroll
                        for (int e = 0; e < 4; ++e) { ga[e] = fsigmoid(ga[e]); gb[e] = fsigmoid(gb[e]); }
                        *(u32x4*)(gates + (size_t)row * LDG + col) = pack8(ga, gb);
                    }
            }
        } else {
#pragma unroll
            for (int ai = 0; ai < 2; ++ai)
#pragma unroll
                for (int m = 0; m < 4; ++m) { bf16* rowp = m1 + (size_t)(row0 + ai * 128 + m * 16) * LDM1 + (pn - 16) * 256 + cw;
#pragma unroll
                    for (int bj = 0; bj < 2; ++bj) *(u32x4*)(rowp + bj * 128) = pack8(acc[ai][bj][m][0], acc[ai][bj][m][1]); }
        }
    }
};
struct EpiMerge2 {
    static constexpr bool PERM = true, AFTER_DRAIN = false;
    const bf16* gates; const bf16* m1; bf16* outp;
    DI void operator()(EPI_ARGS) const {
        const int row0 = u.pm * 256 + wr * 64 + fr, cw = wc * 32 + 8 * fq;
#pragma unroll
        for (int ai = 0; ai < 2; ++ai)
#pragma unroll
            for (int mp = 0; mp < 2; ++mp) {
                u32x4 gs[2][2], gr[2][2], pv[2][2];
#pragma unroll
                for (int mm = 0; mm < 2; ++mm)
#pragma unroll
                    for (int bj = 0; bj < 2; ++bj) { const int row = row0 + ai * 128 + (2 * mp + mm) * 16, col = u.pn * 256 + bj * 128 + cw;
                        gs[mm][bj] = *(const u32x4*)(gates + (size_t)row * LDG + col); gr[mm][bj] = *(const u32x4*)(gates + (size_t)row * LDG + 1024 + col);
                        pv[mm][bj] = *(const u32x4*)(m1 + (size_t)row * LDM1 + col); }
#pragma unroll
                for (int mm = 0; mm < 2; ++mm)
#pragma unroll
                    for (int bj = 0; bj < 2; ++bj) { const int m = 2 * mp + mm, row = row0 + ai * 128 + m * 16, col = u.pn * 256 + bj * 128 + cw;
                        f32x4 sa, sb, ra, rb, pa, pb; unpack8(gs[mm][bj], sa, sb); unpack8(gr[mm][bj], ra, rb); unpack8(pv[mm][bj], pa, pb);
                        *(u32x4*)(outp + (size_t)row * 1024 + col) = pack8(sa * pa + ra * acc[ai][bj][m][0], sb * pb + rb * acc[ai][bj][m][1]); }
            }
    }
};
struct EpiResid {
    static constexpr bool PERM = true, AFTER_DRAIN = false;
    const float* base; float* outp; const float* gate;
    DI void operator()(EPI_ARGS) const {
        const int row0 = u.pm * 256 + wr * 64 + fr, cw = wc * 32 + 8 * fq, b = u.pm >> 3;
        f32x4 gt[2][2];
#pragma unroll
        for (int bj = 0; bj < 2; ++bj) { const int col = u.pn * 256 + bj * 128 + cw; gt[bj][0] = *(const f32x4*)(gate + b * NMOD + col); gt[bj][1] = *(const f32x4*)(gate + b * NMOD + col + 4); }
#pragma unroll
        for (int ai = 0; ai < 2; ++ai)
#pragma unroll
            for (int mp = 0; mp < 2; ++mp) {
                f32x4 xv[2][2][2];
#pragma unroll
                for (int mm = 0; mm < 2; ++mm)
#pragma unroll
                    for (int bj = 0; bj < 2; ++bj) { const size_t off = (size_t)(row0 + ai * 128 + (2 * mp + mm) * 16) * 1024 + u.pn * 256 + bj * 128 + cw;
                        xv[mm][bj][0] = *(const f32x4*)(base + off); xv[mm][bj][1] = *(const f32x4*)(base + off + 4); }
#pragma unroll
                for (int mm = 0; mm < 2; ++mm)
#pragma unroll
                    for (int bj = 0; bj < 2; ++bj) { const int m = 2 * mp + mm; const size_t off = (size_t)(row0 + ai * 128 + m * 16) * 1024 + u.pn * 256 + bj * 128 + cw;
                        *(f32x4*)(outp + off) = xv[mm][bj][0] + gt[bj][0] * acc[ai][bj][m][0]; *(f32x4*)(outp + off + 4) = xv[mm][bj][1] + gt[bj][1] * acc[ai][bj][m][1]; }
            }
    }
};
struct EpiSwiglu {
    static constexpr bool PERM = true, AFTER_DRAIN = false;
    bf16* H;
    DI void operator()(EPI_ARGS) const {
        const int row0 = u.pm * 256 + wr * 64 + fr, cw = wc * 32 + 8 * fq;
#pragma unroll
        for (int ai = 0; ai < 2; ++ai)
#pragma unroll
            for (int m = 0; m < 4; ++m) {
                f32x4 a0 = acc[ai][0][m][0], a1 = acc[ai][0][m][1]; const f32x4 u0 = acc[ai][1][m][0], u1 = acc[ai][1][m][1];
#pragma unroll
                for (int e = 0; e < 4; ++e) { a0[e] = a0[e] * fsigmoid(a0[e]) * u0[e]; a1[e] = a1[e] * fsigmoid(a1[e]) * u1[e]; }
                *(u32x4*)(H + (size_t)(row0 + ai * 128 + m * 16) * DFF + u.pn * 128 + cw) = pack8(a0, a1);
            }
    }
};

DI int ffi_row(int n) { return n < DFF ? 256 * (n >> 7) + (n & 127) : 256 * ((n - DFF) >> 7) + 128 + ((n - DFF) & 127); }
DI void transpose_item(const float* W, int K, int N, bf16* WT, int mode, LAS float* scr, int item, int lane) {
    const int nblk = N / 32, kb = item / nblk, nb = item % nblk, k0 = 64 * kb, n0 = 32 * nb;
    const int d0 = mode ? ffi_row(n0) : n0;
#pragma unroll 8
    for (int i = 0; i < 32; ++i) { const int kk = 2 * i + (lane >> 5); scr[kk * 33 + (lane & 31)] = W[(size_t)(k0 + kk) * N + n0 + (lane & 31)]; }
    asm volatile("s_waitcnt lgkmcnt(0)" ::: "memory");
    const int c = lane & 7;
#pragma unroll
    for (int j = 0; j < 4; ++j) { const int n = (lane >> 3) + 8 * j; const LAS float* s = scr + (8 * c) * 33 + n;
        u32x4 o; o.x = pk2(s[0 * 33], s[1 * 33]); o.y = pk2(s[2 * 33], s[3 * 33]); o.z = pk2(s[4 * 33], s[5 * 33]); o.w = pk2(s[6 * 33], s[7 * 33]);
        *(u32x4*)(WT + (size_t)(d0 + n) * K + k0 + 8 * c) = o; }
    asm volatile("s_waitcnt lgkmcnt(0)" ::: "memory");
}
DI void p0_prologue(const Args& A, ldsp lds, int G) {
    const int tid = threadIdx.x, lane = tid & 63, wave = tid >> 6;
    LAS float* scr = (LAS float*)(lds + wave * 16384);
    const int gw = blockIdx.x * NWAVES + wave, NGW = G * NWAVES;
    unsigned char* ws = A.ws;
    constexpr int I_IN = (D_ / 64) * (INW / 32), I_SB = 16 * 32, I_RET = 32 * 32, I_OUT = 16 * 32, I_FFI = 16 * (2 * DFF / 32), I_FFO = (DFF / 64) * 32;
    constexpr int I_MOD = 96 * 8, I_ROPE = 2048 * 128 / 64;
    constexpr int NIT = I_IN + I_SB + I_RET + I_OUT + I_FFI + I_FFO + I_MOD + I_ROPE;
    for (int it = gw; it < NIT; it += NGW) {
        int r = it;
        if (r < I_IN) { transpose_item(A.w_in, D_, INW, (bf16*)(ws + WS_WIN), 0, scr, r, lane); continue; } r -= I_IN;
        if (r < I_SB) { transpose_item(A.w_sb, 1024, 1024, (bf16*)(ws + WS_WSB), 0, scr, r, lane); continue; } r -= I_SB;
        if (r < I_RET) { transpose_item(A.w_ret, 2048, 1024, (bf16*)(ws + WS_WRET), 0, scr, r, lane); continue; } r -= I_RET;
        if (r < I_OUT) { transpose_item(A.w_out, 1024, 1024, (bf16*)(ws + WS_WOUT), 0, scr, r, lane); continue; } r -= I_OUT;
        if (r < I_FFI) { transpose_item(A.w_ffi, 1024, 2 * DFF, (bf16*)(ws + WS_WFFI), 1, scr, r, lane); continue; } r -= I_FFI;
        if (r < I_FFO) { transpose_item(A.w_ffo, DFF, 1024, (bf16*)(ws + WS_WFFO), 0, scr, r, lane); continue; } r -= I_FFO;
        if (r < I_MOD) {
            const int eb = r % 96, ks = r / 96, d0 = ks * 128, e = eb * 64 + lane;
#pragma unroll 4
            for (int i = 0; i < 32; ++i) { const int idx = i * 64 + lane, b = idx >> 7, dd = idx & 127; const float cv = A.c[b * 1024 + d0 + dd]; scr[idx] = cv * fsigmoid(cv); }
            asm volatile("s_waitcnt lgkmcnt(0)" ::: "memory");
            float a[16];
#pragma unroll
            for (int b = 0; b < 16; ++b) a[b] = 0.f;
            for (int dd = 0; dd < 128; ++dd) { const float w = A.w_ada[(size_t)(d0 + dd) * NMOD + e];
#pragma unroll
                for (int b = 0; b < 16; ++b) a[b] += scr[b * 128 + dd] * w; }
            float* mp = (float*)(ws + WS_MODP) + (size_t)ks * NB * NMOD + e;
#pragma unroll
            for (int b = 0; b < 16; ++b) mp[b * NMOD] = a[b];
            asm volatile("s_waitcnt lgkmcnt(0)" ::: "memory");
            continue;
        } r -= I_MOD;
        {
            const int idx = r * 64 + lane, pos = idx >> 7, j = idx & 127;
            const float inv = exp2f(-(float)j * (13.287712379549449f / 128.0f));
            const float ang = (float)pos * inv;
            const float n = rintf(ang * 0.15915494309189535f);
            float rr = __builtin_fmaf(-n, 6.28125f, ang); rr = __builtin_fmaf(-n, 0.0019353071795864769f, rr);
            ((float*)(ws + WS_COS))[idx] = cosf(rr); ((float*)(ws + WS_SIN))[idx] = sinf(rr);
        }
    }
}
template <bool FIRST> DI void norm_mod_phase(const Args& A, ldsp lds, int G, const float* src, const float* gw_, bf16* dst, int shift_off) {
    const int tid = threadIdx.x, lane = tid & 63, wave = tid >> 6;
    LAS float* modl = (LAS float*)lds;
    const float* modp = (const float*)(A.ws + WS_MODP); float* modf = (float*)(A.ws + WS_MODF);
    for (int rb = blockIdx.x; rb < 256; rb += G) {
        const int b = rb >> 4;
        __syncthreads();
        for (int i = tid; i < 2048; i += NTHR) {
            float v;
            if (FIRST) { const int e = i; v = A.b_ada[e]; for (int ks = 0; ks < 8; ++ks) v += modp[(size_t)ks * NB * NMOD + b * NMOD + e]; }
            else v = modf[b * NMOD + shift_off + i];
            modl[i] = v;
        }
        if (FIRST && tid < 384) { const int idx = rb * 384 + tid, e = idx % NMOD; float v = A.b_ada[e]; for (int ks = 0; ks < 8; ++ks) v += modp[(size_t)ks * NB * NMOD + idx]; modf[idx] = v; }
        __syncthreads();
        for (int rr = 0; rr < 16; ++rr) {
            const int row = rb * 128 + wave * 16 + rr;
            const f32x4* xr = (const f32x4*)(src + (size_t)row * 1024) + lane;
            f32x4 v[4]; float s = 0.f;
#pragma unroll
            for (int j = 0; j < 4; ++j) { v[j] = xr[64 * j]; s += (v[j][0] * v[j][0] + v[j][1] * v[j][1]) + (v[j][2] * v[j][2] + v[j][3] * v[j][3]); }
            const float rstd = rsqrtf(wave_sum(s) * (1.0f / 1024.0f) + EPS_);
            unsigned long long* o8 = (unsigned long long*)(dst + (size_t)row * 1024) + lane;
#pragma unroll
            for (int j = 0; j < 4; ++j) {
                const int col = 4 * lane + 256 * j;
                const f32x4 g = *(const f32x4*)(gw_ + col); const f32x4 sh = *(const LAS f32x4*)(modl + col), sc = *(const LAS f32x4*)(modl + 1024 + col);
                const f32x4 y = v[j] * rstd * g * (sc + 1.0f) + sh;
                o8[64 * j] = (unsigned long long)pk2(y[0], y[1]) | ((unsigned long long)pk2(y[2], y[3]) << 32);
            }
        }
    }
    __syncthreads();
}
DI void final_norm_phase(const Args& A, int G) {
    const int tid = threadIdx.x, lane = tid & 63, wave = tid >> 6;
    const int gw = blockIdx.x * NWAVES + wave, NGW = G * NWAVES;
    for (int row = gw; row < T_; row += NGW) {
        f32x4* xr = (f32x4*)(A.out + (size_t)row * 1024) + lane;
        f32x4 v[4]; float s = 0.f;
#pragma unroll
        for (int j = 0; j < 4; ++j) { v[j] = xr[64 * j]; s += (v[j][0] * v[j][0] + v[j][1] * v[j][1]) + (v[j][2] * v[j][2] + v[j][3] * v[j][3]); }
        const float rstd = rsqrtf(wave_sum(s) * (1.0f / 1024.0f) + EPS_);
#pragma unroll
        for (int j = 0; j < 4; ++j) { const f32x4 g = *(const f32x4*)(A.gf + 4 * lane + 256 * j); xr[64 * j] = v[j] * rstd * g; }
    }
}

typedef short v4i16_t __attribute__((ext_vector_type(4)));
DI s16x4 tr_read(const LAS unsigned char* p) { return __builtin_bit_cast(s16x4, __builtin_amdgcn_ds_read_tr16_b64_v4i16((LAS v4i16_t*)p)); }
#define MFMA32(a, b, c) __builtin_amdgcn_mfma_f32_32x32x16_bf16((a), (b), (c), 0, 0, 0)
#define MFMA16(a, b, c) __builtin_amdgcn_mfma_f32_16x16x32_bf16((a), (b), (c), 0, 0, 0)
DI int crow(int r, int hi) { return (r & 3) + 8 * (r >> 2) + 4 * hi; }
DI bf16x8 pack_step(const f32x16& x, int s) {
    u32x4 p; p.x = pk2(x[8 * s], x[8 * s + 1]); p.y = pk2(x[8 * s + 2], x[8 * s + 3]); p.z = pk2(x[8 * s + 4], x[8 * s + 5]); p.w = pk2(x[8 * s + 6], x[8 * s + 7]);
    return __builtin_bit_cast(bf16x8, p);
}
constexpr int SB_PK = 144, SB_PV = 192;
constexpr int SB_KBYTES = 64 * SB_PK, SB_VBYTES = 64 * SB_PV, SB_BUF = SB_KBYTES + SB_VBYTES;
DI void sb_attn_unit(ldsp lds, const bf16* Q, const bf16* K, const bf16* V, bf16* O, int b, int h, int qb, int dry = 0) {
    const int tid = threadIdx.x, lane = tid & 63, wave = __builtin_amdgcn_readfirstlane(tid >> 6), r32 = lane & 31, hi = lane >> 5;
    const int t0 = qb * 256 + wave * 32, tq = t0 + r32;
    const size_t rowbase = (size_t)b * S_;
    bf16x8 qf[4];
#pragma unroll
    for (int ks = 0; ks < 4; ++ks) qf[ks] = *(const bf16x8*)(Q + (rowbase + tq) * 1024 + h * 64 + 16 * ks + 8 * hi);
    bf16x8 U0, U1, ONES;
#pragma unroll
    for (int jj = 0; jj < 8; ++jj) { const int k0 = 8 * (jj >> 2) + 4 * hi + (jj & 3); U0[jj] = (k0 >= r32) ? (short)0x3F80 : (short)0; U1[jj] = (16 + k0 >= r32) ? (short)0x3F80 : (short)0; ONES[jj] = (short)0x3F80; }
    f32x16 o0, o1;
#pragma unroll
    for (int i = 0; i < 16; ++i) { o0[i] = 0.f; o1[i] = 0.f; }
    float R2 = 0.f;
    const int ntiles = qb * 4 + 4;
    const int srow = tid >> 3, schunk = tid & 7;
    const bf16* kg = K + (rowbase + srow) * 1024 + h * 64 + schunk * 8; const bf16* vg = V + (rowbase + srow) * 1024 + h * 64 + schunk * 8;
    const int kso = srow * SB_PK + schunk * 16, vso = SB_KBYTES + srow * SB_PV + schunk * 16;
    LAS unsigned* doneF = (LAS unsigned*)(lds + 2 * SB_BUF);
    bool wdone = false;
    __syncthreads();
    { const int jt = ntiles - 1; const u32x4 kr = *(const u32x4*)(kg + (size_t)jt * 64 * 1024), vr = *(const u32x4*)(vg + (size_t)jt * 64 * 1024);
      *(LAS u32x4*)(lds + kso) = kr; *(LAS u32x4*)(lds + vso) = vr; }
    __syncthreads();
    const float C2 = 0.125f * 1.4426950408889634f;
    const int i16 = lane & 15, blk = (lane >> 4) & 1, qq = i16 >> 2, pp = i16 & 3;
    for (int jt = ntiles - 1; jt >= 0; --jt) {
        const int cur = (ntiles - 1 - jt) & 1;
        u32x4 kr, vr;
        if (jt > 0) { kr = *(const u32x4*)(kg + (size_t)(jt - 1) * 64 * 1024); vr = *(const u32x4*)(vg + (size_t)(jt - 1) * 64 * 1024); }
        if (!wdone && 64 * jt < t0 + 31) {
            const LAS unsigned char* Kb = lds + cur * SB_BUF; const LAS unsigned char* Vb = Kb + SB_KBYTES;
            const bool diag = (64 * jt + 63 >= t0);
            f32x16 z[2];
#pragma unroll
            for (int rb = 0; rb < 2; ++rb) {
#pragma unroll
                for (int i = 0; i < 16; ++i) z[rb][i] = 0.f;
#pragma unroll
                for (int ks = 0; ks < 4; ++ks) { const bf16x8 a = *(const LAS bf16x8*)(Kb + (32 * rb + r32) * SB_PK + (16 * ks + 8 * hi) * 2); z[rb] = MFMA32(a, qf[ks], z[rb]); }
            }
            float lsum = 0.f; f32x16 L[2];
#pragma unroll
            for (int rb = 0; rb < 2; ++rb)
#pragma unroll
                for (int i = 0; i < 16; ++i) {
                    const float z2 = z[rb][i] * C2;
                    const float e = __builtin_amdgcn_exp2f(-__builtin_fabsf(z2));
                    float l = -(__builtin_fmaxf(z2, 0.f) + __builtin_amdgcn_logf(1.0f + e));
                    if (diag) { const int s = 64 * jt + 32 * rb + crow(i, hi); if (!(s < tq)) l = 0.f; }
                    L[rb][i] = l; lsum += l; z[rb][i] = z2 + R2;
                }
            bf16x8 Lp[4];
#pragma unroll
            for (int q = 0; q < 4; ++q) Lp[q] = pack_step(L[q >> 1], q & 1);
            f32x16 la0 = MFMA32(U0, Lp[0], z[0]); la0 = MFMA32(U1, Lp[1], la0); la0 = MFMA32(ONES, Lp[2], la0); la0 = MFMA32(ONES, Lp[3], la0);
            f32x16 la1 = MFMA32(U0, Lp[2], z[1]); la1 = MFMA32(U1, Lp[3], la1);
#pragma unroll
            for (int i = 0; i < 16; ++i) {
                float a0 = __builtin_amdgcn_exp2f(la0[i]), a1 = __builtin_amdgcn_exp2f(la1[i]);
                if (diag) { const int s = 64 * jt + crow(i, hi); if (!(s < tq)) a0 = 0.f; if (!(s + 32 < tq)) a1 = 0.f; }
                la0[i] = a0; la1[i] = a1;
            }
            bf16x8 Ap[4]; Ap[0] = pack_step(la0, 0); Ap[1] = pack_step(la0, 1); Ap[2] = pack_step(la1, 0); Ap[3] = pack_step(la1, 1);
#pragma unroll
            for (int q = 0; q < 4; ++q) {
                const int key0 = 16 * q + 4 * hi;
#pragma unroll
                for (int db = 0; db < 2; ++db) {
                    const LAS unsigned char* ap = Vb + (key0 + qq) * SB_PV + (32 * db + 16 * blk + 4 * pp) * 2;
                    const s16x4 lo = tr_read(ap), hi4 = tr_read(ap + 8 * SB_PV);
                    const bf16x8 va = __builtin_shufflevector(lo, hi4, 0, 1, 2, 3, 4, 5, 6, 7);
                    if (db == 0) o0 = MFMA32(va, Ap[q], o0); else o1 = MFMA32(va, Ap[q], o1);
                }
            }
            R2 += lsum + __shfl_xor(lsum, 32);
            wdone = __all(R2 < -160.0f);
        }
        if (lane == 0) doneF[(jt & 1) * 8 + wave] = wdone ? 1u : 0u;
        if (jt > 0) { *(LAS u32x4*)(lds + (cur ^ 1) * SB_BUF + kso) = kr; *(LAS u32x4*)(lds + (cur ^ 1) * SB_BUF + vso) = vr; }
        __syncthreads();
        { const LAS u32x4* df = (const LAS u32x4*)(doneF + (jt & 1) * 8); const u32x4 f0 = df[0], f1 = df[1];
          if ((f0.x & f0.y & f0.z & f0.w & f1.x & f1.y & f1.z & f1.w) != 0u) break; }
    }
    bf16* op = O + (rowbase + tq) * 1024 + h * 64 + 4 * hi;
#pragma unroll
    for (int g = 0; g < 4; ++g) {
        u32x2 w0, w1; w0.x = pk2(o0[4 * g], o0[4 * g + 1]); w0.y = pk2(o0[4 * g + 2], o0[4 * g + 3]); w1.x = pk2(o1[4 * g], o1[4 * g + 1]); w1.y = pk2(o1[4 * g + 2], o1[4 * g + 3]);
        if (!dry) { *(u32x2*)(op + 8 * g) = w0; *(u32x2*)(op + 32 + 8 * g) = w1; }
    }
}


DI void sb_attn_wave(ldsp vl  , const bf16* Q, const bf16* K, const bf16* V, bf16* O, int b, int h, int rg) {
    const int lane = threadIdx.x & 63, r32 = lane & 31, hi = lane >> 5;
    const int t0 = rg * 32, tq = t0 + r32;
    const size_t rowbase = (size_t)b * S_;
    bf16x8 qf[4];
#pragma unroll
    for (int ks = 0; ks < 4; ++ks) qf[ks] = *(const bf16x8*)(Q + (rowbase + tq) * 1024 + h * 64 + 16 * ks + 8 * hi);
    bf16x8 U0, U1, ONES;
#pragma unroll
    for (int jj = 0; jj < 8; ++jj) { const int k0 = 8 * (jj >> 2) + 4 * hi + (jj & 3); U0[jj] = (k0 >= r32) ? (short)0x3F80 : (short)0; U1[jj] = (16 + k0 >= r32) ? (short)0x3F80 : (short)0; ONES[jj] = (short)0x3F80; }
    f32x16 o0, o1;
#pragma unroll
    for (int i = 0; i < 16; ++i) { o0[i] = 0.f; o1[i] = 0.f; }
    float R2 = 0.f;
    const int jtop = (t0 + 30) >> 6;
    const bf16* kg = K + (rowbase + r32) * 1024 + h * 64 + 8 * hi;
    const bf16* vg = V + (rowbase + (lane >> 3)) * 1024 + h * 64 + (((lane & 7) ^ ((((lane >> 3) >> 1) & 1) << 2)) * 8);
    const int i16 = lane & 15, blk = (lane >> 4) & 1, qq = i16 >> 2, pp = i16 & 3;
    const int vro = (4 * hi + qq) * 128 + (((2 * blk + (pp >> 1)) ^ (((qq >> 1) & 1) << 2)) * 16) + 8 * (pp & 1);
    bf16x8 kf[8];
#pragma unroll
    for (int i = 0; i < 8; ++i) __builtin_amdgcn_global_load_lds((const unsigned*)(vg + (size_t)(64 * jtop + 8 * i) * 1024), (LAS unsigned*)(vl + i * 1024), 16, 0, 0);
#pragma unroll
    for (int i = 0; i < 8; ++i) kf[i] = *(const bf16x8*)(kg + (size_t)(64 * jtop + 32 * (i >> 2)) * 1024 + 16 * (i & 3));
    const float C2 = 0.125f * 1.4426950408889634f;
    for (int jt = jtop; jt >= 0; --jt) {
        const int cur = (jtop - jt) & 1;
        asm volatile("s_waitcnt vmcnt(0)" ::: "memory");
        f32x16 z[2];
#pragma unroll
        for (int rb = 0; rb < 2; ++rb) {
#pragma unroll
            for (int i = 0; i < 16; ++i) z[rb][i] = 0.f;
#pragma unroll
            for (int ks = 0; ks < 4; ++ks) z[rb] = MFMA32(kf[rb * 4 + ks], qf[ks], z[rb]);
        }
        if (jt > 0) {
#pragma unroll
            for (int i = 0; i < 8; ++i) __builtin_amdgcn_global_load_lds((const unsigned*)(vg + (size_t)(64 * (jt - 1) + 8 * i) * 1024), (LAS unsigned*)(vl + (cur ^ 1) * 8192 + i * 1024), 16, 0, 0);
#pragma unroll
            for (int i = 0; i < 8; ++i) kf[i] = *(const bf16x8*)(kg + (size_t)(64 * (jt - 1) + 32 * (i >> 2)) * 1024 + 16 * (i & 3));
        }
        const bool diag = (jt == jtop);
        float lsum = 0.f; f32x16 L[2];
#pragma unroll
        for (int rb = 0; rb < 2; ++rb)
#pragma unroll
            for (int i = 0; i < 16; ++i) {
                const float z2 = z[rb][i] * C2;
                const float e = __builtin_amdgcn_exp2f(-__builtin_fabsf(z2));
                L[rb][i] = -(__builtin_fmaxf(z2, 0.f) + __builtin_amdgcn_logf(1.0f + e));
                z[rb][i] = z2 + R2;
            }
        if (diag) {
#pragma unroll
            for (int rb = 0; rb < 2; ++rb)
#pragma unroll
                for (int i = 0; i < 16; ++i) { const int s = 64 * jt + 32 * rb + crow(i, hi); if (!(s < tq)) L[rb][i] = 0.f; }
        }
#pragma unroll
        for (int i = 0; i < 16; ++i) lsum += L[0][i] + L[1][i];
        bf16x8 Lp[4];
#pragma unroll
        for (int q = 0; q < 4; ++q) Lp[q] = pack_step(L[q >> 1], q & 1);
        f32x16 la0 = MFMA32(U0, Lp[0], z[0]); la0 = MFMA32(U1, Lp[1], la0); la0 = MFMA32(ONES, Lp[2], la0); la0 = MFMA32(ONES, Lp[3], la0);
        f32x16 la1 = MFMA32(U0, Lp[2], z[1]); la1 = MFMA32(U1, Lp[3], la1);
#pragma unroll
        for (int i = 0; i < 16; ++i) { la0[i] = __builtin_amdgcn_exp2f(la0[i]); la1[i] = __builtin_amdgcn_exp2f(la1[i]); }
        if (diag) {
#pragma unroll
            for (int i = 0; i < 16; ++i) { const int s = 64 * jt + crow(i, hi); if (!(s < tq)) la0[i] = 0.f; if (!(s + 32 < tq)) la1[i] = 0.f; }
        }
        bf16x8 Ap[4]; Ap[0] = pack_step(la0, 0); Ap[1] = pack_step(la0, 1); Ap[2] = pack_step(la1, 0); Ap[3] = pack_step(la1, 1);
        const LAS unsigned char* vb = vl + cur * 8192 + vro;
#pragma unroll
        for (int q = 0; q < 4; ++q) {
#pragma unroll
            for (int db = 0; db < 2; ++db) {
                const LAS unsigned char* ap = (const LAS unsigned char*)((unsigned)(size_t)(vb + 2048 * q) ^ (unsigned)(64 * db));
                const s16x4 lo = tr_read(ap), hi4 = tr_read(ap + 1024);
                const bf16x8 va = __builtin_shufflevector(lo, hi4, 0, 1, 2, 3, 4, 5, 6, 7);
                if (db == 0) o0 = MFMA32(va, Ap[q], o0); else o1 = MFMA32(va, Ap[q], o1);
            }
        }
        R2 += lsum + __shfl_xor(lsum, 32);
        if (__all(R2 < -152.0f)) break;
    }
    asm volatile("s_waitcnt vmcnt(0)" ::: "memory");
    bf16* op = O + (rowbase + tq) * 1024 + h * 64 + 4 * hi;
#pragma unroll
    for (int g = 0; g < 4; ++g) {
        u32x2 w0, w1; w0.x = pk2(o0[4 * g], o0[4 * g + 1]); w0.y = pk2(o0[4 * g + 2], o0[4 * g + 3]); w1.x = pk2(o1[4 * g], o1[4 * g + 1]); w1.y = pk2(o1[4 * g + 2], o1[4 * g + 3]);
        *(u32x2*)(op + 8 * g) = w0; *(u32x2*)(op + 32 + 8 * g) = w1;
    }
}

constexpr int RT_P = 272;
constexpr int RT_TILE = 128 * RT_P, RT_Q = 0, RT_K = RT_TILE, RT_V = 2 * RT_TILE, RT_PS = 3 * RT_TILE, RT_SS = 4 * RT_TILE;
#define RT_STAGE(dh_, withv_) do { \
    const int row_ = tid >> 4, chunk_ = tid & 15; \
    const bf16* qg_ = RQ + (rowbase + c0 + row_) * 1024 + hh * 256 + (dh_) * 128 + chunk_ * 8; \
    const bf16* kg_ = RK + (rowbase + c0 + row_) * 1024 + hh * 256 + (dh_) * 128 + chunk_ * 8; \
    const ldsp lq_ = lds + row_ * RT_P + chunk_ * 16; \
    _Pragma("unroll") for (int i_ = 0; i_ < 4; ++i_) *(LAS u32x4*)(lq_ + RT_Q + i_ * 32 * RT_P) = *(const u32x4*)(qg_ + (size_t)i_ * 32 * 1024); \
    __builtin_amdgcn_sched_barrier(0); \
    _Pragma("unroll") for (int i_ = 0; i_ < 4; ++i_) *(LAS u32x4*)(lq_ + RT_K + i_ * 32 * RT_P) = *(const u32x4*)(kg_ + (size_t)i_ * 32 * 1024); \
    __builtin_amdgcn_sched_barrier(0); \
    if (withv_) { const bf16* vg_ = RV + (rowbase + c0 + row_) * 2048 + hh * 512 + es * 128 + chunk_ * 8; \
        _Pragma("unroll") for (int i_ = 0; i_ < 4; ++i_) *(LAS u32x4*)(lq_ + RT_V + i_ * 32 * RT_P) = *(const u32x4*)(vg_ + (size_t)i_ * 32 * 2048); } \
    __builtin_amdgcn_sched_barrier(0); } while (0)
DI void retention_unit(ldsp lds, const bf16* RQ, const bf16* RK, bf16* RV, float* RS, int b, int hh, int es, int dry = 0) {
    const int tid = threadIdx.x, lane = tid & 63, w = __builtin_amdgcn_readfirstlane(tid >> 6), i16 = lane & 15, g = lane >> 4, qq = i16 >> 2, pp = i16 & 3;
    const size_t rowbase = (size_t)b * S_;
    const float g128 = exp2f(128.0f * __log2f(1.0f - exp2f(-5.0f - (float)hh)));
    f32x4 Tst[16];
#pragma unroll
    for (int i = 0; i < 16; ++i) Tst[i] = (f32x4){0.f, 0.f, 0.f, 0.f};
    for (int ch = 0; ch < 16; ++ch) {
        const int c0 = ch * 128;
        {
            f32x4 sc[8];
#pragma unroll
            for (int i = 0; i < 8; ++i) sc[i] = (f32x4){0.f, 0.f, 0.f, 0.f};
#pragma unroll
            for (int dh = 0; dh < 2; ++dh) {
                __syncthreads();
                RT_STAGE(dh, false);
                __syncthreads();
#pragma unroll
                for (int kb = 0; kb < 4; ++kb) {
                    const bf16x8 bq = *(const LAS bf16x8*)(lds + RT_Q + (16 * w + i16) * RT_P + (32 * kb + 8 * g) * 2);
#pragma unroll
                    for (int mb = 0; mb < 8; ++mb) { const bf16x8 ak = *(const LAS bf16x8*)(lds + RT_K + (16 * mb + i16) * RT_P + (32 * kb + 8 * g) * 2); sc[mb] = MFMA16(ak, bq, sc[mb]); }
                    __builtin_amdgcn_sched_barrier(0);
                }
            }
            const int c = 16 * w + i16;
#pragma unroll
            for (int mb = 0; mb < 8; ++mb) {
                const int m0 = 16 * mb + 4 * g;
                const float v0 = (m0 <= c) ? sc[mb][0] : 0.f, v1 = (m0 + 1 <= c) ? sc[mb][1] : 0.f, v2 = (m0 + 2 <= c) ? sc[mb][2] : 0.f, v3 = (m0 + 3 <= c) ? sc[mb][3] : 0.f;
                u32x2 pw; pw.x = pk2(v0, v1); pw.y = pk2(v2, v3);
                *(LAS u32x2*)(lds + RT_PS + c * RT_P + m0 * 2) = pw;
            }
        }
        __builtin_amdgcn_sched_barrier(0);
        f32x4 cr[8]; bf16x8 vf[4];
#pragma unroll
        for (int i = 0; i < 8; ++i) cr[i] = (f32x4){0.f, 0.f, 0.f, 0.f};
#pragma unroll
        for (int dh = 0; dh < 2; ++dh) {
            __syncthreads();
            RT_STAGE(dh, dh == 0);
            __syncthreads();
            if (dh == 0) {
#pragma unroll
                for (int cbk = 0; cbk < 4; ++cbk) {
                    const LAS unsigned char* ap = lds + RT_V + (32 * cbk + 8 * g + qq) * RT_P + (16 * w + 4 * pp) * 2;
                    const s16x4 lo = tr_read(ap), hi4 = tr_read(ap + 4 * RT_P);
                    vf[cbk] = __builtin_shufflevector(lo, hi4, 0, 1, 2, 3, 4, 5, 6, 7);
                }
            }
#pragma unroll
            for (int kb = 0; kb < 4; ++kb) {
                const int kbg = 4 * dh + kb;
                u32x4 tp; tp.x = pk2(Tst[2 * kbg][0], Tst[2 * kbg][1]); tp.y = pk2(Tst[2 * kbg][2], Tst[2 * kbg][3]); tp.z = pk2(Tst[2 * kbg + 1][0], Tst[2 * kbg + 1][1]); tp.w = pk2(Tst[2 * kbg + 1][2], Tst[2 * kbg + 1][3]);
                const bf16x8 tb = __builtin_bit_cast(bf16x8, tp);
#pragma unroll
                for (int cb = 0; cb < 8; ++cb) {
                    const LAS unsigned char* qp = lds + RT_Q + (16 * cb + i16) * RT_P + (32 * kb + 4 * g) * 2;
                    const s16x4 lo = *(const LAS s16x4*)qp, hi4 = *(const LAS s16x4*)(qp + 32);
                    const bf16x8 aq = __builtin_shufflevector(lo, hi4, 0, 1, 2, 3, 4, 5, 6, 7);
                    cr[cb] = MFMA16(aq, tb, cr[cb]);
                }
                __builtin_amdgcn_sched_barrier(0);
            }
#pragma unroll
            for (int dtl = 0; dtl < 8; ++dtl) {
                const int dt = 8 * dh + dtl;
                Tst[dt] = Tst[dt] * g128;
#pragma unroll
                for (int cbk = 0; cbk < 4; ++cbk) {
                    const LAS unsigned char* ap = lds + RT_K + (32 * cbk + 8 * g + qq) * RT_P + (16 * dtl + 4 * pp) * 2;
                    const s16x4 lo = tr_read(ap), hi4 = tr_read(ap + 4 * RT_P);
                    const bf16x8 ak = __builtin_shufflevector(lo, hi4, 0, 1, 2, 3, 4, 5, 6, 7);
                    Tst[dt] = MFMA16(ak, vf[cbk], Tst[dt]);
                }
                __builtin_amdgcn_sched_barrier(0);
            }
        }
#pragma unroll
        for (int cb = 0; cb < 8; ++cb) cr[cb] = cr[cb] * g128;
#pragma unroll
        for (int cb = 0; cb < 8; ++cb)
#pragma unroll
            for (int mbk = 0; mbk < 4; ++mbk) if (32 * mbk <= 16 * cb + 15) {
                const bf16x8 ap = *(const LAS bf16x8*)(lds + RT_PS + (16 * cb + i16) * RT_P + (32 * mbk + 8 * g) * 2);
                cr[cb] = MFMA16(ap, vf[mbk], cr[cb]);
            }
        LAS float* ssq = (LAS float*)(lds + RT_SS);
#pragma unroll
        for (int cb = 0; cb < 8; ++cb)
#pragma unroll
            for (int j = 0; j < 4; ++j) {
                const int c = 16 * cb + 4 * g + j;
                const unsigned short ob = (unsigned short)(pk2(cr[cb][j], 0.f) & 0xffffu);
                if (!dry) RV[(rowbase + c0 + c) * 2048 + hh * 512 + es * 128 + 16 * w + i16] = ob;
                const float of = bf2f(ob); float s = of * of;
                s += __shfl_xor(s, 1); s += __shfl_xor(s, 2); s += __shfl_xor(s, 4); s += __shfl_xor(s, 8);
                if (i16 == 0) ssq[w * 128 + c] = s;
            }
        __syncthreads();
        if (tid < 128) { float s = 0.f;
#pragma unroll
            for (int ww = 0; ww < 8; ++ww) s += ssq[ww * 128 + tid];
            if (!dry) RS[(rowbase + c0 + tid) * 16 + hh * 4 + es] = s; }
    }
    __syncthreads();
}


constexpr int SC_P = 528;
DI void ret_scores_item(ldsp lds, const bf16* RQ, const bf16* RK, bf16* PG, int item) {
    const int tid = threadIdx.x, lane = tid & 63, w = __builtin_amdgcn_readfirstlane(tid >> 6), i16 = lane & 15, g = lane >> 4;
    const int ch = item & 15, hh = (item >> 4) & 3, b = item >> 6;
    const size_t grow0 = (size_t)b * S_ + ch * 128;
    __syncthreads();
#pragma unroll
    for (int t = 0; t < 2; ++t) {
        const bf16* src = (t ? RK : RQ) + grow0 * 1024 + hh * 256;
#pragma unroll
        for (int i = 0; i < 8; ++i) { const int idx = tid + 512 * i, row = idx >> 5, chunk = idx & 31;
            *(LAS u32x4*)(lds + t * (128 * SC_P) + row * SC_P + chunk * 16) = *(const u32x4*)(src + (size_t)row * 1024 + chunk * 8); }
        __builtin_amdgcn_sched_barrier(0);
    }
    __syncthreads();
    f32x4 sc[8];
#pragma unroll
    for (int i = 0; i < 8; ++i) sc[i] = (f32x4){0.f, 0.f, 0.f, 0.f};
#pragma unroll
    for (int kb = 0; kb < 8; ++kb) {
        const bf16x8 bq = *(const LAS bf16x8*)(lds + (16 * w + i16) * SC_P + (32 * kb + 8 * g) * 2);
#pragma unroll
        for (int mb = 0; mb < 8; ++mb) { const bf16x8 ak = *(const LAS bf16x8*)(lds + 128 * SC_P + (16 * mb + i16) * SC_P + (32 * kb + 8 * g) * 2); sc[mb] = MFMA16(ak, bq, sc[mb]); }
        __builtin_amdgcn_sched_barrier(0);
    }
    const int c = 16 * w + i16;
    bf16* prow = PG + (size_t)item * 16384 + c * 128;
#pragma unroll
    for (int mb = 0; mb < 8; ++mb) {
        const int m0 = 16 * mb + 4 * g;
        const float v0 = (m0 <= c) ? sc[mb][0] : 0.f, v1 = (m0 + 1 <= c) ? sc[mb][1] : 0.f, v2 = (m0 + 2 <= c) ? sc[mb][2] : 0.f, v3 = (m0 + 3 <= c) ? sc[mb][3] : 0.f;
        u32x2 pw; pw.x = pk2(v0, v1); pw.y = pk2(v2, v3);
        *(u32x2*)(prow + m0) = pw;
    }
}

constexpr int R2_RING = 0, R2_V = 65536, R2_P = 98304, R2_SS = 131072;
#define DMA16(gp, lp) __builtin_amdgcn_global_load_lds((const unsigned*)(gp), (LAS unsigned*)(lp), 16, 0, 0)
DI void retention_unit2(ldsp lds, const bf16* RQ, const bf16* RK, bf16* RV, const bf16* PG, float* RS, int b, int hh, int es) {
    const int tid = threadIdx.x, lane = tid & 63, w = __builtin_amdgcn_readfirstlane(tid >> 6), i16 = lane & 15, g = lane >> 4, qq = i16 >> 2, pp = i16 & 3;
    const size_t rowbase = (size_t)b * S_;
    const float g128 = exp2f(128.0f * __log2f(1.0f - exp2f(-5.0f - (float)hh)));
    const int r8 = lane >> 3;
    const int fq0 = (((r8 >> 1) & 1) << 1) | ((r8 >> 2) & 1);
    const unsigned char* qsrc = (const unsigned char*)(RQ + (rowbase + 16 * w) * 1024 + hh * 256);
    const unsigned char* ksrc = (const unsigned char*)(RK + (rowbase + 16 * w) * 1024 + hh * 256);
    const unsigned qc0 = (unsigned)(r8 * 1024 + ((lane & 7) ^ fq0) * 8) * 2u, qc1 = (unsigned)((r8 + 8) * 1024 + ((lane & 7) ^ (fq0 | 4)) * 8) * 2u;
    const int r4 = lane >> 4;
    const unsigned char* vsrc = (const unsigned char*)(RV + (rowbase + 16 * w) * 2048 + hh * 512 + es * 128);
    const unsigned char* psrc = (const unsigned char*)(PG + ((size_t)((b * 4 + hh) * 16) * 128 + 16 * w) * 128);
    unsigned voff[4], poff[4];
#pragma unroll
    for (int j = 0; j < 4; ++j) { const int row = 16 * w + 4 * j + r4; const int hs = 2 * ((row & 3) | (((row >> 3) & 1) << 2));
        voff[j] = (unsigned)((4 * j + r4) * 2048 + (((lane & 15) ^ hs) * 8)) * 2u; poff[j] = (unsigned)((4 * j + r4) * 128 + (((lane & 15) ^ (row & 15)) * 8)) * 2u; }
    const int fA0 = (((i16 >> 1) & 1) << 1) | ((i16 >> 2) & 1) | (((i16 >> 3) & 1) << 2);
    const int fT0 = (((qq >> 1) & 1) << 1) | ((g & 1) << 2);
    const int hV0 = 2 * (qq | ((g & 1) << 2));
    f32x4 Tst[16];
#pragma unroll
    for (int i = 0; i < 16; ++i) Tst[i] = (f32x4){0.f, 0.f, 0.f, 0.f};
    __syncthreads();
    {
        DMA16(qsrc + qc0, lds + R2_RING + (2 * w) * 1024); DMA16(qsrc + qc1, lds + R2_RING + (2 * w + 1) * 1024);
        DMA16(ksrc + qc0, lds + R2_RING + 16384 + (2 * w) * 1024); DMA16(ksrc + qc1, lds + R2_RING + 16384 + (2 * w + 1) * 1024);
#pragma unroll
        for (int j = 0; j < 4; ++j) DMA16(vsrc + voff[j], lds + R2_V + (4 * w + j) * 1024);
    }
    asm volatile("s_waitcnt vmcnt(0)" ::: "memory");
    __syncthreads();
    for (int ch = 0; ch < 16; ++ch) {
        const int c0 = ch * 128;
        f32x4 cr[8]; bf16x8 vf[4];
#pragma unroll
        for (int i = 0; i < 8; ++i) cr[i] = (f32x4){0.f, 0.f, 0.f, 0.f};
#pragma unroll
        for (int qd = 0; qd < 4; ++qd) {
            const int cur = qd & 1;
            int fA = fA0, fT = fT0, hV = hV0, lane_ = lane;
            asm volatile("" : "+v"(fA), "+v"(fT), "+v"(hV), "+v"(lane_));
            const int i16 = lane_ & 15, g = lane_ >> 4, qq = i16 >> 2, pp = i16 & 3;
            {
                const int nch = (qd == 3) ? ch + 1 : ch, nqd = (qd + 1) & 3;
                if (nch < 16) {
                    const size_t go = ((size_t)(nch * 128) * 1024 + nqd * 64) * 2;
                    const ldsp rb = lds + R2_RING + (cur ^ 1) * 32768;
                    DMA16(qsrc + go + qc0, rb + (2 * w) * 1024); DMA16(qsrc + go + qc1, rb + (2 * w + 1) * 1024);
                    DMA16(ksrc + go + qc0, rb + 16384 + (2 * w) * 1024); DMA16(ksrc + go + qc1, rb + 16384 + (2 * w + 1) * 1024);
                }
                if (qd == 0) {
#pragma unroll
                    for (int j = 0; j < 4; ++j) DMA16(psrc + (size_t)ch * 32768 + poff[j], lds + R2_P + (4 * w + j) * 1024);
                }
                if (qd == 1 && ch + 1 < 16) {
#pragma unroll
                    for (int j = 0; j < 4; ++j) DMA16(vsrc + (size_t)((ch + 1) * 128) * 4096 + voff[j], lds + R2_V + (4 * w + j) * 1024);
                }
            }
            const LAS unsigned char* Qb = lds + R2_RING + cur * 32768; const LAS unsigned char* Kb = Qb + 16384;
            if (qd == 0) {
#pragma unroll
                for (int cbk = 0; cbk < 4; ++cbk) {
                    const LAS unsigned char* ap = lds + R2_V + (32 * cbk + 8 * g + qq) * 256 + (((2 * w + (pp >> 1)) ^ hV) * 16) + 8 * (pp & 1);
                    const s16x4 lo = tr_read(ap), hi4 = tr_read(ap + 4 * 256);
                    vf[cbk] = __builtin_shufflevector(lo, hi4, 0, 1, 2, 3, 4, 5, 6, 7);
                }
            }
#pragma unroll
            for (int kb = 0; kb < 2; ++kb) {
                const int kbg = 2 * qd + kb;
                u32x4 tp; tp.x = pk2(Tst[2 * kbg][0], Tst[2 * kbg][1]); tp.y = pk2(Tst[2 * kbg][2], Tst[2 * kbg][3]); tp.z = pk2(Tst[2 * kbg + 1][0], Tst[2 * kbg + 1][1]); tp.w = pk2(Tst[2 * kbg + 1][2], Tst[2 * kbg + 1][3]);
                const bf16x8 tb = __builtin_bit_cast(bf16x8, tp);
                const int ol = (((4 * kb + (g >> 1)) ^ fA) * 16) + 8 * (g & 1), oh = (((4 * kb + (g >> 1) + 2) ^ fA) * 16) + 8 * (g & 1);
#pragma unroll
                for (int cb = 0; cb < 8; ++cb) {
                    const LAS unsigned char* qp = Qb + (16 * cb + i16) * 128;
                    const s16x4 lo = *(const LAS s16x4*)(qp + ol), hi4 = *(const LAS s16x4*)(qp + oh);
                    const bf16x8 aq = __builtin_shufflevector(lo, hi4, 0, 1, 2, 3, 4, 5, 6, 7);
                    cr[cb] = MFMA16(aq, tb, cr[cb]);
                }
                __builtin_amdgcn_sched_barrier(0);
            }
#pragma unroll
            for (int dtl = 0; dtl < 4; ++dtl) {
                const int dt = 4 * qd + dtl;
                Tst[dt] = Tst[dt] * g128;
                const int ot = (((2 * dtl + (pp >> 1)) ^ fT) * 16) + 8 * (pp & 1);
#pragma unroll
                for (int cbk = 0; cbk < 4; ++cbk) {
                    const LAS unsigned char* ap = Kb + (32 * cbk + 8 * g + qq) * 128;
                    const s16x4 lo = tr_read(ap + ot), hi4 = tr_read(ap + 4 * 128 + (ot ^ 16));
                    const bf16x8 ak = __builtin_shufflevector(lo, hi4, 0, 1, 2, 3, 4, 5, 6, 7);
                    Tst[dt] = MFMA16(ak, vf[cbk], Tst[dt]);
                }
                __builtin_amdgcn_sched_barrier(0);
            }
            asm volatile("s_waitcnt vmcnt(0)" ::: "memory");
            __syncthreads();
        }
#pragma unroll
        for (int cb = 0; cb < 8; ++cb) cr[cb] = cr[cb] * g128;
#pragma unroll
        for (int cb = 0; cb < 8; ++cb)
#pragma unroll
            for (int mbk = 0; mbk < 4; ++mbk) if (32 * mbk <= 16 * cb + 15) {
                const bf16x8 ap = *(const LAS bf16x8*)(lds + R2_P + (16 * cb + i16) * 256 + (((4 * mbk + g) ^ i16) * 16));
                cr[cb] = MFMA16(ap, vf[mbk], cr[cb]);
            }
        __syncthreads();
        {
            const ldsp ob = lds + R2_P + (16 * w + i16) * 2;
#pragma unroll
            for (int cb = 0; cb < 8; ++cb)
#pragma unroll
                for (int j = 0; j < 4; ++j) *(LAS unsigned short*)(ob + (16 * cb + 4 * g + j) * 256) = (unsigned short)(pk2(cr[cb][j], 0.f) & 0xffffu);
        }
        __syncthreads();
        {
            const int row = tid >> 2, seg = tid & 3;
            const LAS u32x4* src = (const LAS u32x4*)(lds + R2_P + row * 256 + seg * 64);
            u32x4* dst = (u32x4*)(RV + (rowbase + c0 + row) * 2048 + hh * 512 + es * 128 + seg * 32);
            float s = 0.f;
#pragma unroll
            for (int k = 0; k < 4; ++k) { const u32x4 v = src[k]; dst[k] = v; f32x4 fa, fb; unpack8(v, fa, fb);
                s += (fa[0] * fa[0] + fa[1] * fa[1]) + (fa[2] * fa[2] + fa[3] * fa[3]) + (fb[0] * fb[0] + fb[1] * fb[1]) + (fb[2] * fb[2] + fb[3] * fb[3]); }
            s += __shfl_xor(s, 1); s += __shfl_xor(s, 2);
            if (seg == 0) RS[(rowbase + c0 + row) * 16 + hh * 4 + es] = s;
        }
        __syncthreads();
    }
    __syncthreads();
}

#define GEMM_PHASE2(EpiT, E, Aptr, Bptr, N_, K_, A2ptr, SPLIT_) do { pg8::Gemm g_{(const pg8::bf16_t*)(Aptr), (const pg8::bf16_t*)(Bptr), T_, (N_), (K_), (const pg8::bf16_t*)(A2ptr), (SPLIT_)}; pg8::StaticOrder S_o; S_o.init(T_, (N_), G, (int)blockIdx.x); \
    pg8::gemm_phase<EpiT, pg8::StaticOrder, true, true>(lds, g_, S_o, (E)); } while (0)
#define GEMM_PHASE(EpiT, E, Aptr, Bptr, N_, K_) GEMM_PHASE2(EpiT, E, Aptr, Bptr, N_, K_, Aptr, (1 << 30))
#ifndef PH_LO
#define PH_LO 0
#endif
#ifndef PH_HI
#define PH_HI 99
#endif
DI void fast_grid_barrier(unsigned* ctr, unsigned target) {
    asm volatile("s_waitcnt vmcnt(0)" ::: "memory");
    __syncthreads();
    if (threadIdx.x == 0) {
        __builtin_amdgcn_fence(__ATOMIC_RELEASE, "agent");
        asm volatile("s_waitcnt vmcnt(0)" ::: "memory");
        __hip_atomic_fetch_add(ctr, 1u, __ATOMIC_RELAXED, __HIP_MEMORY_SCOPE_AGENT);
        while (__hip_atomic_load(ctr, __ATOMIC_RELAXED, __HIP_MEMORY_SCOPE_AGENT) < target) __builtin_amdgcn_s_sleep(1);
        __builtin_amdgcn_fence(__ATOMIC_ACQUIRE, "agent");
        asm volatile("s_waitcnt vmcnt(0)" ::: "memory");
    }
    __syncthreads();
}
typedef const __attribute__((address_space(4))) Args* kargp;
#if defined(__HIP_DEVICE_COMPILE__)
DI Args load_args() { kargp kp = (kargp)__builtin_amdgcn_kernarg_segment_ptr(); asm volatile("" : "+s"(kp)); Args a;
    a.x = kp->x; a.c = kp->c; a.w_ada = kp->w_ada; a.b_ada = kp->b_ada; a.g1 = kp->g1; a.w_in = kp->w_in; a.b_branch = kp->b_branch; a.w_sb = kp->w_sb; a.w_ret = kp->w_ret; a.w_out = kp->w_out;
    a.g2 = kp->g2; a.w_ffi = kp->w_ffi; a.w_ffo = kp->w_ffo; a.gf = kp->gf; a.out = kp->out; a.ws = kp->ws; return a; }
#else
DI Args load_args() { return Args{}; }
#endif
#define PHASE_ARGS const Args A = load_args(); unsigned char* const ws = A.ws; bf16* const hmix = (bf16*)A.out; (void)ws; (void)hmix
__global__ void __launch_bounds__(NTHR, 2) fwd_megakernel(Args Aunused) {
    extern __shared__ __attribute__((aligned(16))) unsigned char lds_raw[];
    ldsp lds = (ldsp)lds_raw;
    cg::grid_group grid = cg::this_grid();
    const int G = gridDim.x;
    unsigned bar_k = 0u;
#define GBAR() do { PHASE_ARGS; ++bar_k; fast_grid_barrier((unsigned*)(ws + WS_CTR) + 64, bar_k * (unsigned)G); } while (0)
#ifndef PHM
#define PHM 0xFFFFF
#endif
    if (PHM & 1) { PHASE_ARGS; if (blockIdx.x == 0 && threadIdx.x == 0) { __hip_atomic_store((unsigned*)(ws + WS_CTR), 0u, __ATOMIC_RELAXED, __HIP_MEMORY_SCOPE_AGENT); __hip_atomic_store((unsigned*)(ws + WS_CTR) + 64, 0u, __ATOMIC_RELAXED, __HIP_MEMORY_SCOPE_AGENT); } p0_prologue(A, lds, G); }
    grid.sync();
    if (PHM & 2) { PHASE_ARGS; norm_mod_phase<true>(A, lds, G, A.x, A.g1, hmix, 0); }
    GBAR();
    if (PHM & 4) { PHASE_ARGS; EpiInProj E{(bf16*)(ws + WS_SBQ), (bf16*)(ws + WS_SBK), (bf16*)(ws + WS_SBV), (bf16*)(ws + WS_RQ), (bf16*)(ws + WS_RK), (bf16*)(ws + WS_RV), (const float*)(ws + WS_COS), (const float*)(ws + WS_SIN)};
      GEMM_PHASE(EpiInProj, E, hmix, ws + WS_WIN, 7168, 1024); }
    GBAR();
    if (PHM & 8) { PHASE_ARGS; for (int it = blockIdx.x; it < 1024; it += G) ret_scores_item(lds, (const bf16*)(ws + WS_RQ), (const bf16*)(ws + WS_RK), (bf16*)((unsigned char*)A.out + 64 * MiB), it); }
    __syncthreads();
    if (PHM & 16) { PHASE_ARGS;
        const int wv = __builtin_amdgcn_readfirstlane(threadIdx.x >> 6);
        unsigned* ctr = (unsigned*)(ws + WS_CTR);
        for (;;) {
            unsigned uu = 0u;
            if ((threadIdx.x & 63) == 0) uu = __hip_atomic_fetch_add(ctr, 1u, __ATOMIC_RELAXED, __HIP_MEMORY_SCOPE_AGENT);
            const int u = __builtin_amdgcn_readfirstlane((int)uu);
            if (u >= 16384) break;
            sb_attn_wave(lds + wv * 16384, (const bf16*)(ws + WS_SBQ), (const bf16*)(ws + WS_SBK), (const bf16*)(ws + WS_SBV), (bf16*)(ws + WS_SBQ), u >> 10, (u >> 6) & 15, 63 - (u & 63));
        }
    }
    GBAR();
    if (PHM & 0x2000) { PHASE_ARGS; for (int u = blockIdx.x; u < 256; u += G) retention_unit2(lds, (const bf16*)(ws + WS_RQ), (const bf16*)(ws + WS_RK), (bf16*)(ws + WS_RV), (const bf16*)((unsigned char*)A.out + 64 * MiB), (float*)(ws + WS_RS), u >> 4, (u >> 2) & 3, u & 3); }
    GBAR();
    if (PHM & 32) { PHASE_ARGS; EpiGates E{(bf16*)(ws + WS_RV), (bf16*)(ws + WS_GATES), (const float*)(ws + WS_RS), A.b_branch, (bf16*)(ws + WS_M1)};
      GEMM_PHASE2(EpiGates, E, hmix, ws + WS_WIN + (size_t)7168 * 1024 * 2, 5120, 1024, ws + WS_SBQ, 16); }
    GBAR();
    if (PHM & 128) { PHASE_ARGS; EpiMerge2 E{(const bf16*)(ws + WS_GATES), (const bf16*)(ws + WS_M1), (bf16*)(ws + WS_MERGED)};
      GEMM_PHASE(EpiMerge2, E, ws + WS_RV, ws + WS_WRET, 1024, 2048); }
    GBAR();
    if (PHM & 256) { PHASE_ARGS; EpiResid E{A.x, A.out, (const float*)(ws + WS_MODF) + 2048};
      GEMM_PHASE(EpiResid, E, ws + WS_MERGED, ws + WS_WOUT, 1024, 1024); }
    GBAR();
    if (PHM & 512) { PHASE_ARGS; norm_mod_phase<false>(A, lds, G, A.out, A.g2, (bf16*)(ws + WS_HFFN), 3072); }
    GBAR();
    if (PHM & 1024) { PHASE_ARGS; EpiSwiglu E{(bf16*)(ws + WS_H)};
      GEMM_PHASE(EpiSwiglu, E, ws + WS_HFFN, ws + WS_WFFI, 2 * DFF, 1024); }
    GBAR();
    if (PHM & 2048) { PHASE_ARGS; EpiResid E{A.out, A.out, (const float*)(ws + WS_MODF) + 5120};
      GEMM_PHASE(EpiResid, E, ws + WS_H, ws + WS_WFFO, 1024, DFF); }
    GBAR();
    if (PHM & 4096) { PHASE_ARGS; final_norm_phase(A, G); }
}

extern "C" void kernel_launch(void* const* d_in, const int* in_sizes, int n_in, void* d_out, int out_size, void* d_ws, size_t ws_size, hipStream_t stream) {
    static int grid = 0;
    if (grid == 0) {
        if (n_in != 14 || in_sizes[0] != T_ * D_ || out_size != T_ * D_ || ws_size < WS_END) { fprintf(stderr, "kernel_launch: unexpected shapes / ws %zu\n", ws_size); grid = -1; return; }
        int dev = 0, cus = 0, per_cu = 0;
        hipGetDevice(&dev); hipDeviceGetAttribute(&cus, hipDeviceAttributeMultiprocessorCount, dev);
        if (hipFuncSetAttribute((const void*)fwd_megakernel, hipFuncAttributeMaxDynamicSharedMemorySize, LDS_BYTES) != hipSuccess) { fprintf(stderr, "hipFuncSetAttribute failed\n"); grid = -1; return; }
        if (hipOccupancyMaxActiveBlocksPerMultiprocessor(&per_cu, (const void*)fwd_megakernel, NTHR, LDS_BYTES) != hipSuccess || per_cu < 1) { fprintf(stderr, "occupancy query: %d\n", per_cu); per_cu = 1; }
        (void)hipGetLastError();
        grid = cus * per_cu;
    }
    if (grid < 0) return;
    Args a{};
    a.x = (const float*)d_in[0]; a.c = (const float*)d_in[1]; a.w_ada = (const float*)d_in[2]; a.b_ada = (const float*)d_in[3]; a.g1 = (const float*)d_in[4];
    a.w_in = (const float*)d_in[5]; a.b_branch = (const float*)d_in[6]; a.w_sb = (const float*)d_in[7]; a.w_ret = (const float*)d_in[8]; a.w_out = (const float*)d_in[9];
    a.g2 = (const float*)d_in[10]; a.w_ffi = (const float*)d_in[11]; a.w_ffo = (const float*)d_in[12]; a.gf = (const float*)d_in[13];
    a.out = (float*)d_out; a.ws = (unsigned char*)d_ws;
    void* args[] = {&a};
    hipError_t e = hipLaunchCooperativeKernel((const void*)fwd_megakernel, dim3(grid), dim3(NTHR), args, LDS_BYTES, stream);
    if (e != hipSuccess) fprintf(stderr, "cooperative launch failed: %s (grid %d)\n", hipGetErrorString(e), grid);
}
```

```cpp
#include <hip/hip_runtime.h>
#include <hip/hip_cooperative_groups.h>
#include <cstdio>
#include <cstdint>
namespace cg = cooperative_groups;
namespace pg8 {
#define PG8_LAS __attribute__((address_space(3)))
typedef unsigned short bf16_t;
typedef short bf16x8 __attribute__((ext_vector_type(8)));
typedef float f32x4 __attribute__((ext_vector_type(4)));
typedef unsigned u32x4 __attribute__((ext_vector_type(4)));
constexpr int BM = 256, BK = 64, HALF = 128, HTB = HALF * BK * 2  , STAGE_BYTES = 8 * HTB, NXCD = 8, WGM = 8;

__host__ __device__ __forceinline__ int lds_byte(int r, int c) { const int st = (r >> 4) * 2 + (c >> 5), rr = r & 15, cc = c & 31, ob = rr * 64 + cc * 2; return st * 1024 + (ob ^ (((ob >> 9) & 1) << 5)); }
__host__ __device__ __forceinline__ void stage_rc(int b, int& R, int& C) { const int st = b / 1024, sb = b % 1024, swz = sb ^ (((sb >> 9) & 1) << 5); R = (st >> 1) * 16 + swz / 64; C = (st & 1) * 32 + (swz % 64) / 2; }
__host__ __device__ __forceinline__ int perm32(int rho) { const int n = rho >> 4, i = rho & 15; return 8 * (i >> 2) + 4 * n + (i & 3); }

struct Unit { int pm, pn; };
struct Gemm { const bf16_t* A; const bf16_t* Bt; int M, N, K; const bf16_t* A2; int pn_split; };

struct StaticOrder {
    int nM, nN, nwg, G, c;
    __host__ __device__ void init(int M, int N, int G_, int c_) { nM = M / BM; nN = N / BM; nwg = nM * nN; G = G_; c = c_; }
    __host__ __device__ bool next(int i, Unit& u) const {
        const long L = (long)i * G + c; if (L >= nwg) return false;
        int wgid = (int)L; { const int q = nwg / NXCD, r = nwg % NXCD, xcd = wgid % NXCD, off = wgid / NXCD; wgid = (xcd < r ? xcd * (q + 1) : r * (q + 1) + (xcd - r) * q) + off; }
        const int nig = WGM * nN, gid = wgid / nig, fm = gid * WGM, gsz = (nM - fm) < WGM ? (nM - fm) : WGM;
        u.pm = fm + ((wgid % nig) % gsz); u.pn = (wgid % nig) / gsz; return true;
    }
    __device__ __forceinline__ void a_ready(const Unit&) const {}
    __device__ __forceinline__ void done(const Unit&) const {}
};

__device__ __forceinline__ unsigned cvt_pk_bf16(float lo, float hi) { unsigned r; asm volatile("v_cvt_pk_bf16_f32 %0, %1, %2" : "=v"(r) : "v"(lo), "v"(hi)); return r; }
template <class Epi, class Sched, bool ALIGN_EPI = false, bool SP2 = false>
__device__ __forceinline__ void gemm_phase(PG8_LAS unsigned char* lds, const Gemm g, const Sched& S, const Epi& E) {
    int tid_ = threadIdx.x; asm volatile("" : "+v"(tid_));
    const int tid = tid_, wid = __builtin_amdgcn_readfirstlane(tid >> 6), lane = tid & 63, wr = wid >> 2, wc = wid & 3, fr = lane & 15, fq = lane >> 4;
    const int K = g.K, nt = K / BK;
    unsigned voffA[2], voffB[2];
#pragma unroll
    for (int i = 0; i < 2; ++i) { int R, C; stage_rc(tid * 16 + i * 8192, R, C); const int Rb = Epi::PERM ? ((R & ~31) + perm32(R & 31)) : R;
        voffA[i] = (unsigned)(R * K + C) * 2u; voffB[i] = (unsigned)(Rb * K + C) * 2u; }
    const size_t kstep = (size_t)(BK * 2);
    const size_t hstep = (size_t)HALF * K * 2;
    const size_t tstep = 2 * hstep;
    const unsigned ldsw = (unsigned)wid * 1024u;
    const int aoff = lds_byte(wr * 64 + fr, fq * 8), boff = lds_byte(wc * 32 + fr, fq * 8);
#define PG8_SA(b, h) (((b) * 2 + (h)) * HTB)
#define PG8_SB(b, h) ((4 + (b) * 2 + (h)) * HTB)
#define PG8_STAGE(bufoff, gbase, voff) do { _Pragma("unroll") for (int _i = 0; _i < 2; ++_i) \
        __builtin_amdgcn_global_load_lds((const unsigned*)((const char*)(gbase) + (voff)[_i]), (PG8_LAS unsigned*)(lds + (bufoff) + ldsw + _i * 8192), 16, 0, 0); } while (0)
#define PG8_LDA(dst, b, h) do { _Pragma("unroll") for (int m = 0; m < 4; ++m) _Pragma("unroll") for (int k = 0; k < 2; ++k) dst[m][k] = *(const PG8_LAS bf16x8*)(lds + PG8_SA(b, h) + aoff + m * 2048 + k * 1024); } while (0)
#define PG8_LDB(dst, b, h) do { _Pragma("unroll") for (int n = 0; n < 2; ++n) _Pragma("unroll") for (int k = 0; k < 2; ++k) dst[n][k] = *(const PG8_LAS bf16x8*)(lds + PG8_SB(b, h) + boff + n * 2048 + k * 1024); } while (0)
#define PG8_MMA(ai, bj, At, Bt) do { __builtin_amdgcn_s_setprio(1); _Pragma("unroll") for (int m = 0; m < 4; ++m) _Pragma("unroll") for (int n = 0; n < 2; ++n) _Pragma("unroll") for (int k = 0; k < 2; ++k) \
        acc[ai][bj][m][n] = __builtin_amdgcn_mfma_f32_16x16x32_bf16(Bt[n][k], At[m][k], acc[ai][bj][m][n], 0, 0, 0); __builtin_amdgcn_s_setprio(0); } while (0)
#define PG8_WAIT_V(n) asm volatile("s_waitcnt vmcnt(" #n ")" ::: "memory")
#define PG8_WAIT_L(n) asm volatile("s_waitcnt lgkmcnt(" #n ")" ::: "memory")
#define PG8_BAR __builtin_amdgcn_s_barrier()
#define PG8_SCHED __builtin_amdgcn_sched_barrier(0)
    Unit cur, nxt; int ui = 0;
    if (!S.next(0, cur)) return;
    f32x4 acc[2][2][4][2];
#pragma unroll
    for (int a = 0; a < 2; ++a)
#pragma unroll
        for (int b = 0; b < 2; ++b)
#pragma unroll
            for (int m = 0; m < 4; ++m)
#pragma unroll
                for (int n = 0; n < 2; ++n) acc[a][b][m][n] = (f32x4){0.f, 0.f, 0.f, 0.f};
    bf16x8 At[4][2], B0[2][2], B1[2][2];
    const char* cA = (const char*)(cur.pn >= g.pn_split ? g.A2 : g.A) + (size_t)cur.pm * tstep; const char* cB = (const char*)g.Bt + (size_t)cur.pn * tstep;
    S.a_ready(cur);
    if constexpr (SP2) {
        PG8_STAGE(PG8_SB(0, 0), cB, voffB); PG8_STAGE(PG8_SB(0, 1), cB + hstep, voffB); PG8_STAGE(PG8_SA(0, 0), cA, voffA); PG8_STAGE(PG8_SA(0, 1), cA + hstep, voffA);
        if (wr == 1) PG8_BAR;
        PG8_WAIT_V(2); PG8_BAR;
        PG8_STAGE(PG8_SB(1, 0), cB + kstep, voffB); PG8_STAGE(PG8_SA(1, 0), cA + kstep, voffA); PG8_STAGE(PG8_SB(1, 1), cB + hstep + kstep, voffB);
        PG8_WAIT_V(6); PG8_BAR;
    } else {
        PG8_STAGE(PG8_SB(0, 0), cB, voffB); PG8_STAGE(PG8_SA(0, 0), cA, voffA); PG8_STAGE(PG8_SB(0, 1), cB + hstep, voffB); PG8_STAGE(PG8_SA(0, 1), cA + hstep, voffA);
        if (wr == 1) PG8_BAR;
        PG8_WAIT_V(4); PG8_BAR;
        PG8_STAGE(PG8_SB(1, 0), cB + kstep, voffB); PG8_STAGE(PG8_SA(1, 0), cA + kstep, voffA); PG8_STAGE(PG8_SB(1, 1), cB + hstep + kstep, voffB);
        PG8_WAIT_V(6); PG8_BAR;
    }
    for (;;) {
        const bool has_next = S.next(ui + 1, nxt);
        const char* nA = has_next ? (const char*)(nxt.pn >= g.pn_split ? g.A2 : g.A) + (size_t)nxt.pm * tstep : cA; const char* nB = has_next ? (const char*)g.Bt + (size_t)nxt.pn * tstep : cB;
        for (int t = 0; t < nt; t += 2) {
            const bool last = (t == nt - 2);
            const char* a1 = cA + (size_t)(t + 1) * kstep;
            const char* a2 = last ? nA : cA + (size_t)(t + 2) * kstep; const char* b2 = last ? nB : cB + (size_t)(t + 2) * kstep;
            const char* a3 = a2 + kstep; const char* b3 = b2 + kstep;
            if (last && has_next) S.a_ready(nxt);
            if constexpr (SP2) {
            PG8_LDB(B0, 0, 0); PG8_LDB(B1, 0, 1); PG8_SCHED; PG8_LDA(At, 0, 0); PG8_STAGE(PG8_SA(1, 1), a1 + hstep, voffA);
            PG8_WAIT_V(8); PG8_WAIT_L(0); PG8_BAR; PG8_MMA(0, 0, At, B0); PG8_MMA(0, 1, At, B1); PG8_BAR; PG8_SCHED;
            PG8_LDA(At, 0, 1); PG8_STAGE(PG8_SB(0, 0), b2, voffB); PG8_STAGE(PG8_SB(0, 1), b2 + hstep, voffB); PG8_STAGE(PG8_SA(0, 0), a2, voffA);
            PG8_WAIT_V(8); PG8_WAIT_L(0); PG8_BAR; PG8_MMA(1, 0, At, B0); PG8_MMA(1, 1, At, B1); PG8_BAR; PG8_SCHED;
            PG8_LDB(B0, 1, 0); PG8_LDB(B1, 1, 1); PG8_SCHED; PG8_LDA(At, 1, 0); PG8_STAGE(PG8_SA(0, 1), a2 + hstep, voffA);
            PG8_WAIT_V(8); PG8_WAIT_L(0); PG8_BAR; PG8_MMA(0, 0, At, B0); PG8_MMA(0, 1, At, B1); PG8_BAR; PG8_SCHED;
            PG8_LDA(At, 1, 1); PG8_STAGE(PG8_SB(1, 0), b3, voffB); PG8_STAGE(PG8_SB(1, 1), b3 + hstep, voffB); PG8_STAGE(PG8_SA(1, 0), a3, voffA);
            PG8_WAIT_V(8); PG8_WAIT_L(0); PG8_BAR; PG8_MMA(1, 0, At, B0); PG8_MMA(1, 1, At, B1); PG8_BAR; PG8_SCHED;
            } else {
            PG8_LDB(B0, 0, 0); PG8_SCHED; PG8_LDA(At, 0, 0); PG8_STAGE(PG8_SA(1, 1), a1 + hstep, voffA);
            PG8_WAIT_L(8); PG8_BAR; PG8_WAIT_L(0); PG8_MMA(0, 0, At, B0); PG8_BAR; PG8_SCHED;
            PG8_LDB(B1, 0, 1); PG8_STAGE(PG8_SB(0, 0), b2, voffB);
            PG8_BAR; PG8_WAIT_L(0); PG8_MMA(0, 1, At, B1); PG8_BAR;
            PG8_LDA(At, 0, 1); PG8_STAGE(PG8_SA(0, 0), a2, voffA);
            PG8_BAR; PG8_WAIT_L(0); PG8_MMA(1, 0, At, B0); PG8_BAR; PG8_SCHED;
            PG8_STAGE(PG8_SB(0, 1), b2 + hstep, voffB);
            PG8_WAIT_V(6); PG8_BAR; PG8_MMA(1, 1, At, B1); PG8_BAR;
            PG8_LDB(B0, 1, 0); PG8_SCHED; PG8_LDA(At, 1, 0); PG8_STAGE(PG8_SA(0, 1), a2 + hstep, voffA);
            PG8_WAIT_L(8); PG8_BAR; PG8_WAIT_L(0); PG8_MMA(0, 0, At, B0); PG8_BAR; PG8_SCHED;
            PG8_LDB(B1, 1, 1); PG8_STAGE(PG8_SB(1, 0), b3, voffB);
            PG8_BAR; PG8_WAIT_L(0); PG8_MMA(0, 1, At, B1); PG8_BAR;
            PG8_LDA(At, 1, 1); PG8_STAGE(PG8_SA(1, 0), a3, voffA);
            PG8_BAR; PG8_WAIT_L(0); PG8_MMA(1, 0, At, B0); PG8_BAR; PG8_SCHED;
            PG8_STAGE(PG8_SB(1, 1), b3 + hstep, voffB);
            PG8_WAIT_V(6); PG8_BAR; PG8_MMA(1, 1, At, B1); PG8_BAR;
            }
        }
        if constexpr (ALIGN_EPI) { if (wr == 0) PG8_BAR; }
        if constexpr (!Epi::AFTER_DRAIN) { E(acc, cur, wr, wc, fr, fq); S.done(cur); }
        if (!has_next) break;
#pragma unroll
        for (int a = 0; a < 2; ++a)
#pragma unroll
            for (int b = 0; b < 2; ++b)
#pragma unroll
                for (int m = 0; m < 4; ++m)
#pragma unroll
                    for (int n = 0; n < 2; ++n) acc[a][b][m][n] = (f32x4){0.f, 0.f, 0.f, 0.f};
        cur = nxt; cA = nA; cB = nB; ++ui;
        if constexpr (ALIGN_EPI) { if (wr == 1) PG8_BAR; }
    }
    PG8_WAIT_V(0);
    if constexpr (!ALIGN_EPI) { if (wr == 0) PG8_BAR; }
    PG8_BAR;
    if constexpr (Epi::AFTER_DRAIN) { E.fused(acc, cur, wr, wc, fr, fq, lds, wid, lane); S.done(cur); }
#undef PG8_SA
#undef PG8_SB
#undef PG8_STAGE
#undef PG8_LDA
#undef PG8_LDB
#undef PG8_MMA
#undef PG8_WAIT_V
#undef PG8_WAIT_L
#undef PG8_BAR
#undef PG8_SCHED
}
}

#define GAS __attribute__((address_space(1)))
#define LAS __attribute__((address_space(3)))
#define DI __device__ __forceinline__
typedef unsigned short bf16;
typedef unsigned u32x4 __attribute__((ext_vector_type(4)));
typedef unsigned u32x2 __attribute__((ext_vector_type(2)));
typedef float f32x4 __attribute__((ext_vector_type(4)));
typedef float f32x16 __attribute__((ext_vector_type(16)));
typedef short bf16x8 __attribute__((ext_vector_type(8)));
typedef short s16x4 __attribute__((ext_vector_type(4)));
typedef LAS unsigned char* ldsp;

constexpr int NWAVES = 8, NTHR = 512;
constexpr int T_ = 32768, D_ = 1024, S_ = 2048, NB = 16, DFF = 2816, INW = 11264, NMOD = 6144;
constexpr float EPS_ = 1e-6f;
constexpr size_t MiB = 1u << 20;
constexpr size_t WS_SBQ = 0, WS_SBK = 64 * MiB, WS_SBV = 128 * MiB, WS_RQ = 192 * MiB, WS_RK = 256 * MiB, WS_RV = 320 * MiB;
constexpr size_t WS_WIN = 448 * MiB, WS_WSB = 470 * MiB, WS_WRET = 472 * MiB, WS_WOUT = 476 * MiB, WS_WFFI = 478 * MiB, WS_WFFO = 489 * MiB;
constexpr size_t WS_CTR = 494 * MiB + 512 * 1024;
constexpr size_t WS_MODP = 495 * MiB, WS_MODF = 498 * MiB, WS_COS = 499 * MiB, WS_SIN = 500 * MiB, WS_RS = 501 * MiB, WS_END = 512 * MiB;
constexpr size_t WS_GATES = 64 * MiB, WS_M1 = 196 * MiB, WS_MERGED = 0, WS_HFFN = 0, WS_H = 64 * MiB;
constexpr int LDG = 2080, LDM1 = 1056;
constexpr int LDS_BYTES = 147456;

DI unsigned pk2(float lo, float hi) { return pg8::cvt_pk_bf16(lo, hi); }
DI float bf2f(unsigned short v) { return __uint_as_float((unsigned)v << 16); }
DI float bflo(unsigned w) { return __uint_as_float(w << 16); }
DI float bfhi(unsigned w) { return __uint_as_float(w & 0xffff0000u); }
DI float wave_sum(float v) {
#pragma unroll
    for (int o = 1; o < 64; o <<= 1) v += __shfl_xor(v, o);
    return v;
}
DI float fsigmoid(float v) { return 1.0f / (1.0f + __expf(-v)); }
DI u32x4 pack8(f32x4 a, f32x4 b) { u32x4 w; w.x = pk2(a[0], a[1]); w.y = pk2(a[2], a[3]); w.z = pk2(b[0], b[1]); w.w = pk2(b[2], b[3]); return w; }
DI void unpack8(u32x4 w, f32x4& a, f32x4& b) { a = (f32x4){bflo(w.x), bfhi(w.x), bflo(w.y), bfhi(w.y)}; b = (f32x4){bflo(w.z), bfhi(w.z), bflo(w.w), bfhi(w.w)}; }

struct Args {
    const float *x, *c, *w_ada, *b_ada, *g1, *w_in, *b_branch, *w_sb, *w_ret, *w_out, *g2, *w_ffi, *w_ffo, *gf;
    float* out; unsigned char* ws;
};

using pg8::Unit;
#define EPI_ARGS const f32x4 (&acc)[2][2][4][2], const Unit& u, int wr, int wc, int fr, int fq
struct EpiInProj {
    static constexpr bool PERM = true, AFTER_DRAIN = false;
    bf16 *sbq, *sbk, *sbv, *rq, *rk, *rv; const float *cosT, *sinT;
    DI void operator()(EPI_ARGS) const {
        const int pn = u.pn, row0 = u.pm * 256 + wr * 64 + fr, cw = wc * 32 + 8 * fq;
        if (pn < 12 || pn >= 20) {
            bf16* base; int ld = 1024, colt;
            if (pn < 4) { base = sbq; colt = pn * 256; } else if (pn < 8) { base = sbk; colt = (pn - 4) * 256; }
            else if (pn < 12) { base = sbv; colt = (pn - 8) * 256; } else { base = rv; ld = 2048; colt = (pn - 20) * 256; }
#pragma unroll
            for (int ai = 0; ai < 2; ++ai)
#pragma unroll
                for (int m = 0; m < 4; ++m) { bf16* rowp = base + (size_t)(row0 + ai * 128 + m * 16) * ld + colt + cw;
#pragma unroll
                    for (int bj = 0; bj < 2; ++bj) *(u32x4*)(rowp + bj * 128) = pack8(acc[ai][bj][m][0], acc[ai][bj][m][1]); }
        } else {
            const bool isk = pn >= 16; const int hh = isk ? pn - 16 : pn - 12; bf16* base = (isk ? rk : rq) + hh * 256 + cw;
            const float lg = __log2f(1.0f - exp2f(-5.0f - (float)hh));
            float fj[8];
#pragma unroll
            for (int e = 0; e < 8; ++e) fj[e] = exp2f(-(float)(cw + e) * (13.287712379549449f / 128.0f)) * 0.15915494309189535f;
#pragma unroll
            for (int ai = 0; ai < 2; ++ai)
#pragma unroll
                for (int m = 0; m < 4; ++m) {
                    const int row = row0 + ai * 128 + m * 16, pos = row & 2047, c = row & 127;
                    const float f = isk ? exp2f(-(float)c * lg) * 0.0625f : exp2f((float)c * lg);
                    bf16* rowp = base + (size_t)row * 1024;
                    f32x4 o1[2], o2[2];
#pragma unroll
                    for (int n = 0; n < 2; ++n) {
                        f32x4 cs, sn;
#pragma unroll
                        for (int e = 0; e < 4; ++e) { const float rev = __builtin_amdgcn_fractf((float)pos * fj[4 * n + e]); cs[e] = __builtin_amdgcn_cosf(rev) * f; sn[e] = __builtin_amdgcn_sinf(rev) * f; }
                        const f32x4 v1 = acc[ai][0][m][n], v2 = acc[ai][1][m][n];
                        o1[n] = v1 * cs - v2 * sn; o2[n] = v1 * sn + v2 * cs;
                    }
                    *(u32x4*)rowp = pack8(o1[0], o1[1]); *(u32x4*)(rowp + 128) = pack8(o2[0], o2[1]);
                }
        }
    }
};
struct EpiGates {
    static constexpr bool PERM = true, AFTER_DRAIN = false;
    bf16 *rv, *gates; const float *rs, *bb; bf16* m1;
    DI void operator()(EPI_ARGS) const {
        const int pn = u.pn, row0 = u.pm * 256 + wr * 64 + fr, cw = wc * 32 + 8 * fq;
        if (pn < 8) {
            const int head = pn >> 1;
#pragma unroll
            for (int ai = 0; ai < 2; ++ai) {
                f32x4 q[4]; u32x4 ov[4][2];
#pragma unroll
                for (int m = 0; m < 4; ++m) { const int row = row0 + ai * 128 + m * 16; q[m] = *(const f32x4*)(rs + (size_t)row * 16 + head * 4);
#pragma unroll
                    for (int bj = 0; bj < 2; ++bj) ov[m][bj] = *(const u32x4*)(rv + (size_t)row * 2048 + pn * 256 + bj * 128 + cw); }
#pragma unroll
                for (int m = 0; m < 4; ++m) {
                    const int row = row0 + ai * 128 + m * 16;
                    const float rsv = rsqrtf(((q[m][0] + q[m][1]) + (q[m][2] + q[m][3])) * (1.0f / 512.0f) + EPS_);
#pragma unroll
                    for (int bj = 0; bj < 2; ++bj) {
                        f32x4 oa, ob; unpack8(ov[m][bj], oa, ob);
                        f32x4 ga = acc[ai][bj][m][0], gb = acc[ai][bj][m][1];
#pragma unroll
                        for (int e = 0; e < 4; ++e) { ga[e] = ga[e] * fsigmoid(ga[e]) * oa[e] * rsv; gb[e] = gb[e] * fsigmoid(gb[e]) * ob[e] * rsv; }
                        *(u32x4*)(rv + (size_t)row * 2048 + pn * 256 + bj * 128 + cw) = pack8(ga, gb);
                    }
                }
            }
        } else if (pn < 16) {
#pragma unroll
            for (int bj = 0; bj < 2; ++bj) {
                const int col = (pn - 8) * 256 + bj * 128 + cw;
                const f32x4 b0 = *(const f32x4*)(bb + col), b1 = *(const f32x4*)(bb + col + 4);
#pragma unroll
                for (int ai = 0; ai < 2; ++ai)
#pragma unroll
                    for (int m = 0; m < 4; ++m) {
                        const int row = row0 + ai * 128 + m * 16;
                        f32x4 ga = acc[ai][bj][m][0] + b0, gb = acc[ai][bj][m][1] + b1;
#pragma unroll
                        for (int e = 0; e < 4; ++e) { ga[e] = fsigmoid(ga[e]); gb[e] = fsigmoid(gb[e]); }
                        *(u32x4*)(gates + (size_t)row * LDG + col) = pack8(ga, gb);
                    }
            }
        } else {
#pragma unroll
            for (int ai = 0; ai < 2; ++ai)
#pragma unroll
                for (int m = 0; m < 4; ++m) { bf16* rowp = m1 + (size_t)(row0 + ai * 128 + m * 16) * LDM1 + (pn - 16) * 256 + cw;
#pragma unroll
                    for (int bj = 0; bj < 2; ++bj) *(u32x4*)(rowp + bj * 128) = pack8(acc[ai][bj][m][0], acc[ai][bj][m][1]); }
        }
    }
};
struct EpiMerge2 {
    static constexpr bool PERM = true, AFTER_DRAIN = false;
    const bf16* gates; const bf16* m1; bf16* outp;
    DI void operator()(EPI_ARGS) const {
        const int row0 = u.pm * 256 + wr * 64 + fr, cw = wc * 32 + 8 * fq;
#pragma unroll
        for (int ai = 0; ai < 2; ++ai)
#pragma unroll
            for (int mp = 0; mp < 2; ++mp) {
                u32x4 gs[2][2], gr[2][2], pv[2][2];
#pragma unroll
                for (int mm = 0; mm < 2; ++mm)
#pragma unroll
                    for (int bj = 0; bj < 2; ++bj) { const int row = row0 + ai * 128 + (2 * mp + mm) * 16, col = u.pn * 256 + bj * 128 + cw;
                        gs[mm][bj] = *(const u32x4*)(gates + (size_t)row * LDG + col); gr[mm][bj] = *(const u32x4*)(gates + (size_t)row * LDG + 1024 + col);
                        pv[mm][bj] = *(const u32x4*)(m1 + (size_t)row * LDM1 + col); }
#pragma unroll
                for (int mm = 0; mm < 2; ++mm)
#pragma unroll
                    for (int bj = 0; bj < 2; ++bj) { const int m = 2 * mp + mm, row = row0 + ai * 128 + m * 16, col = u.pn * 256 + bj * 128 + cw;
                        f32x4 sa, sb, ra, rb, pa, pb; unpack8(gs[mm][bj], sa, sb); unpack8(gr[mm][bj], ra, rb); unpack8(pv[mm][bj], pa, pb);
                        *(u32x4*)(outp + (size_t)row * 1024 + col) = pack8(sa * pa + ra * acc[ai][bj][m][0], sb * pb + rb * acc[ai][bj][m][1]); }
            }
    }
};
struct EpiResid {
    static constexpr bool PERM = true, AFTER_DRAIN = false;
    const float* base; float* outp; const float* gate;
    DI void operator()(EPI_ARGS) const {
        const int row0 = u.pm * 256 + wr * 64 + fr, cw = wc * 32 + 8 * fq, b = u.pm >> 3;
        f32x4 gt[2][2];
#pragma unroll
        for (int bj = 0; bj < 2; ++bj) { const int col = u.pn * 256 + bj * 128 + cw; gt[bj][0] = *(const f32x4*)(gate + b * NMOD + col); gt[bj][1] = *(const f32x4*)(gate + b * NMOD + col + 4); }
#pragma unroll
        for (int ai = 0; ai < 2; ++ai)
#pragma unroll
            for (int mp = 0; mp < 2; ++mp) {
                f32x4 xv[2][2][2];
#pragma unroll
                for (int mm = 0; mm < 2; ++mm)
#pragma unroll
                    for (int bj = 0; bj < 2; ++bj) { const size_t off = (size_t)(row0 + ai * 128 + (2 * mp + mm) * 16) * 1024 + u.pn * 256 + bj * 128 + cw;
                        xv[mm][bj][0] = *(const f32x4*)(base + off); xv[mm][bj][1] = *(const f32x4*)(base + off + 4); }
#pragma unroll
                for (int mm = 0; mm < 2; ++mm)
#pragma unroll
                    for (int bj = 0; bj < 2; ++bj) { const int m = 2 * mp + mm; const size_t off = (size_t)(row0 + ai * 128 + m * 16) * 1024 + u.pn * 256 + bj * 128 + cw;
                        *(f32x4*)(outp + off) = xv[mm][bj][0] + gt[bj][0] * acc[ai][bj][m][0]; *(f32x4*)(outp + off + 4) = xv[mm][bj][1] + gt[bj][1] * acc[ai][bj][m][1]; }
            }
    }
};
struct EpiSwiglu {
    static constexpr bool PERM = true, AFTER_DRAIN = false;
    bf16* H;
    DI void operator()(EPI_ARGS) const {
        const int row0 = u.pm * 256 + wr * 64 + fr, cw = wc * 32 + 8 * fq;
#pragma unroll
        for (int ai = 0; ai < 2; ++ai)
#pragma unroll
            for (int m = 0; m < 4; ++m) {
                f32x4 a0 = acc[ai][0][m][0], a1 = acc[ai][0][m][1]; const f32x4 u0 = acc[ai][1][m][0], u1 = acc[ai][1][m][1];
#pragma unroll
                for (int e = 0; e < 4; ++e) { a0[e] = a0[e] * fsigmoid(a0[e]) * u0[e]; a1[e] = a1[e] * fsigmoid(a1[e]) * u1[e]; }
                *(u32x4*)(H + (size_t)(row0 + ai * 128 + m * 16) * DFF + u.pn * 128 + cw) = pack8(a0, a1);
            }
    }
};

DI int ffi_row(int n) { return n < DFF ? 256 * (n >> 7) + (n & 127) : 256 * ((n - DFF) >> 7) + 128 + ((n - DFF) & 127); }
DI void transpose_item(const float* W, int K, int N, bf16* WT, int mode, LAS float* scr, int item, int lane) {
    const int nblk = N / 32, kb = item / nblk, nb = item % nblk, k0 = 64 * kb, n0 = 32 * nb;
    const int d0 = mode ? ffi_row(n0) : n0;
#pragma unroll 8
    for (int i = 0; i < 32; ++i) { const int kk = 2 * i + (lane >> 5); scr[kk * 33 + (lane & 31)] = W[(size_t)(k0 + kk) * N + n0 + (lane & 31)]; }
    asm volatile("s_waitcnt lgkmcnt(0)" ::: "memory");
    const int c = lane & 7;
#pragma unroll
    for (int j = 0; j < 4; ++j) { const int n = (lane >> 3) + 8 * j; const LAS float* s = scr + (8 * c) * 33 + n;
        u32x4 o; o.x = pk2(s[0 * 33], s[1 * 33]); o.y = pk2(s[2 * 33], s[3 * 33]); o.z = pk2(s[4 * 33], s[5 * 33]); o.w = pk2(s[6 * 33], s[7 * 33]);
        *(u32x4*)(WT + (size_t)(d0 + n) * K + k0 + 8 * c) = o; }
    asm volatile("s_waitcnt lgkmcnt(0)" ::: "memory");
}
DI void p0_prologue(const Args& A, ldsp lds, int G) {
    const int tid = threadIdx.x, lane = tid & 63, wave = tid >> 6;
    LAS float* scr = (LAS float*)(lds + wave * 16384);
    const int gw = blockIdx.x * NWAVES + wave, NGW = G * NWAVES;
    unsigned char* ws = A.ws;
    constexpr int I_IN = (D_ / 64) * (INW / 32), I_SB = 16 * 32, I_RET = 32 * 32, I_OUT = 16 * 32, I_FFI = 16 * (2 * DFF / 32), I_FFO = (DFF / 64) * 32;
    constexpr int I_MOD = 96 * 8, I_ROPE = 2048 * 128 / 64;
    constexpr int NIT = I_IN + I_SB + I_RET + I_OUT + I_FFI + I_FFO + I_MOD + I_ROPE;
    for (int it = gw; it < NIT; it += NGW) {
        int r = it;
        if (r < I_IN) { transpose_item(A.w_in, D_, INW, (bf16*)(ws + WS_WIN), 0, scr, r, lane); continue; } r -= I_IN;
        if (r < I_SB) { transpose_item(A.w_sb, 1024, 1024, (bf16*)(ws + WS_WSB), 0, scr, r, lane); continue; } r -= I_SB;
        if (r < I_RET) { transpose_item(A.w_ret, 2048, 1024, (bf16*)(ws + WS_WRET), 0, scr, r, lane); continue; } r -= I_RET;
        if (r < I_OUT) { transpose_item(A.w_out, 1024, 1024, (bf16*)(ws + WS_WOUT), 0, scr, r, lane); continue; } r -= I_OUT;
        if (r < I_FFI) { transpose_item(A.w_ffi, 1024, 2 * DFF, (bf16*)(ws + WS_WFFI), 1, scr, r, lane); continue; } r -= I_FFI;
        if (r < I_FFO) { transpose_item(A.w_ffo, DFF, 1024, (bf16*)(ws + WS_WFFO), 0, scr, r, lane); continue; } r -= I_FFO;
        if (r < I_MOD) {
            const int eb = r % 96, ks = r / 96, d0 = ks * 128, e = eb * 64 + lane;
#pragma unroll 4
            for (int i = 0; i < 32; ++i) { const int idx = i * 64 + lane, b = idx >> 7, dd = idx & 127; const float cv = A.c[b * 1024 + d0 + dd]; scr[idx] = cv * fsigmoid(cv); }
            asm volatile("s_waitcnt lgkmcnt(0)" ::: "memory");
            float a[16];
#pragma unroll
            for (int b = 0; b < 16; ++b) a[b] = 0.f;
            for (int dd = 0; dd < 128; ++dd) { const float w = A.w_ada[(size_t)(d0 + dd) * NMOD + e];
#pragma unroll
                for (int b = 0; b < 16; ++b) a[b] += scr[b * 128 + dd] * w; }
            float* mp = (float*)(ws + WS_MODP) + (size_t)ks * NB * NMOD + e;
#pragma unroll
            for (int b = 0; b < 16; ++b) mp[b * NMOD] = a[b];
            asm volatile("s_waitcnt lgkmcnt(0)" ::: "memory");
            continue;
        } r -= I_MOD;
        {
            const int idx = r * 64 + lane, pos = idx >> 7, j = idx & 127;
            const float inv = exp2f(-(float)j * (13.287712379549449f / 128.0f));
            const float ang = (float)pos * inv;
            const float n = rintf(ang * 0.15915494309189535f);
            float rr = __builtin_fmaf(-n, 6.28125f, ang); rr = __builtin_fmaf(-n, 0.0019353071795864769f, rr);
            ((float*)(ws + WS_COS))[idx] = cosf(rr); ((float*)(ws + WS_SIN))[idx] = sinf(rr);
        }
    }
}
template <bool FIRST> DI void norm_mod_phase(const Args& A, ldsp lds, int G, const float* src, const float* gw_, bf16* dst, int shift_off) {
    const int tid = threadIdx.x, lane = tid & 63, wave = tid >> 6;
    LAS float* modl = (LAS float*)lds;
    const float* modp = (const float*)(A.ws + WS_MODP); float* modf = (float*)(A.ws + WS_MODF);
    for (int rb = blockIdx.x; rb < 256; rb += G) {
        const int b = rb >> 4;
        __syncthreads();
        for (int i = tid; i < 2048; i += NTHR) {
            float v;
            if (FIRST) { const int e = i; v = A.b_ada[e]; for (int ks = 0; ks < 8; ++ks) v += modp[(size_t)ks * NB * NMOD + b * NMOD + e]; }
            else v = modf[b * NMOD + shift_off + i];
            modl[i] = v;
        }
        if (FIRST && tid < 384) { const int idx = rb * 384 + tid, e = idx % NMOD; float v = A.b_ada[e]; for (int ks = 0; ks < 8; ++ks) v += modp[(size_t)ks * NB * NMOD + idx]; modf[idx] = v; }
        __syncthreads();
        for (int rr = 0; rr < 16; ++rr) {
            const int row = rb * 128 + wave * 16 + rr;
            const f32x4* xr = (const f32x4*)(src + (size_t)row * 1024) + lane;
            f32x4 v[4]; float s = 0.f;
#pragma unroll
            for (int j = 0; j < 4; ++j) { v[j] = xr[64 * j]; s += (v[j][0] * v[j][0] + v[j][1] * v[j][1]) + (v[j][2] * v[j][2] + v[j][3] * v[j][3]); }
            const float rstd = rsqrtf(wave_sum(s) * (1.0f / 1024.0f) + EPS_);
            unsigned long long* o8 = (unsigned long long*)(dst + (size_t)row * 1024) + lane;
#pragma unroll
            for (int j = 0; j < 4; ++j) {
                const int col = 4 * lane + 256 * j;
                const f32x4 g = *(const f32x4*)(gw_ + col); const f32x4 sh = *(const LAS f32x4*)(modl + col), sc = *(const LAS f32x4*)(modl + 1024 + col);
                const f32x4 y = v[j] * rstd * g * (sc + 1.0f) + sh;
                o8[64 * j] = (unsigned long long)pk2(y[0], y[1]) | ((unsigned long long)pk2(y[2], y[3]) << 32);
            }
        }
    }
    __syncthreads();
}
DI void final_norm_phase(const Args& A, int G) {
    const int tid = threadIdx.x, lane = tid & 63, wave = tid >> 6;
    const int gw = blockIdx.x * NWAVES + wave, NGW = G * NWAVES;
    for (int row = gw; row < T_; row += NGW) {
        f32x4* xr = (f32x4*)(A.out + (size_t)row * 1024) + lane;
        f32x4 v[4]; float s = 0.f;
#pragma unroll
        for (int j = 0; j < 4; ++j) { v[j] = xr[64 * j]; s += (v[j][0] * v[j][0] + v[j][1] * v[j][1]) + (v[j][2] * v[j][2] + v[j][3] * v[j][3]); }
        const float rstd = rsqrtf(wave_sum(s) * (1.0f / 1024.0f) + EPS_);
#pragma unroll
        for (int j = 0; j < 4; ++j) { const f32x4 g = *(const f32x4*)(A.gf + 4 * lane + 256 * j); xr[64 * j] = v[j] * rstd * g; }
    }
}

typedef short v4i16_t __attribute__((ext_vector_type(4)));
DI s16x4 tr_read(const LAS unsigned char* p) { return __builtin_bit_cast(s16x4, __builtin_amdgcn_ds_read_tr16_b64_v4i16((LAS v4i16_t*)p)); }
#define MFMA32(a, b, c) __builtin_amdgcn_mfma_f32_32x32x16_bf16((a), (b), (c), 0, 0, 0)
#define MFMA16(a, b, c) __builtin_amdgcn_mfma_f32_16x16x32_bf16((a), (b), (c), 0, 0, 0)
DI int crow(int r, int hi) { return (r & 3) + 8 * (r >> 2) + 4 * hi; }
DI bf16x8 pack_step(const f32x16& x, int s) {
    u32x4 p; p.x = pk2(x[8 * s], x[8 * s + 1]); p.y = pk2(x[8 * s + 2], x[8 * s + 3]); p.z = pk2(x[8 * s + 4], x[8 * s + 5]); p.w = pk2(x[8 * s + 6], x[8 * s + 7]);
    return __builtin_bit_cast(bf16x8, p);
}
constexpr int SB_PK = 144, SB_PV = 192;
constexpr int SB_KBYTES = 64 * SB_PK, SB_VBYTES = 64 * SB_PV, SB_BUF = SB_KBYTES + SB_VBYTES;
DI void sb_attn_unit(ldsp lds, const bf16* Q, const bf16* K, const bf16* V, bf16* O, int b, int h, int qb, int dry = 0) {
    const int tid = threadIdx.x, lane = tid & 63, wave = __builtin_amdgcn_readfirstlane(tid >> 6), r32 = lane & 31, hi = lane >> 5;
    const int t0 = qb * 256 + wave * 32, tq = t0 + r32;
    const size_t rowbase = (size_t)b * S_;
    bf16x8 qf[4];
#pragma unroll
    for (int ks = 0; ks < 4; ++ks) qf[ks] = *(const bf16x8*)(Q + (rowbase + tq) * 1024 + h * 64 + 16 * ks + 8 * hi);
    bf16x8 U0, U1, ONES;
#pragma unroll
    for (int jj = 0; jj < 8; ++jj) { const int k0 = 8 * (jj >> 2) + 4 * hi + (jj & 3); U0[jj] = (k0 >= r32) ? (short)0x3F80 : (short)0; U1[jj] = (16 + k0 >= r32) ? (short)0x3F80 : (short)0; ONES[jj] = (short)0x3F80; }
    f32x16 o0, o1;
#pragma unroll
    for (int i = 0; i < 16; ++i) { o0[i] = 0.f; o1[i] = 0.f; }
    float R2 = 0.f;
    const int ntiles = qb * 4 + 4;
    const int srow = tid >> 3, schunk = tid & 7;
    const bf16* kg = K + (rowbase + srow) * 1024 + h * 64 + schunk * 8; const bf16* vg = V + (rowbase + srow) * 1024 + h * 64 + schunk * 8;
    const int kso = srow * SB_PK + schunk * 16, vso = SB_KBYTES + srow * SB_PV + schunk * 16;
    LAS unsigned* doneF = (LAS unsigned*)(lds + 2 * SB_BUF);
    bool wdone = false;
    __syncthreads();
    { const int jt = ntiles - 1; const u32x4 kr = *(const u32x4*)(kg + (size_t)jt * 64 * 1024), vr = *(const u32x4*)(vg + (size_t)jt * 64 * 1024);
      *(LAS u32x4*)(lds + kso) = kr; *(LAS u32x4*)(lds + vso) = vr; }
    __syncthreads();
    const float C2 = 0.125f * 1.4426950408889634f;
    const int i16 = lane & 15, blk = (lane >> 4) & 1, qq = i16 >> 2, pp = i16 & 3;
    for (int jt = ntiles - 1; jt >= 0; --jt) {
        const int cur = (ntiles - 1 - jt) & 1;
        u32x4 kr, vr;
        if (jt > 0) { kr = *(const u32x4*)(kg + (size_t)(jt - 1) * 64 * 1024); vr = *(const u32x4*)(vg + (size_t)(jt - 1) * 64 * 1024); }
        if (!wdone && 64 * jt < t0 + 31) {
            const LAS unsigned char* Kb = lds + cur * SB_BUF; const LAS unsigned char* Vb = Kb + SB_KBYTES;
            const bool diag = (64 * jt + 63 >= t0);
            f32x16 z[2];
#pragma unroll
            for (int rb = 0; rb < 2; ++rb) {
#pragma unroll
                for (int i = 0; i < 16; ++i) z[rb][i] = 0.f;
#pragma unroll
                for (int ks = 0; ks < 4; ++ks) { const bf16x8 a = *(const LAS bf16x8*)(Kb + (32 * rb + r32) * SB_PK + (16 * ks + 8 * hi) * 2); z[rb] = MFMA32(a, qf[ks], z[rb]); }
            }
            float lsum = 0.f; f32x16 L[2];
#pragma unroll
            for (int rb = 0; rb < 2; ++rb)
#pragma unroll
                for (int i = 0; i < 16; ++i) {
                    const float z2 = z[rb][i] * C2;
                    const float e = __builtin_amdgcn_exp2f(-__builtin_fabsf(z2));
                    float l = -(__builtin_fmaxf(z2, 0.f) + __builtin_amdgcn_logf(1.0f + e));
                    if (diag) { const int s = 64 * jt + 32 * rb + crow(i, hi); if (!(s < tq)) l = 0.f; }
                    L[rb][i] = l; lsum += l; z[rb][i] = z2 + R2;
                }
            bf16x8 Lp[4];
#pragma unroll
            for (int q = 0; q < 4; ++q) Lp[q] = pack_step(L[q >> 1], q & 1);
            f32x16 la0 = MFMA32(U0, Lp[0], z[0]); la0 = MFMA32(U1, Lp[1], la0); la0 = MFMA32(ONES, Lp[2], la0); la0 = MFMA32(ONES, Lp[3], la0);
            f32x16 la1 = MFMA32(U0, Lp[2], z[1]); la1 = MFMA32(U1, Lp[3], la1);
#pragma unroll
            for (int i = 0; i < 16; ++i) {
                float a0 = __builtin_amdgcn_exp2f(la0[i]), a1 = __builtin_amdgcn_exp2f(la1[i]);
                if (diag) { const int s = 64 * jt + crow(i, hi); if (!(s < tq)) a0 = 0.f; if (!(s + 32 < tq)) a1 = 0.f; }
                la0[i] = a0; la1[i] = a1;
            }
            bf16x8 Ap[4]; Ap[0] = pack_step(la0, 0); Ap[1] = pack_step(la0, 1); Ap[2] = pack_step(la1, 0); Ap[3] = pack_step(la1, 1);
#pragma unroll
            for (int q = 0; q < 4; ++q) {
                const int key0 = 16 * q + 4 * hi;
#pragma unroll
                for (int db = 0; db < 2; ++db) {
                    const LAS unsigned char* ap = Vb + (key0 + qq) * SB_PV + (32 * db + 16 * blk + 4 * pp) * 2;
                    const s16x4 lo = tr_read(ap), hi4 = tr_read(ap + 8 * SB_PV);
                    const bf16x8 va = __builtin_shufflevector(lo, hi4, 0, 1, 2, 3, 4, 5, 6, 7);
                    if (db == 0) o0 = MFMA32(va, Ap[q], o0); else o1 = MFMA32(va, Ap[q], o1);
                }
            }
            R2 += lsum + __shfl_xor(lsum, 32);
            wdone = __all(R2 < -160.0f);
        }
        if (lane == 0) doneF[(jt & 1) * 8 + wave] = wdone ? 1u : 0u;
        if (jt > 0) { *(LAS u32x4*)(lds + (cur ^ 1) * SB_BUF + kso) = kr; *(LAS u32x4*)(lds + (cur ^ 1) * SB_BUF + vso) = vr; }
        __syncthreads();
        { const LAS u32x4* df = (const LAS u32x4*)(doneF + (jt & 1) * 8); const u32x4 f0 = df[0], f1 = df[1];
          if ((f0.x & f0.y & f0.z & f0.w & f1.x & f1.y & f1.z & f1.w) != 0u) break; }
    }
    bf16* op = O + (rowbase + tq) * 1024 + h * 64 + 4 * hi;
#pragma unroll
    for (int g = 0; g < 4; ++g) {
        u32x2 w0, w1; w0.x = pk2(o0[4 * g], o0[4 * g + 1]); w0.y = pk2(o0[4 * g + 2], o0[4 * g + 3]); w1.x = pk2(o1[4 * g], o1[4 * g + 1]); w1.y = pk2(o1[4 * g + 2], o1[4 * g + 3]);
        if (!dry) { *(u32x2*)(op + 8 * g) = w0; *(u32x2*)(op + 32 + 8 * g) = w1; }
    }
}


DI void sb_attn_wave(ldsp vl  , const bf16* Q, const bf16* K, const bf16* V, bf16* O, int b, int h, int rg) {
    const int lane = threadIdx.x & 63, r32 = lane & 31, hi = lane >> 5;
    const int t0 = rg * 32, tq = t0 + r32;
    const size_t rowbase = (size_t)b * S_;
    bf16x8 qf[4];
#pragma unroll
    for (int ks = 0; ks < 4; ++ks) qf[ks] = *(const bf16x8*)(Q + (rowbase + tq) * 1024 + h * 64 + 16 * ks + 8 * hi);
    bf16x8 U0, U1, ONES;
#pragma unroll
    for (int jj = 0; jj < 8; ++jj) { const int k0 = 8 * (jj >> 2) + 4 * hi + (jj & 3); U0[jj] = (k0 >= r32) ? (short)0x3F80 : (short)0; U1[jj] = (16 + k0 >= r32) ? (short)0x3F80 : (short)0; ONES[jj] = (short)0x3F80; }
    f32x16 o0, o1;
#pragma unroll
    for (int i = 0; i < 16; ++i) { o0[i] = 0.f; o1[i] = 0.f; }
    float R2 = 0.f;
    const int jtop = (t0 + 30) >> 6;
    const bf16* kg = K + (rowbase + r32) * 1024 + h * 64 + 8 * hi;
    const bf16* vg = V + (rowbase + (lane >> 3)) * 1024 + h * 64 + (((lane & 7) ^ ((((lane >> 3) >> 1) & 1) << 2)) * 8);
    const int i16 = lane & 15, blk = (lane >> 4) & 1, qq = i16 >> 2, pp = i16 & 3;
    const int vro = (4 * hi + qq) * 128 + (((2 * blk + (pp >> 1)) ^ (((qq >> 1) & 1) << 2)) * 16) + 8 * (pp & 1);
    bf16x8 kf[8];
#pragma unroll
    for (int i = 0; i < 8; ++i) __builtin_amdgcn_global_load_lds((const unsigned*)(vg + (size_t)(64 * jtop + 8 * i) * 1024), (LAS unsigned*)(vl + i * 1024), 16, 0, 0);
#pragma unroll
    for (int i = 0; i < 8; ++i) kf[i] = *(const bf16x8*)(kg + (size_t)(64 * jtop + 32 * (i >> 2)) * 1024 + 16 * (i & 3));
    const float C2 = 0.125f * 1.4426950408889634f;
    for (int jt = jtop; jt >= 0; --jt) {
        const int cur = (jtop - jt) & 1;
        asm volatile("s_waitcnt vmcnt(0)" ::: "memory");
        f32x16 z[2];
#pragma unroll
        for (int rb = 0; rb < 2; ++rb) {
#pragma unroll
            for (int i = 0; i < 16; ++i) z[rb][i] = 0.f;
#pragma unroll
            for (int ks = 0; ks < 4; ++ks) z[rb] = MFMA32(kf[rb * 4 + ks], qf[ks], z[rb]);
        }
        if (jt > 0) {
#pragma unroll
            for (int i = 0; i < 8; ++i) __builtin_amdgcn_global_load_lds((const unsigned*)(vg + (size_t)(64 * (jt - 1) + 8 * i) * 1024), (LAS unsigned*)(vl + (cur ^ 1) * 8192 + i * 1024), 16, 0, 0);
#pragma unroll
            for (int i = 0; i < 8; ++i) kf[i] = *(const bf16x8*)(kg + (size_t)(64 * (jt - 1) + 32 * (i >> 2)) * 1024 + 16 * (i & 3));
        }
        const bool diag = (jt == jtop);
        float lsum = 0.f; f32x16 L[2];
#pragma unroll
        for (int rb = 0; rb < 2; ++rb)
#pragma unroll
            for (int i = 0; i < 16; ++i) {
                const float z2 = z[rb][i] * C2;
                const float e = __builtin_amdgcn_exp2f(-__builtin_fabsf(z2));
                L[rb][i] = -(__builtin_fmaxf(z2, 0.f) + __builtin_amdgcn_logf(1.0f + e));
                z[rb][i] = z2 + R2;
            }
        if (diag) {
#pragma unroll
            for (int rb = 0; rb < 2; ++rb)
#pragma unroll
                for (int i = 0; i < 16; ++i) { const int s = 64 * jt + 32 * rb + crow(i, hi); if (!(s < tq)) L[rb][i] = 0.f; }
        }
#pragma unroll
        for (int i = 0; i < 16; ++i) lsum += L[0][i] + L[1][i];
        bf16x8 Lp[4];
#pragma unroll
        for (int q = 0; q < 4; ++q) Lp[q] = pack_step(L[q >> 1], q & 1);
        f32x16 la0 = MFMA32(U0, Lp[0], z[0]); la0 = MFMA32(U1, Lp[1], la0); la0 = MFMA32(ONES, Lp[2], la0); la0 = MFMA32(ONES, Lp[3], la0);
        f32x16 la1 = MFMA32(U0, Lp[2], z[1]); la1 = MFMA32(U1, Lp[3], la1);
#pragma unroll
        for (int i = 0; i < 16; ++i) { la0[i] = __builtin_amdgcn_exp2f(la0[i]); la1[i] = __builtin_amdgcn_exp2f(la1[i]); }
        if (diag) {
#pragma unroll
            for (int i = 0; i < 16; ++i) { const int s = 64 * jt + crow(i, hi); if (!(s < tq)) la0[i] = 0.f; if (!(s + 32 < tq)) la1[i] = 0.f; }
        }
        bf16x8 Ap[4]; Ap[0] = pack_step(la0, 0); Ap[1] = pack_step(la0, 1); Ap[2] = pack_step(la1, 0); Ap[3] = pack_step(la1, 1);
        const LAS unsigned char* vb = vl + cur * 8192 + vro;
#pragma unroll
        for (int q = 0; q < 4; ++q) {
#pragma unroll
            for (int db = 0; db < 2; ++db) {
                const LAS unsigned char* ap = (const LAS unsigned char*)((unsigned)(size_t)(vb + 2048 * q) ^ (unsigned)(64 * db));
                const s16x4 lo = tr_read(ap), hi4 = tr_read(ap + 1024);
                const bf16x8 va = __builtin_shufflevector(lo, hi4, 0, 1, 2, 3, 4, 5, 6, 7);
                if (db == 0) o0 = MFMA32(va, Ap[q], o0); else o1 = MFMA32(va, Ap[q], o1);
            }
        }
        R2 += lsum + __shfl_xor(lsum, 32);
        if (__all(R2 < -152.0f)) break;
    }
    asm volatile("s_waitcnt vmcnt(0)" ::: "memory");
    bf16* op = O + (rowbase + tq) * 1024 + h * 64 + 4 * hi;
#pragma unroll
    for (int g = 0; g < 4; ++g) {
        u32x2 w0, w1; w0.x = pk2(o0[4 * g], o0[4 * g + 1]); w0.y = pk2(o0[4 * g + 2], o0[4 * g + 3]); w1.x = pk2(o1[4 * g], o1[4 * g + 1]); w1.y = pk2(o1[4 * g + 2], o1[4 * g + 3]);
        *(u32x2*)(op + 8 * g) = w0; *(u32x2*)(op + 32 + 8 * g) = w1;
    }
}

constexpr int RT_P = 272;
constexpr int RT_TILE = 128 * RT_P, RT_Q = 0, RT_K = RT_TILE, RT_V = 2 * RT_TILE, RT_PS = 3 * RT_TILE, RT_SS = 4 * RT_TILE;
#define RT_STAGE(dh_, withv_) do { \
    const int row_ = tid >> 4, chunk_ = tid & 15; \
    const bf16* qg_ = RQ + (rowbase + c0 + row_) * 1024 + hh * 256 + (dh_) * 128 + chunk_ * 8; \
    const bf16* kg_ = RK + (rowbase + c0 + row_) * 1024 + hh * 256 + (dh_) * 128 + chunk_ * 8; \
    const ldsp lq_ = lds + row_ * RT_P + chunk_ * 16; \
    _Pragma("unroll") for (int i_ = 0; i_ < 4; ++i_) *(LAS u32x4*)(lq_ + RT_Q + i_ * 32 * RT_P) = *(const u32x4*)(qg_ + (size_t)i_ * 32 * 1024); \
    __builtin_amdgcn_sched_barrier(0); \
    _Pragma("unroll") for (int i_ = 0; i_ < 4; ++i_) *(LAS u32x4*)(lq_ + RT_K + i_ * 32 * RT_P) = *(const u32x4*)(kg_ + (size_t)i_ * 32 * 1024); \
    __builtin_amdgcn_sched_barrier(0); \
    if (withv_) { const bf16* vg_ = RV + (rowbase + c0 + row_) * 2048 + hh * 512 + es * 128 + chunk_ * 8; \
        _Pragma("unroll") for (int i_ = 0; i_ < 4; ++i_) *(LAS u32x4*)(lq_ + RT_V + i_ * 32 * RT_P) = *(const u32x4*)(vg_ + (size_t)i_ * 32 * 2048); } \
    __builtin_amdgcn_sched_barrier(0); } while (0)
DI void retention_unit(ldsp lds, const bf16* RQ, const bf16* RK, bf16* RV, float* RS, int b, int hh, int es, int dry = 0) {
    const int tid = threadIdx.x, lane = tid & 63, w = __builtin_amdgcn_readfirstlane(tid >> 6), i16 = lane & 15, g = lane >> 4, qq = i16 >> 2, pp = i16 & 3;
    const size_t rowbase = (size_t)b * S_;
    const float g128 = exp2f(128.0f * __log2f(1.0f - exp2f(-5.0f - (float)hh)));
    f32x4 Tst[16];
#pragma unroll
    for (int i = 0; i < 16; ++i) Tst[i] = (f32x4){0.f, 0.f, 0.f, 0.f};
    for (int ch = 0; ch < 16; ++ch) {
        const int c0 = ch * 128;
        {
            f32x4 sc[8];
#pragma unroll
            for (int i = 0; i < 8; ++i) sc[i] = (f32x4){0.f, 0.f, 0.f, 0.f};
#pragma unroll
            for (int dh = 0; dh < 2; ++dh) {
                __syncthreads();
                RT_STAGE(dh, false);
                __syncthreads();
#pragma unroll
                for (int kb = 0; kb < 4; ++kb) {
                    const bf16x8 bq = *(const LAS bf16x8*)(lds + RT_Q + (16 * w + i16) * RT_P + (32 * kb + 8 * g) * 2);
#pragma unroll
                    for (int mb = 0; mb < 8; ++mb) { const bf16x8 ak = *(const LAS bf16x8*)(lds + RT_K + (16 * mb + i16) * RT_P + (32 * kb + 8 * g) * 2); sc[mb] = MFMA16(ak, bq, sc[mb]); }
                    __builtin_amdgcn_sched_barrier(0);
                }
            }
            const int c = 16 * w + i16;
#pragma unroll
            for (int mb = 0; mb < 8; ++mb) {
                const int m0 = 16 * mb + 4 * g;
                const float v0 = (m0 <= c) ? sc[mb][0] : 0.f, v1 = (m0 + 1 <= c) ? sc[mb][1] : 0.f, v2 = (m0 + 2 <= c) ? sc[mb][2] : 0.f, v3 = (m0 + 3 <= c) ? sc[mb][3] : 0.f;
                u32x2 pw; pw.x = pk2(v0, v1); pw.y = pk2(v2, v3);
                *(LAS u32x2*)(lds + RT_PS + c * RT_P + m0 * 2) = pw;
            }
        }
        __builtin_amdgcn_sched_barrier(0);
        f32x4 cr[8]; bf16x8 vf[4];
#pragma unroll
        for (int i = 0; i < 8; ++i) cr[i] = (f32x4){0.f, 0.f, 0.f, 0.f};
#pragma unroll
        for (int dh = 0; dh < 2; ++dh) {
            __syncthreads();
            RT_STAGE(dh, dh == 0);
            __syncthreads();
            if (dh == 0) {
#pragma unroll
                for (int cbk = 0; cbk < 4; ++cbk) {
                    const LAS unsigned char* ap = lds + RT_V + (32 * cbk + 8 * g + qq) * RT_P + (16 * w + 4 * pp) * 2;
                    const s16x4 lo = tr_read(ap), hi4 = tr_read(ap + 4 * RT_P);
                    vf[cbk] = __builtin_shufflevector(lo, hi4, 0, 1, 2, 3, 4, 5, 6, 7);
                }
            }
#pragma unroll
            for (int kb = 0; kb < 4; ++kb) {
                const int kbg = 4 * dh + kb;
                u32x4 tp; tp.x = pk2(Tst[2 * kbg][0], Tst[2 * kbg][1]); tp.y = pk2(Tst[2 * kbg][2], Tst[2 * kbg][3]); tp.z = pk2(Tst[2 * kbg + 1][0], Tst[2 * kbg + 1][1]); tp.w = pk2(Tst[2 * kbg + 1][2], Tst[2 * kbg + 1][3]);
                const bf16x8 tb = __builtin_bit_cast(bf16x8, tp);
#pragma unroll
                for (int cb = 0; cb < 8; ++cb) {
                    const LAS unsigned char* qp = lds + RT_Q + (16 * cb + i16) * RT_P + (32 * kb + 4 * g) * 2;
                    const s16x4 lo = *(const LAS s16x4*)qp, hi4 = *(const LAS s16x4*)(qp + 32);
                    const bf16x8 aq = __builtin_shufflevector(lo, hi4, 0, 1, 2, 3, 4, 5, 6, 7);
                    cr[cb] = MFMA16(aq, tb, cr[cb]);
                }
                __builtin_amdgcn_sched_barrier(0);
            }
#pragma unroll
            for (int dtl = 0; dtl < 8; ++dtl) {
                const int dt = 8 * dh + dtl;
                Tst[dt] = Tst[dt] * g128;
#pragma unroll
                for (int cbk = 0; cbk < 4; ++cbk) {
                    const LAS unsigned char* ap = lds + RT_K + (32 * cbk + 8 * g + qq) * RT_P + (16 * dtl + 4 * pp) * 2;
                    const s16x4 lo = tr_read(ap), hi4 = tr_read(ap + 4 * RT_P);
                    const bf16x8 ak = __builtin_shufflevector(lo, hi4, 0, 1, 2, 3, 4, 5, 6, 7);
                    Tst[dt] = MFMA16(ak, vf[cbk], Tst[dt]);
                }
                __builtin_amdgcn_sched_barrier(0);
            }
        }
#pragma unroll
        for (int cb = 0; cb < 8; ++cb) cr[cb] = cr[cb] * g128;
#pragma unroll
        for (int cb = 0; cb < 8; ++cb)
#pragma unroll
            for (int mbk = 0; mbk < 4; ++mbk) if (32 * mbk <= 16 * cb + 15) {
                const bf16x8 ap = *(const LAS bf16x8*)(lds + RT_PS + (16 * cb + i16) * RT_P + (32 * mbk + 8 * g) * 2);
                cr[cb] = MFMA16(ap, vf[mbk], cr[cb]);
            }
        LAS float* ssq = (LAS float*)(lds + RT_SS);
#pragma unroll
        for (int cb = 0; cb < 8; ++cb)
#pragma unroll
            for (int j = 0; j < 4; ++j) {
                const int c = 16 * cb + 4 * g + j;
                const unsigned short ob = (unsigned short)(pk2(cr[cb][j], 0.f) & 0xffffu);
                if (!dry) RV[(rowbase + c0 + c) * 2048 + hh * 512 + es * 128 + 16 * w + i16] = ob;
                const float of = bf2f(ob); float s = of * of;
                s += __shfl_xor(s, 1); s += __shfl_xor(s, 2); s += __shfl_xor(s, 4); s += __shfl_xor(s, 8);
                if (i16 == 0) ssq[w * 128 + c] = s;
            }
        __syncthreads();
        if (tid < 128) { float s = 0.f;
#pragma unroll
            for (int ww = 0; ww < 8; ++ww) s += ssq[ww * 128 + tid];
            if (!dry) RS[(rowbase + c0 + tid) * 16 + hh * 4 + es] = s; }
    }
    __syncthreads();
}


constexpr int SC_P = 528;
DI void ret_scores_item(ldsp lds, const bf16* RQ, const bf16* RK, bf16* PG, int item) {
    const int tid = threadIdx.x, lane = tid & 63, w = __builtin_amdgcn_readfirstlane(tid >> 6), i16 = lane & 15, g = lane >> 4;
    const int ch = item & 15, hh = (item >> 4) & 3, b = item >> 6;
    const size_t grow0 = (size_t)b * S_ + ch * 128;
    __syncthreads();
#pragma unroll
    for (int t = 0; t < 2; ++t) {
        const bf16* src = (t ? RK : RQ) + grow0 * 1024 + hh * 256;
#pragma unroll
        for (int i = 0; i < 8; ++i) { const int idx = tid + 512 * i, row = idx >> 5, chunk = idx & 31;
            *(LAS u32x4*)(lds + t * (128 * SC_P) + row * SC_P + chunk * 16) = *(const u32x4*)(src + (size_t)row * 1024 + chunk * 8); }
        __builtin_amdgcn_sched_barrier(0);
    }
    __syncthreads();
    f32x4 sc[8];
#pragma unroll
    for (int i = 0; i < 8; ++i) sc[i] = (f32x4){0.f, 0.f, 0.f, 0.f};
#pragma unroll
    for (int kb = 0; kb < 8; ++kb) {
        const bf16x8 bq = *(const LAS bf16x8*)(lds + (16 * w + i16) * SC_P + (32 * kb + 8 * g) * 2);
#pragma unroll
        for (int mb = 0; mb < 8; ++mb) { const bf16x8 ak = *(const LAS bf16x8*)(lds + 128 * SC_P + (16 * mb + i16) * SC_P + (32 * kb + 8 * g) * 2); sc[mb] = MFMA16(ak, bq, sc[mb]); }
        __builtin_amdgcn_sched_barrier(0);
    }
    const int c = 16 * w + i16;
    bf16* prow = PG + (size_t)item * 16384 + c * 128;
#pragma unroll
    for (int mb = 0; mb < 8; ++mb) {
        const int m0 = 16 * mb + 4 * g;
        const float v0 = (m0 <= c) ? sc[mb][0] : 0.f, v1 = (m0 + 1 <= c) ? sc[mb][1] : 0.f, v2 = (m0 + 2 <= c) ? sc[mb][2] : 0.f, v3 = (m0 + 3 <= c) ? sc[mb][3] : 0.f;
        u32x2 pw; pw.x = pk2(v0, v1); pw.y = pk2(v2, v3);
        *(u32x2*)(prow + m0) = pw;
    }
}

constexpr int R2_RING = 0, R2_V = 65536, R2_P = 98304, R2_SS = 131072;
#define DMA16(gp, lp) __builtin_amdgcn_global_load_lds((const unsigned*)(gp), (LAS unsigned*)(lp), 16, 0, 0)
DI void retention_unit2(ldsp lds, const bf16* RQ, const bf16* RK, bf16* RV, const bf16* PG, float* RS, int b, int hh, int es) {
    const int tid = threadIdx.x, lane = tid & 63, w = __builtin_amdgcn_readfirstlane(tid >> 6), i16 = lane & 15, g = lane >> 4, qq = i16 >> 2, pp = i16 & 3;
    const size_t rowbase = (size_t)b * S_;
    const float g128 = exp2f(128.0f * __log2f(1.0f - exp2f(-5.0f - (float)hh)));
    const int r8 = lane >> 3;
    const int fq0 = (((r8 >> 1) & 1) << 1) | ((r8 >> 2) & 1);
    const unsigned char* qsrc = (const unsigned char*)(RQ + (rowbase + 16 * w) * 1024 + hh * 256);
    const unsigned char* ksrc = (const unsigned char*)(RK + (rowbase + 16 * w) * 1024 + hh * 256);
    const unsigned qc0 = (unsigned)(r8 * 1024 + ((lane & 7) ^ fq0) * 8) * 2u, qc1 = (unsigned)((r8 + 8) * 1024 + ((lane & 7) ^ (fq0 | 4)) * 8) * 2u;
    const int r4 = lane >> 4;
    const unsigned char* vsrc = (const unsigned char*)(RV + (rowbase + 16 * w) * 2048 + hh * 512 + es * 128);
    const unsigned char* psrc = (const unsigned char*)(PG + ((size_t)((b * 4 + hh) * 16) * 128 + 16 * w) * 128);
    unsigned voff[4], poff[4];
#pragma unroll
    for (int j = 0; j < 4; ++j) { const int row = 16 * w + 4 * j + r4; const int hs = 2 * ((row & 3) | (((row >> 3) & 1) << 2));
        voff[j] = (unsigned)((4 * j + r4) * 2048 + (((lane & 15) ^ hs) * 8)) * 2u; poff[j] = (unsigned)((4 * j + r4) * 128 + (((lane & 15) ^ (row & 15)) * 8)) * 2u; }
    const int fA0 = (((i16 >> 1) & 1) << 1) | ((i16 >> 2) & 1) | (((i16 >> 3) & 1) << 2);
    const int fT0 = (((qq >> 1) & 1) << 1) | ((g & 1) << 2);
    const int hV0 = 2 * (qq | ((g & 1) << 2));
    f32x4 Tst[16];
#pragma unroll
    for (int i = 0; i < 16; ++i) Tst[i] = (f32x4){0.f, 0.f, 0.f, 0.f};
    __syncthreads();
    {
        DMA16(qsrc + qc0, lds + R2_RING + (2 * w) * 1024); DMA16(qsrc + qc1, lds + R2_RING + (2 * w + 1) * 1024);
        DMA16(ksrc + qc0, lds + R2_RING + 16384 + (2 * w) * 1024); DMA16(ksrc + qc1, lds + R2_RING + 16384 + (2 * w + 1) * 1024);
#pragma unroll
        for (int j = 0; j < 4; ++j) DMA16(vsrc + voff[j], lds + R2_V + (4 * w + j) * 1024);
    }
    asm volatile("s_waitcnt vmcnt(0)" ::: "memory");
    __syncthreads();
    for (int ch = 0; ch < 16; ++ch) {
        const int c0 = ch * 128;
        f32x4 cr[8]; bf16x8 vf[4];
#pragma unroll
        for (int i = 0; i < 8; ++i) cr[i] = (f32x4){0.f, 0.f, 0.f, 0.f};
#pragma unroll
        for (int qd = 0; qd < 4; ++qd) {
            const int cur = qd & 1;
            int fA = fA0, fT = fT0, hV = hV0, lane_ = lane;
            asm volatile("" : "+v"(fA), "+v"(fT), "+v"(hV), "+v"(lane_));
            const int i16 = lane_ & 15, g = lane_ >> 4, qq = i16 >> 2, pp = i16 & 3;
            {
                const int nch = (qd == 3) ? ch + 1 : ch, nqd = (qd + 1) & 3;
                if (nch < 16) {
                    const size_t go = ((size_t)(nch * 128) * 1024 + nqd * 64) * 2;
                    const ldsp rb = lds + R2_RING + (cur ^ 1) * 32768;
                    DMA16(qsrc + go + qc0, rb + (2 * w) * 1024); DMA16(qsrc + go + qc1, rb + (2 * w + 1) * 1024);
                    DMA16(ksrc + go + qc0, rb + 16384 + (2 * w) * 1024); DMA16(ksrc + go + qc1, rb + 16384 + (2 * w + 1) * 1024);
                }
                if (qd == 0) {
#pragma unroll
                    for (int j = 0; j < 4; ++j) DMA16(psrc + (size_t)ch * 32768 + poff[j], lds + R2_P + (4 * w + j) * 1024);
                }
                if (qd == 1 && ch + 1 < 16) {
#pragma unroll
                    for (int j = 0; j < 4; ++j) DMA16(vsrc + (size_t)((ch + 1) * 128) * 4096 + voff[j], lds + R2_V + (4 * w + j) * 1024);
                }
            }
            const LAS unsigned char* Qb = lds + R2_RING + cur * 32768; const LAS unsigned char* Kb = Qb + 16384;
            if (qd == 0) {
#pragma unroll
                for (int cbk = 0; cbk < 4; ++cbk) {
                    const LAS unsigned char* ap = lds + R2_V + (32 * cbk + 8 * g + qq) * 256 + (((2 * w + (pp >> 1)) ^ hV) * 16) + 8 * (pp & 1);
                    const s16x4 lo = tr_read(ap), hi4 = tr_read(ap + 4 * 256);
                    vf[cbk] = __builtin_shufflevector(lo, hi4, 0, 1, 2, 3, 4, 5, 6, 7);
                }
            }
#pragma unroll
            for (int kb = 0; kb < 2; ++kb) {
                const int kbg = 2 * qd + kb;
                u32x4 tp; tp.x = pk2(Tst[2 * kbg][0], Tst[2 * kbg][1]); tp.y = pk2(Tst[2 * kbg][2], Tst[2 * kbg][3]); tp.z = pk2(Tst[2 * kbg + 1][0], Tst[2 * kbg + 1][1]); tp.w = pk2(Tst[2 * kbg + 1][2], Tst[2 * kbg + 1][3]);
                const bf16x8 tb = __builtin_bit_cast(bf16x8, tp);
                const int ol = (((4 * kb + (g >> 1)) ^ fA) * 16) + 8 * (g & 1), oh = (((4 * kb + (g >> 1) + 2) ^ fA) * 16) + 8 * (g & 1);
#pragma unroll
                for (int cb = 0; cb < 8; ++cb) {
                    const LAS unsigned char* qp = Qb + (16 * cb + i16) * 128;
                    const s16x4 lo = *(const LAS s16x4*)(qp + ol), hi4 = *(const LAS s16x4*)(qp + oh);
                    const bf16x8 aq = __builtin_shufflevector(lo, hi4, 0, 1, 2, 3, 4, 5, 6, 7);
                    cr[cb] = MFMA16(aq, tb, cr[cb]);
                }
                __builtin_amdgcn_sched_barrier(0);
            }
#pragma unroll
            for (int dtl = 0; dtl < 4; ++dtl) {
                const int dt = 4 * qd + dtl;
                Tst[dt] = Tst[dt] * g128;
                const int ot = (((2 * dtl + (pp >> 1)) ^ fT) * 16) + 8 * (pp & 1);
#pragma unroll
                for (int cbk = 0; cbk < 4; ++cbk) {
                    const LAS unsigned char* ap = Kb + (32 * cbk + 8 * g + qq) * 128;
                    const s16x4 lo = tr_read(ap + ot), hi4 = tr_read(ap + 4 * 128 + (ot ^ 16));
                    const bf16x8 ak = __builtin_shufflevector(lo, hi4, 0, 1, 2, 3, 4, 5, 6, 7);
                    Tst[dt] = MFMA16(ak, vf[cbk], Tst[dt]);
                }
                __builtin_amdgcn_sched_barrier(0);
            }
            asm volatile("s_waitcnt vmcnt(0)" ::: "memory");
            __syncthreads();
        }
#pragma unroll
        for (int cb = 0; cb < 8; ++cb) cr[cb] = cr[cb] * g128;
#pragma unroll
        for (int cb = 0; cb < 8; ++cb)
#pragma unroll
            for (int mbk = 0; mbk < 4; ++mbk) if (32 * mbk <= 16 * cb + 15) {
                const bf16x8 ap = *(const LAS bf16x8*)(lds + R2_P + (16 * cb + i16) * 256 + (((4 * mbk + g) ^ i16) * 16));
                cr[cb] = MFMA16(ap, vf[mbk], cr[cb]);
            }
        __syncthreads();
        {
            const ldsp ob = lds + R2_P + (16 * w + i16) * 2;
#pragma unroll
            for (int cb = 0; cb < 8; ++cb)
#pragma unroll
                for (int j = 0; j < 4; ++j) *(LAS unsigned short*)(ob + (16 * cb + 4 * g + j) * 256) = (unsigned short)(pk2(cr[cb][j], 0.f) & 0xffffu);
        }
        __syncthreads();
        {
            const int row = tid >> 2, seg = tid & 3;
            const LAS u32x4* src = (const LAS u32x4*)(lds + R2_P + row * 256 + seg * 64);
            u32x4* dst = (u32x4*)(RV + (rowbase + c0 + row) * 2048 + hh * 512 + es * 128 + seg * 32);
            float s = 0.f;
#pragma unroll
            for (int k = 0; k < 4; ++k) { const u32x4 v = src[k]; dst[k] = v; f32x4 fa, fb; unpack8(v, fa, fb);
                s += (fa[0] * fa[0] + fa[1] * fa[1]) + (fa[2] * fa[2] + fa[3] * fa[3]) + (fb[0] * fb[0] + fb[1] * fb[1]) + (fb[2] * fb[2] + fb[3] * fb[3]); }
            s += __shfl_xor(s, 1); s += __shfl_xor(s, 2);
            if (seg == 0) RS[(rowbase + c0 + row) * 16 + hh * 4 + es] = s;
        }
        __syncthreads();
    }
    __syncthreads();
}

#define GEMM_PHASE2(EpiT, E, Aptr, Bptr, N_, K_, A2ptr, SPLIT_) do { pg8::Gemm g_{(const pg8::bf16_t*)(Aptr), (const pg8::bf16_t*)(Bptr), T_, (N_), (K_), (const pg8::bf16_t*)(A2ptr), (SPLIT_)}; pg8::StaticOrder S_o; S_o.init(T_, (N_), G, (int)blockIdx.x); \
    pg8::gemm_phase<EpiT, pg8::StaticOrder, true, true>(lds, g_, S_o, (E)); } while (0)
#define GEMM_PHASE(EpiT, E, Aptr, Bptr, N_, K_) GEMM_PHASE2(EpiT, E, Aptr, Bptr, N_, K_, Aptr, (1 << 30))
#ifndef PH_LO
#define PH_LO 0
#endif
#ifndef PH_HI
#define PH_HI 99
#endif
#define XB_TMO      128
#define XB_XCNT(j)  (256  + 64 * (j))
#define XB_XSUB(j)  (1280 + 64 * (j))
#define XB_XGEN(j)  (2304 + 64 * (j))
#define XB_TOP      3328
#define XB_TOPGEN   3392
#define XCD_BAR_WORDS 3456
#define XB_SPIN_CAP (1u << 18)

__device__ __forceinline__ unsigned xb_ld(unsigned* p)              { return __hip_atomic_load(p, __ATOMIC_RELAXED, __HIP_MEMORY_SCOPE_AGENT); }
__device__ __forceinline__ unsigned xb_add(unsigned* p, unsigned v) { return __hip_atomic_fetch_add(p, v, __ATOMIC_RELAXED, __HIP_MEMORY_SCOPE_AGENT); }
__device__ __forceinline__ unsigned xb_xcc_id() { return (unsigned)__builtin_amdgcn_s_getreg((3 << 11) | 20) & 0xFu; }
#define XB_SPIN(cond, bar) do { unsigned _sp = 0; while (cond) { __builtin_amdgcn_s_sleep(1); \
    if ((++_sp & 255u) == 0u) { if (xb_ld(&(bar)[XB_TMO])) break; if (_sp > XB_SPIN_CAP) { atomicAdd(&(bar)[XB_TMO], 1u); break; } } } } while (0)

struct XcdBarrier {
    unsigned* bar; unsigned x;
    volatile LAS unsigned* st;
};

__device__ __forceinline__ XcdBarrier xcd_barrier_post(unsigned* bar, volatile LAS unsigned* st) {
    XcdBarrier b; b.bar = bar; b.x = xb_xcc_id(); b.st = st;
    if (threadIdx.x == 0) (void)xb_add(&bar[XB_XCNT(b.x)], 1u);
    return b;
}
__device__ __forceinline__ void xcd_barrier_complete(unsigned* bar, unsigned x, unsigned& nloc, unsigned& nx) {
    const unsigned G = gridDim.x * gridDim.y * gridDim.z;
    unsigned sum, cnt, mine, sp = 0u;
    for (;;) {
        sum = 0u; cnt = 0u; mine = 0u;
#pragma unroll
        for (unsigned j = 0; j < 16; ++j) { const unsigned c = xb_ld(&bar[XB_XCNT(j)]); sum += c; cnt += (c > 0u) ? 1u : 0u; mine = (j == x) ? c : mine; }
        if (sum == G) break;
        __builtin_amdgcn_s_sleep(1);
        if ((++sp & 255u) == 0u) { if (xb_ld(&bar[XB_TMO])) break; if (sp > XB_SPIN_CAP) { atomicAdd(&bar[XB_TMO], 1u); break; } }
    }
    nloc = mine > 0u ? mine : 1u; nx = cnt > 0u ? cnt : 1u;
}

__device__ __forceinline__ void xcd_barrier(const XcdBarrier& b) {
    asm volatile("s_waitcnt vmcnt(0)" ::: "memory");
    __syncthreads();
    if (threadIdx.x == 0) {
        unsigned* bar = b.bar;
        __builtin_amdgcn_s_waitcnt(0);
        unsigned nloc = b.st[0], nx = b.st[1];
        if (nloc == 0u) { xcd_barrier_complete(bar, b.x, nloc, nx); b.st[0] = nloc; b.st[1] = nx; }
        const unsigned old = xb_add(&bar[XB_XSUB(b.x)], 1u);
        const unsigned gen = old / nloc;
        if (old + 1u == (gen + 1u) * nloc) {
            __builtin_amdgcn_fence(__ATOMIC_RELEASE, "agent");
            asm volatile("s_waitcnt vmcnt(0)" ::: "memory");
            const unsigned og = xb_add(&bar[XB_TOP], 1u);
            const unsigned tg = og / nx;
            if (og + 1u == (tg + 1u) * nx) xb_add(&bar[XB_TOPGEN], 1u);
            else XB_SPIN(xb_ld(&bar[XB_TOPGEN]) == tg, bar);
            __builtin_amdgcn_fence(__ATOMIC_ACQUIRE, "agent");
            xb_add(&bar[XB_XGEN(b.x)], 1u);
            asm volatile("s_waitcnt vmcnt(0)" ::: "memory");
        } else {
            XB_SPIN(xb_ld(&bar[XB_XGEN(b.x)]) == gen, bar);
            __builtin_amdgcn_fence(__ATOMIC_ACQUIRE, "agent");
            asm volatile("s_waitcnt vmcnt(0)" ::: "memory");
        }
    }
    __syncthreads();
}

DI void fast_grid_barrier(unsigned* ctr, unsigned target) {
    asm volatile("s_waitcnt vmcnt(0)" ::: "memory");
    __syncthreads();
    if (threadIdx.x == 0) {
        __builtin_amdgcn_fence(__ATOMIC_RELEASE, "agent");
        asm volatile("s_waitcnt vmcnt(0)" ::: "memory");
        __hip_atomic_fetch_add(ctr, 1u, __ATOMIC_RELAXED, __HIP_MEMORY_SCOPE_AGENT);
        while (__hip_atomic_load(ctr, __ATOMIC_RELAXED, __HIP_MEMORY_SCOPE_AGENT) < target) __builtin_amdgcn_s_sleep(1);
        __builtin_amdgcn_fence(__ATOMIC_ACQUIRE, "agent");
        asm volatile("s_waitcnt vmcnt(0)" ::: "memory");
    }
    __syncthreads();
}
typedef const __attribute__((address_space(4))) Args* kargp;
#if defined(__HIP_DEVICE_COMPILE__)
DI Args load_args() { kargp kp = (kargp)__builtin_amdgcn_kernarg_segment_ptr(); asm volatile("" : "+s"(kp)); Args a;
    a.x = kp->x; a.c = kp->c; a.w_ada = kp->w_ada; a.b_ada = kp->b_ada; a.g1 = kp->g1; a.w_in = kp->w_in; a.b_branch = kp->b_branch; a.w_sb = kp->w_sb; a.w_ret = kp->w_ret; a.w_out = kp->w_out;
    a.g2 = kp->g2; a.w_ffi = kp->w_ffi; a.w_ffo = kp->w_ffo; a.gf = kp->gf; a.out = kp->out; a.ws = kp->ws; return a; }
#else
DI Args load_args() { return Args{}; }
#endif
#define PHASE_ARGS const Args A = load_args(); unsigned char* const ws = A.ws; bf16* const hmix = (bf16*)A.out; (void)ws; (void)hmix
__global__ void __launch_bounds__(NTHR, 2) fwd_megakernel(Args Aunused) {
    extern __shared__ __attribute__((aligned(16))) unsigned char lds_raw[];
    ldsp lds = (ldsp)lds_raw;
    cg::grid_group grid = cg::this_grid();
    const int G = gridDim.x;
    unsigned bar_k = 0u; (void)bar_k;
    volatile LAS unsigned* xb_st = (volatile LAS unsigned*)(lds + LDS_BYTES - 64);
    if (threadIdx.x < 2) xb_st[threadIdx.x] = 0u;
    XcdBarrier xbar; xbar.bar = nullptr; xbar.x = 0; xbar.st = xb_st;
#define GBAR() do { xcd_barrier(xbar); } while (0)
#ifndef PHM
#define PHM 0xFFFFF
#endif
    if (PHM & 1) { PHASE_ARGS; if (blockIdx.x == 0) { for (int i = threadIdx.x; i < XCD_BAR_WORDS; i += NTHR) __hip_atomic_store((unsigned*)(ws + WS_CTR) + 1024 + i, 0u, __ATOMIC_RELAXED, __HIP_MEMORY_SCOPE_AGENT); }
      if (blockIdx.x == 0 && threadIdx.x == 0) { __hip_atomic_store((unsigned*)(ws + WS_CTR), 0u, __ATOMIC_RELAXED, __HIP_MEMORY_SCOPE_AGENT); __hip_atomic_store((unsigned*)(ws + WS_CTR) + 64, 0u, __ATOMIC_RELAXED, __HIP_MEMORY_SCOPE_AGENT); } p0_prologue(A, lds, G); }
    grid.sync();
    { PHASE_ARGS; xbar = xcd_barrier_post((unsigned*)(ws + WS_CTR) + 1024, xb_st); }
    if (PHM & 2) { PHASE_ARGS; norm_mod_phase<true>(A, lds, G, A.x, A.g1, hmix, 0); }
    GBAR();
    if (PHM & 4) { PHASE_ARGS; EpiInProj E{(bf16*)(ws + WS_SBQ), (bf16*)(ws + WS_SBK), (bf16*)(ws + WS_SBV), (bf16*)(ws + WS_RQ), (bf16*)(ws + WS_RK), (bf16*)(ws + WS_RV), (const float*)(ws + WS_COS), (const float*)(ws + WS_SIN)};
      GEMM_PHASE(EpiInProj, E, hmix, ws + WS_WIN, 7168, 1024); }
    GBAR();
    if (PHM & 8) { PHASE_ARGS; for (int it = blockIdx.x; it < 1024; it += G) ret_scores_item(lds, (const bf16*)(ws + WS_RQ), (const bf16*)(ws + WS_RK), (bf16*)((unsigned char*)A.out + 64 * MiB), it); }
    __syncthreads();
    if (PHM & 16) { PHASE_ARGS;
        const int wv = __builtin_amdgcn_readfirstlane(threadIdx.x >> 6);
        unsigned* ctr = (unsigned*)(ws + WS_CTR);
        for (;;) {
            unsigned uu = 0u;
            if ((threadIdx.x & 63) == 0) uu = __hip_atomic_fetch_add(ctr, 1u, __ATOMIC_RELAXED, __HIP_MEMORY_SCOPE_AGENT);
            const int u = __builtin_amdgcn_readfirstlane((int)uu);
            if (u >= 16384) break;
            sb_attn_wave(lds + wv * 16384, (const bf16*)(ws + WS_SBQ), (const bf16*)(ws + WS_SBK), (const bf16*)(ws + WS_SBV), (bf16*)(ws + WS_SBQ), u >> 10, (u >> 6) & 15, 63 - (u & 63));
        }
    }
    GBAR();
    if (PHM & 0x2000) { PHASE_ARGS; for (int u = blockIdx.x; u < 256; u += G) retention_unit2(lds, (const bf16*)(ws + WS_RQ), (const bf16*)(ws + WS_RK), (bf16*)(ws + WS_RV), (const bf16*)((unsigned char*)A.out + 64 * MiB), (float*)(ws + WS_RS), u >> 4, (u >> 2) & 3, u & 3); }
    GBAR();
    if (PHM & 32) { PHASE_ARGS; EpiGates E{(bf16*)(ws + WS_RV), (bf16*)(ws + WS_GATES), (const float*)(ws + WS_RS), A.b_branch, (bf16*)(ws + WS_M1)};
      GEMM_PHASE2(EpiGates, E, hmix, ws + WS_WIN + (size_t)7168 * 1024 * 2, 5120, 1024, ws + WS_SBQ, 16); }
    GBAR();
    if (PHM & 128) { PHASE_ARGS; EpiMerge2 E{(const bf16*)(ws + WS_GATES), (const bf16*)(ws + WS_M1), (bf16*)(ws + WS_MERGED)};
      GEMM_PHASE(EpiMerge2, E, ws + WS_RV, ws + WS_WRET, 1024, 2048); }
    GBAR();
    if (PHM & 256) { PHASE_ARGS; EpiResid E{A.x, A.out, (const float*)(ws + WS_MODF) + 2048};
      GEMM_PHASE(EpiResid, E, ws + WS_MERGED, ws + WS_WOUT, 1024, 1024); }
    GBAR();
    if (PHM & 512) { PHASE_ARGS; norm_mod_phase<false>(A, lds, G, A.out, A.g2, (bf16*)(ws + WS_HFFN), 3072); }
    GBAR();
    if (PHM & 1024) { PHASE_ARGS; EpiSwiglu E{(bf16*)(ws + WS_H)};
      GEMM_PHASE(EpiSwiglu, E, ws + WS_HFFN, ws + WS_WFFI, 2 * DFF, 1024); }
    GBAR();
    if (PHM & 2048) { PHASE_ARGS; EpiResid E{A.out, A.out, (const float*)(ws + WS_MODF) + 5120};
      GEMM_PHASE(EpiResid, E, ws + WS_H, ws + WS_WFFO, 1024, DFF); }
    GBAR();
    if (PHM & 4096) { PHASE_ARGS; final_norm_phase(A, G); }
}

extern "C" void kernel_launch(void* const* d_in, const int* in_sizes, int n_in, void* d_out, int out_size, void* d_ws, size_t ws_size, hipStream_t stream) {
    static int grid = 0;
    if (grid == 0) {
        if (n_in != 14 || in_sizes[0] != T_ * D_ || out_size != T_ * D_ || ws_size < WS_END) { fprintf(stderr, "kernel_launch: unexpected shapes / ws %zu\n", ws_size); grid = -1; return; }
        int dev = 0, cus = 0, per_cu = 0;
        hipGetDevice(&dev); hipDeviceGetAttribute(&cus, hipDeviceAttributeMultiprocessorCount, dev);
        if (hipFuncSetAttribute((const void*)fwd_megakernel, hipFuncAttributeMaxDynamicSharedMemorySize, LDS_BYTES) != hipSuccess) { fprintf(stderr, "hipFuncSetAttribute failed\n"); grid = -1; return; }
        if (hipOccupancyMaxActiveBlocksPerMultiprocessor(&per_cu, (const void*)fwd_megakernel, NTHR, LDS_BYTES) != hipSuccess || per_cu < 1) { fprintf(stderr, "occupancy query: %d\n", per_cu); per_cu = 1; }
        (void)hipGetLastError();
        grid = cus * per_cu;
    }
    if (grid < 0) return;
    Args a{};
    a.x = (const float*)d_in[0]; a.c = (const float*)d_in[1]; a.w_ada = (const float*)d_in[2]; a.b_ada = (const float*)d_in[3]; a.g1 = (const float*)d_in[4];
    a.w_in = (const float*)d_in[5]; a.b_branch = (const float*)d_in[6]; a.w_sb = (const float*)d_in[7]; a.w_ret = (const float*)d_in[8]; a.w_out = (const float*)d_in[9];
    a.g2 = (const float*)d_in[10]; a.w_ffi = (const float*)d_in[11]; a.w_ffo = (const float*)d_in[12]; a.gf = (const float*)d_in[13];
    a.out = (float*)d_out; a.ws = (unsigned char*)d_ws;
    void* args[] = {&a};
    hipError_t e = hipLaunchCooperativeKernel((const void*)fwd_megakernel, dim3(grid), dim3(NTHR), args, LDS_BYTES, stream);
    if (e != hipSuccess) fprintf(stderr, "cooperative launch failed: %s (grid %d)\n", hipGetErrorString(e), grid);
}
```

```cpp
#include <hip/hip_runtime.h>
#include <hip/hip_cooperative_groups.h>
#include <cstdio>
#include <cstdint>
namespace cg = cooperative_groups;
namespace pg8 {
#define PG8_LAS __attribute__((address_space(3)))
typedef unsigned short bf16_t;
typedef short bf16x8 __attribute__((ext_vector_type(8)));
typedef float f32x4 __attribute__((ext_vector_type(4)));
typedef unsigned u32x4 __attribute__((ext_vector_type(4)));
constexpr int BM = 256, BK = 64, HALF = 128, HTB = HALF * BK * 2  , STAGE_BYTES = 8 * HTB, NXCD = 8, WGM = 8;

__host__ __device__ __forceinline__ int lds_byte(int r, int c) { const int st = (r >> 4) * 2 + (c >> 5), rr = r & 15, cc = c & 31, ob = rr * 64 + cc * 2; return st * 1024 + (ob ^ (((ob >> 9) & 1) << 5)); }
__host__ __device__ __forceinline__ void stage_rc(int b, int& R, int& C) { const int st = b / 1024, sb = b % 1024, swz = sb ^ (((sb >> 9) & 1) << 5); R = (st >> 1) * 16 + swz / 64; C = (st & 1) * 32 + (swz % 64) / 2; }
__host__ __device__ __forceinline__ int perm32(int rho) { const int n = rho >> 4, i = rho & 15; return 8 * (i >> 2) + 4 * n + (i & 3); }

struct Unit { int pm, pn; };
struct Gemm { const bf16_t* A; const bf16_t* Bt; int M, N, K; const bf16_t* A2; int pn_split; };

struct StaticOrder {
    int nM, nN, nwg, G, c;
    __host__ __device__ void init(int M, int N, int G_, int c_) { nM = M / BM; nN = N / BM; nwg = nM * nN; G = G_; c = c_; }
    __host__ __device__ bool next(int i, Unit& u) const {
        const long L = (long)i * G + c; if (L >= nwg) return false;
        int wgid = (int)L; { const int q = nwg / NXCD, r = nwg % NXCD, xcd = wgid % NXCD, off = wgid / NXCD; wgid = (xcd < r ? xcd * (q + 1) : r * (q + 1) + (xcd - r) * q) + off; }
        const int nig = WGM * nN, gid = wgid / nig, fm = gid * WGM, gsz = (nM - fm) < WGM ? (nM - fm) : WGM;
        u.pm = fm + ((wgid % nig) % gsz); u.pn = (wgid % nig) / gsz; return true;
    }
    __device__ __forceinline__ void a_ready(const Unit&) const {}
    __device__ __forceinline__ void done(const Unit&) const {}
};

__device__ __forceinline__ unsigned cvt_pk_bf16(float lo, float hi) { unsigned r; asm volatile("v_cvt_pk_bf16_f32 %0, %1, %2" : "=v"(r) : "v"(lo), "v"(hi)); return r; }
template <class Epi, class Sched, bool ALIGN_EPI = false, bool SP2 = false>
__device__ __forceinline__ void gemm_phase(PG8_LAS unsigned char* lds, const Gemm g, const Sched& S, const Epi& E) {
    int tid_ = threadIdx.x; asm volatile("" : "+v"(tid_));
    const int tid = tid_, wid = __builtin_amdgcn_readfirstlane(tid >> 6), lane = tid & 63, wr = wid >> 2, wc = wid & 3, fr = lane & 15, fq = lane >> 4;
    const int K = g.K, nt = K / BK;
    unsigned voffA[2], voffB[2];
#pragma unroll
    for (int i = 0; i < 2; ++i) { int R, C; stage_rc(tid * 16 + i * 8192, R, C); const int Rb = Epi::PERM ? ((R & ~31) + perm32(R & 31)) : R;
        voffA[i] = (unsigned)(R * K + C) * 2u; voffB[i] = (unsigned)(Rb * K + C) * 2u; }
    const size_t kstep = (size_t)(BK * 2);
    const size_t hstep = (size_t)HALF * K * 2;
    const size_t tstep = 2 * hstep;
    const unsigned ldsw = (unsigned)wid * 1024u;
    const int aoff = lds_byte(wr * 64 + fr, fq * 8), boff = lds_byte(wc * 32 + fr, fq * 8);
#define PG8_SA(b, h) (((b) * 2 + (h)) * HTB)
#define PG8_SB(b, h) ((4 + (b) * 2 + (h)) * HTB)
#define PG8_STAGE(bufoff, gbase, voff) do { _Pragma("unroll") for (int _i = 0; _i < 2; ++_i) \
        __builtin_amdgcn_global_load_lds((const unsigned*)((const char*)(gbase) + (voff)[_i]), (PG8_LAS unsigned*)(lds + (bufoff) + ldsw + _i * 8192), 16, 0, 0); } while (0)
#define PG8_LDA(dst, b, h) do { _Pragma("unroll") for (int m = 0; m < 4; ++m) _Pragma("unroll") for (int k = 0; k < 2; ++k) dst[m][k] = *(const PG8_LAS bf16x8*)(lds + PG8_SA(b, h) + aoff + m * 2048 + k * 1024); } while (0)
#define PG8_LDB(dst, b, h) do { _Pragma("unroll") for (int n = 0; n < 2; ++n) _Pragma("unroll") for (int k = 0; k < 2; ++k) dst[n][k] = *(const PG8_LAS bf16x8*)(lds + PG8_SB(b, h) + boff + n * 2048 + k * 1024); } while (0)
#define PG8_MMA(ai, bj, At, Bt) do { __builtin_amdgcn_s_setprio(1); _Pragma("unroll") for (int m = 0; m < 4; ++m) _Pragma("unroll") for (int n = 0; n < 2; ++n) _Pragma("unroll") for (int k = 0; k < 2; ++k) \
        acc[ai][bj][m][n] = __builtin_amdgcn_mfma_f32_16x16x32_bf16(Bt[n][k], At[m][k], acc[ai][bj][m][n], 0, 0, 0); __builtin_amdgcn_s_setprio(0); } while (0)
#define PG8_WAIT_V(n) asm volatile("s_waitcnt vmcnt(" #n ")" ::: "memory")
#define PG8_WAIT_L(n) asm volatile("s_waitcnt lgkmcnt(" #n ")" ::: "memory")
#define PG8_BAR __builtin_amdgcn_s_barrier()
#define PG8_SCHED __builtin_amdgcn_sched_barrier(0)
    Unit cur, nxt; int ui = 0;
    if (!S.next(0, cur)) return;
    f32x4 acc[2][2][4][2];
#pragma unroll
    for (int a = 0; a < 2; ++a)
#pragma unroll
        for (int b = 0; b < 2; ++b)
#pragma unroll
            for (int m = 0; m < 4; ++m)
#pragma unroll
                for (int n = 0; n < 2; ++n) acc[a][b][m][n] = (f32x4){0.f, 0.f, 0.f, 0.f};
    bf16x8 At[4][2], B0[2][2], B1[2][2];
    const char* cA = (const char*)(cur.pn >= g.pn_split ? g.A2 : g.A) + (size_t)cur.pm * tstep; const char* cB = (const char*)g.Bt + (size_t)cur.pn * tstep;
    S.a_ready(cur);
    if constexpr (SP2) {
        PG8_STAGE(PG8_SB(0, 0), cB, voffB); PG8_STAGE(PG8_SB(0, 1), cB + hstep, voffB); PG8_STAGE(PG8_SA(0, 0), cA, voffA); PG8_STAGE(PG8_SA(0, 1), cA + hstep, voffA);
        if (wr == 1) PG8_BAR;
        PG8_WAIT_V(2); PG8_BAR;
        PG8_STAGE(PG8_SB(1, 0), cB + kstep, voffB); PG8_STAGE(PG8_SA(1, 0), cA + kstep, voffA); PG8_STAGE(PG8_SB(1, 1), cB + hstep + kstep, voffB);
        PG8_WAIT_V(6); PG8_BAR;
    } else {
        PG8_STAGE(PG8_SB(0, 0), cB, voffB); PG8_STAGE(PG8_SA(0, 0), cA, voffA); PG8_STAGE(PG8_SB(0, 1), cB + hstep, voffB); PG8_STAGE(PG8_SA(0, 1), cA + hstep, voffA);
        if (wr == 1) PG8_BAR;
        PG8_WAIT_V(4); PG8_BAR;
        PG8_STAGE(PG8_SB(1, 0), cB + kstep, voffB); PG8_STAGE(PG8_SA(1, 0), cA + kstep, voffA); PG8_STAGE(PG8_SB(1, 1), cB + hstep + kstep, voffB);
        PG8_WAIT_V(6); PG8_BAR;
    }
    for (;;) {
        const bool has_next = S.next(ui + 1, nxt);
        const char* nA = has_next ? (const char*)(nxt.pn >= g.pn_split ? g.A2 : g.A) + (size_t)nxt.pm * tstep : cA; const char* nB = has_next ? (const char*)g.Bt + (size_t)nxt.pn * tstep : cB;
        for (int t = 0; t < nt; t += 2) {
            const bool last = (t == nt - 2);
            const char* a1 = cA + (size_t)(t + 1) * kstep;
            const char* a2 = last ? nA : cA + (size_t)(t + 2) * kstep; const char* b2 = last ? nB : cB + (size_t)(t + 2) * kstep;
            const char* a3 = a2 + kstep; const char* b3 = b2 + kstep;
            if (last && has_next) S.a_ready(nxt);
            if constexpr (SP2) {
            PG8_LDB(B0, 0, 0); PG8_LDB(B1, 0, 1); PG8_SCHED; PG8_LDA(At, 0, 0); PG8_STAGE(PG8_SA(1, 1), a1 + hstep, voffA);
            PG8_WAIT_V(8); PG8_WAIT_L(0); PG8_BAR; PG8_MMA(0, 0, At, B0); PG8_MMA(0, 1, At, B1); PG8_BAR; PG8_SCHED;
            PG8_LDA(At, 0, 1); PG8_STAGE(PG8_SB(0, 0), b2, voffB); PG8_STAGE(PG8_SB(0, 1), b2 + hstep, voffB); PG8_STAGE(PG8_SA(0, 0), a2, voffA);
            PG8_WAIT_V(8); PG8_WAIT_L(0); PG8_BAR; PG8_MMA(1, 0, At, B0); PG8_MMA(1, 1, At, B1); PG8_BAR; PG8_SCHED;
            PG8_LDB(B0, 1, 0); PG8_LDB(B1, 1, 1); PG8_SCHED; PG8_LDA(At, 1, 0); PG8_STAGE(PG8_SA(0, 1), a2 + hstep, voffA);
            PG8_WAIT_V(8); PG8_WAIT_L(0); PG8_BAR; PG8_MMA(0, 0, At, B0); PG8_MMA(0, 1, At, B1); PG8_BAR; PG8_SCHED;
            PG8_LDA(At, 1, 1); PG8_STAGE(PG8_SB(1, 0), b3, voffB); PG8_STAGE(PG8_SB(1, 1), b3 + hstep, voffB); PG8_STAGE(PG8_SA(1, 0), a3, voffA);
            PG8_WAIT_V(8); PG8_WAIT_L(0); PG8_BAR; PG8_MMA(1, 0, At, B0); PG8_MMA(1, 1, At, B1); PG8_BAR; PG8_SCHED;
            } else {
            PG8_LDB(B0, 0, 0); PG8_SCHED; PG8_LDA(At, 0, 0); PG8_STAGE(PG8_SA(1, 1), a1 + hstep, voffA);
            PG8_WAIT_L(8); PG8_BAR; PG8_WAIT_L(0); PG8_MMA(0, 0, At, B0); PG8_BAR; PG8_SCHED;
            PG8_LDB(B1, 0, 1); PG8_STAGE(PG8_SB(0, 0), b2, voffB);
            PG8_BAR; PG8_WAIT_L(0); PG8_MMA(0, 1, At, B1); PG8_BAR;
            PG8_LDA(At, 0, 1); PG8_STAGE(PG8_SA(0, 0), a2, voffA);
            PG8_BAR; PG8_WAIT_L(0); PG8_MMA(1, 0, At, B0); PG8_BAR; PG8_SCHED;
            PG8_STAGE(PG8_SB(0, 1), b2 + hstep, voffB);
            PG8_WAIT_V(6); PG8_BAR; PG8_MMA(1, 1, At, B1); PG8_BAR;
            PG8_LDB(B0, 1, 0); PG8_SCHED; PG8_LDA(At, 1, 0); PG8_STAGE(PG8_SA(0, 1), a2 + hstep, voffA);
            PG8_WAIT_L(8); PG8_BAR; PG8_WAIT_L(0); PG8_MMA(0, 0, At, B0); PG8_BAR; PG8_SCHED;
            PG8_LDB(B1, 1, 1); PG8_STAGE(PG8_SB(1, 0), b3, voffB);
            PG8_BAR; PG8_WAIT_L(0); PG8_MMA(0, 1, At, B1); PG8_BAR;
            PG8_LDA(At, 1, 1); PG8_STAGE(PG8_SA(1, 0), a3, voffA);
            PG8_BAR; PG8_WAIT_L(0); PG8_MMA(1, 0, At, B0); PG8_BAR; PG8_SCHED;
            PG8_STAGE(PG8_SB(1, 1), b3 + hstep, voffB);
            PG8_WAIT_V(6); PG8_BAR; PG8_MMA(1, 1, At, B1); PG8_BAR;
            }
        }
        if constexpr (ALIGN_EPI) { if (wr == 0) PG8_BAR; }
        if constexpr (!Epi::AFTER_DRAIN) { E(acc, cur, wr, wc, fr, fq); S.done(cur); }
        if (!has_next) break;
#pragma unroll
        for (int a = 0; a < 2; ++a)
#pragma unroll
            for (int b = 0; b < 2; ++b)
#pragma unroll
                for (int m = 0; m < 4; ++m)
#pragma unroll
                    for (int n = 0; n < 2; ++n) acc[a][b][m][n] = (f32x4){0.f, 0.f, 0.f, 0.f};
        cur = nxt; cA = nA; cB = nB; ++ui;
        if constexpr (ALIGN_EPI) { if (wr == 1) PG8_BAR; }
    }
    PG8_WAIT_V(0);
    if constexpr (!ALIGN_EPI) { if (wr == 0) PG8_BAR; }
    PG8_BAR;
    if constexpr (Epi::AFTER_DRAIN) { E.fused(acc, cur, wr, wc, fr, fq, lds, wid, lane); S.done(cur); }
#undef PG8_SA
#undef PG8_SB
#undef PG8_STAGE
#undef PG8_LDA
#undef PG8_LDB
#undef PG8_MMA
#undef PG8_WAIT_V
#undef PG8_WAIT_L
#undef PG8_BAR
#undef PG8_SCHED
}
}

#define GAS __attribute__((address_space(1)))
#define LAS __attribute__((address_space(3)))
#define DI __device__ __forceinline__
typedef unsigned short bf16;
typedef unsigned u32x4 __attribute__((ext_vector_type(4)));
typedef unsigned u32x2 __attribute__((ext_vector_type(2)));
typedef float f32x4 __attribute__((ext_vector_type(4)));
typedef float f32x16 __attribute__((ext_vector_type(16)));
typedef short bf16x8 __attribute__((ext_vector_type(8)));
typedef short s16x4 __attribute__((ext_vector_type(4)));
typedef LAS unsigned char* ldsp;

constexpr int NWAVES = 8, NTHR = 512;
constexpr int T_ = 32768, D_ = 1024, S_ = 2048, NB = 16, DFF = 2816, INW = 11264, NMOD = 6144;
constexpr float EPS_ = 1e-6f;
constexpr size_t MiB = 1u << 20;
constexpr size_t WS_SBQ = 0, WS_SBK = 64 * MiB, WS_SBV = 128 * MiB, WS_RQ = 192 * MiB, WS_RK = 256 * MiB, WS_RV = 320 * MiB;
constexpr size_t WS_WIN = 448 * MiB, WS_WSB = 470 * MiB, WS_WRET = 472 * MiB, WS_WOUT = 476 * MiB, WS_WFFI = 478 * MiB, WS_WFFO = 489 * MiB;
constexpr size_t WS_CTR = 494 * MiB + 512 * 1024;
constexpr size_t WS_MODP = 495 * MiB, WS_MODF = 498 * MiB, WS_COS = 499 * MiB, WS_SIN = 500 * MiB, WS_RS = 501 * MiB, WS_END = 512 * MiB;
constexpr size_t WS_GATES = 64 * MiB, WS_M1 = 196 * MiB, WS_MERGED = 0, WS_HFFN = 0, WS_H = 64 * MiB;
constexpr size_t WS_X2 = 320 * MiB;
constexpr int LDG = 2080, LDM1 = 1056;
constexpr int LDS_BYTES = 147456;

DI unsigned pk2(float lo, float hi) { return pg8::cvt_pk_bf16(lo, hi); }
DI float bf2f(unsigned short v) { return __uint_as_float((unsigned)v << 16); }
DI float bflo(unsigned w) { return __uint_as_float(w << 16); }
DI float bfhi(unsigned w) { return __uint_as_float(w & 0xffff0000u); }
DI float wave_sum(float v) {
#pragma unroll
    for (int o = 1; o < 64; o <<= 1) v += __shfl_xor(v, o);
    return v;
}
DI float fsigmoid(float v) { return 1.0f / (1.0f + __expf(-v)); }
DI u32x4 pack8(f32x4 a, f32x4 b) { u32x4 w; w.x = pk2(a[0], a[1]); w.y = pk2(a[2], a[3]); w.z = pk2(b[0], b[1]); w.w = pk2(b[2], b[3]); return w; }
DI void unpack8(u32x4 w, f32x4& a, f32x4& b) { a = (f32x4){bflo(w.x), bfhi(w.x), bflo(w.y), bfhi(w.y)}; b = (f32x4){bflo(w.z), bfhi(w.z), bflo(w.w), bfhi(w.w)}; }

struct Args {
    const float *x, *c, *w_ada, *b_ada, *g1, *w_in, *b_branch, *w_sb, *w_ret, *w_out, *g2, *w_ffi, *w_ffo, *gf;
    float* out; unsigned char* ws;
};

using pg8::Unit;
#define EPI_ARGS const f32x4 (&acc)[2][2][4][2], const Unit& u, int wr, int wc, int fr, int fq
struct EpiInProj {
    static constexpr bool PERM = true, AFTER_DRAIN = false;
    bf16 *sbq, *sbk, *sbv, *rq, *rk, *rv; const float *cosT, *sinT;
    DI void operator()(EPI_ARGS) const {
        const int pn = u.pn, row0 = u.pm * 256 + wr * 64 + fr, cw = wc * 32 + 8 * fq;
        if (pn < 12 || pn >= 20) {
            bf16* base; int ld = 1024, colt;
            if (pn < 4) { base = sbq; colt = pn * 256; } else if (pn < 8) { base = sbk; colt = (pn - 4) * 256; }
            else if (pn < 12) { base = sbv; colt = (pn - 8) * 256; } else { base = rv; ld = 2048; colt = (pn - 20) * 256; }
#pragma unroll
            for (int ai = 0; ai < 2; ++ai)
#pragma unroll
                for (int m = 0; m < 4; ++m) { bf16* rowp = base + (size_t)(row0 + ai * 128 + m * 16) * ld + colt + cw;
#pragma unroll
                    for (int bj = 0; bj < 2; ++bj) *(u32x4*)(rowp + bj * 128) = pack8(acc[ai][bj][m][0], acc[ai][bj][m][1]); }
        } else {
            const bool isk = pn >= 16; const int hh = isk ? pn - 16 : pn - 12; bf16* base = (isk ? rk : rq) + hh * 256 + cw;
            const float lg = __log2f(1.0f - exp2f(-5.0f - (float)hh));
            float fj[8];
#pragma unroll
            for (int e = 0; e < 8; ++e) fj[e] = exp2f(-(float)(cw + e) * (13.287712379549449f / 128.0f)) * 0.15915494309189535f;
#pragma unroll
            for (int ai = 0; ai < 2; ++ai)
#pragma unroll
                for (int m = 0; m < 4; ++m) {
                    const int row = row0 + ai * 128 + m * 16, pos = row & 2047, c = row & 127;
                    const float f = isk ? exp2f(-(float)c * lg) * 0.0625f : exp2f((float)c * lg);
                    bf16* rowp = base + (size_t)row * 1024;
                    f32x4 o1[2], o2[2];
#pragma unroll
                    for (int n = 0; n < 2; ++n) {
                        f32x4 cs, sn;
#pragma unroll
                        for (int e = 0; e < 4; ++e) { const float rev = __builtin_amdgcn_fractf((float)pos * fj[4 * n + e]); cs[e] = __builtin_amdgcn_cosf(rev) * f; sn[e] = __builtin_amdgcn_sinf(rev) * f; }
                        const f32x4 v1 = acc[ai][0][m][n], v2 = acc[ai][1][m][n];
                        o1[n] = v1 * cs - v2 * sn; o2[n] = v1 * sn + v2 * cs;
                    }
                    *(u32x4*)rowp = pack8(o1[0], o1[1]); *(u32x4*)(rowp + 128) = pack8(o2[0], o2[1]);
                }
        }
    }
};
struct EpiGates {
    static constexpr bool PERM = true, AFTER_DRAIN = false;
    bf16 *rv, *gates; const float *rs, *bb; bf16* m1;
    DI void operator()(EPI_ARGS) const {
        const int pn = u.pn, row0 = u.pm * 256 + wr * 64 + fr, cw = wc * 32 + 8 * fq;
        if (pn < 8) {
            const int head = pn >> 1;
#pragma unroll
            for (int ai = 0; ai < 2; ++ai) {
                f32x4 q[4]; u32x4 ov[4][2];
#pragma unroll
                for (int m = 0; m < 4; ++m) { const int row = row0 + ai * 128 + m * 16; q[m] = *(const f32x4*)(rs + (size_t)row * 16 + head * 4);
#pragma unroll
                    for (int bj = 0; bj < 2; ++bj) ov[m][bj] = *(const u32x4*)(rv + (size_t)row * 2048 + pn * 256 + bj * 128 + cw); }
#pragma unroll
                for (int m = 0; m < 4; ++m) {
                    const int row = row0 + ai * 128 + m * 16;
                    const float rsv = rsqrtf(((q[m][0] + q[m][1]) + (q[m][2] + q[m][3])) * (1.0f / 512.0f) + EPS_);
#pragma unroll
                    for (int bj = 0; bj < 2; ++bj) {
                        f32x4 oa, ob; unpack8(ov[m][bj], oa, ob);
                        f32x4 ga = acc[ai][bj][m][0], gb = acc[ai][bj][m][1];
#pragma unroll
                        for (int e = 0; e < 4; ++e) { ga[e] = ga[e] * fsigmoid(ga[e]) * oa[e] * rsv; gb[e] = gb[e] * fsigmoid(gb[e]) * ob[e] * rsv; }
                        *(u32x4*)(rv + (size_t)row * 2048 + pn * 256 + bj * 128 + cw) = pack8(ga, gb);
                    }
                }
            }
        } else if (pn < 16) {
#pragma unroll
            for (int bj = 0; bj < 2; ++bj) {
                const int col = (pn - 8) * 256 + bj * 128 + cw;
                const f32x4 b0 = *(const f32x4*)(bb + col), b1 = *(const f32x4*)(bb + col + 4);
#pragma unroll
                for (int ai = 0; ai < 2; ++ai)
#pragma unroll
                    for (int m = 0; m < 4; ++m) {
                        const int row = row0 + ai * 128 + m * 16;
                        f32x4 ga = acc[ai][bj][m][0] + b0, gb = acc[ai][bj][m][1] + b1;
#pragma unroll
                        for (int e = 0; e < 4; ++e) { ga[e] = fsigmoid(ga[e]); gb[e] = fsigmoid(gb[e]); }
                        *(u32x4*)(gates + (size_t)row * LDG + col) = pack8(ga, gb);
                    }
            }
        } else {
#pragma unroll
            for (int ai = 0; ai < 2; ++ai)
#pragma unroll
                for (int m = 0; m < 4; ++m) { bf16* rowp = m1 + (size_t)(row0 + ai * 128 + m * 16) * LDM1 + (pn - 16) * 256 + cw;
#pragma unroll
                    for (int bj = 0; bj < 2; ++bj) *(u32x4*)(rowp + bj * 128) = pack8(acc[ai][bj][m][0], acc[ai][bj][m][1]); }
        }
    }
};
struct EpiMerge2 {
    static constexpr bool PERM = true, AFTER_DRAIN = false;
    const bf16* gates; const bf16* m1; bf16* outp;
    DI void operator()(EPI_ARGS) const {
        const int row0 = u.pm * 256 + wr * 64 + fr, cw = wc * 32 + 8 * fq;
#pragma unroll
        for (int ai = 0; ai < 2; ++ai)
#pragma unroll
            for (int mp = 0; mp < 2; ++mp) {
                u32x4 gs[2][2], gr[2][2], pv[2][2];
#pragma unroll
                for (int mm = 0; mm < 2; ++mm)
#pragma unroll
                    for (int bj = 0; bj < 2; ++bj) { const int row = row0 + ai * 128 + (2 * mp + mm) * 16, col = u.pn * 256 + bj * 128 + cw;
                        gs[mm][bj] = *(const u32x4*)(gates + (size_t)row * LDG + col); gr[mm][bj] = *(const u32x4*)(gates + (size_t)row * LDG + 1024 + col);
                        pv[mm][bj] = *(const u32x4*)(m1 + (size_t)row * LDM1 + col); }
#pragma unroll
                for (int mm = 0; mm < 2; ++mm)
#pragma unroll
                    for (int bj = 0; bj < 2; ++bj) { const int m = 2 * mp + mm, row = row0 + ai * 128 + m * 16, col = u.pn * 256 + bj * 128 + cw;
                        f32x4 sa, sb, ra, rb, pa, pb; unpack8(gs[mm][bj], sa, sb); unpack8(gr[mm][bj], ra, rb); unpack8(pv[mm][bj], pa, pb);
                        *(u32x4*)(outp + (size_t)row * 1024 + col) = pack8(sa * pa + ra * acc[ai][bj][m][0], sb * pb + rb * acc[ai][bj][m][1]); }
            }
    }
};
template <bool IN_BF16> struct EpiResid {
    static constexpr bool PERM = true, AFTER_DRAIN = false;
    const void* base; bf16* outp; const float* gate;
    DI void operator()(EPI_ARGS) const {
        const int row0 = u.pm * 256 + wr * 64 + fr, cw = wc * 32 + 8 * fq, b = u.pm >> 3;
        f32x4 gt[2][2];
#pragma unroll
        for (int bj = 0; bj < 2; ++bj) { const int col = u.pn * 256 + bj * 128 + cw; gt[bj][0] = *(const f32x4*)(gate + b * NMOD + col); gt[bj][1] = *(const f32x4*)(gate + b * NMOD + col + 4); }
#pragma unroll
        for (int ai = 0; ai < 2; ++ai)
#pragma unroll
            for (int mp = 0; mp < 2; ++mp) {
                f32x4 xv[2][2][2];
#pragma unroll
                for (int mm = 0; mm < 2; ++mm)
#pragma unroll
                    for (int bj = 0; bj < 2; ++bj) { const size_t off = (size_t)(row0 + ai * 128 + (2 * mp + mm) * 16) * 1024 + u.pn * 256 + bj * 128 + cw;
                        if (IN_BF16) unpack8(*(const u32x4*)((const bf16*)base + off), xv[mm][bj][0], xv[mm][bj][1]);
                        else { xv[mm][bj][0] = *(const f32x4*)((const float*)base + off); xv[mm][bj][1] = *(const f32x4*)((const float*)base + off + 4); } }
#pragma unroll
                for (int mm = 0; mm < 2; ++mm)
#pragma unroll
                    for (int bj = 0; bj < 2; ++bj) { const int m = 2 * mp + mm; const size_t off = (size_t)(row0 + ai * 128 + m * 16) * 1024 + u.pn * 256 + bj * 128 + cw;
                        *(u32x4*)(outp + off) = pack8(xv[mm][bj][0] + gt[bj][0] * acc[ai][bj][m][0], xv[mm][bj][1] + gt[bj][1] * acc[ai][bj][m][1]); }
            }
    }
};
struct EpiSwiglu {
    static constexpr bool PERM = true, AFTER_DRAIN = false;
    bf16* H;
    DI void operator()(EPI_ARGS) const {
        const int row0 = u.pm * 256 + wr * 64 + fr, cw = wc * 32 + 8 * fq;
#pragma unroll
        for (int ai = 0; ai < 2; ++ai)
#pragma unroll
            for (int m = 0; m < 4; ++m) {
                f32x4 a0 = acc[ai][0][m][0], a1 = acc[ai][0][m][1]; const f32x4 u0 = acc[ai][1][m][0], u1 = acc[ai][1][m][1];
#pragma unroll
                for (int e = 0; e < 4; ++e) { a0[e] = a0[e] * fsigmoid(a0[e]) * u0[e]; a1[e] = a1[e] * fsigmoid(a1[e]) * u1[e]; }
                *(u32x4*)(H + (size_t)(row0 + ai * 128 + m * 16) * DFF + u.pn * 128 + cw) = pack8(a0, a1);
            }
    }
};

DI int ffi_row(int n) { return n < DFF ? 256 * (n >> 7) + (n & 127) : 256 * ((n - DFF) >> 7) + 128 + ((n - DFF) & 127); }
DI void transpose_item(const float* W, int K, int N, bf16* WT, int mode, LAS float* scr, int item, int lane) {
    const int nblk = N / 32, kb = item / nblk, nb = item % nblk, k0 = 64 * kb, n0 = 32 * nb;
    const int d0 = mode ? ffi_row(n0) : n0;
#pragma unroll 8
    for (int i = 0; i < 32; ++i) { const int kk = 2 * i + (lane >> 5); scr[kk * 33 + (lane & 31)] = W[(size_t)(k0 + kk) * N + n0 + (lane & 31)]; }
    asm volatile("s_waitcnt lgkmcnt(0)" ::: "memory");
    const int c = lane & 7;
#pragma unroll
    for (int j = 0; j < 4; ++j) { const int n = (lane >> 3) + 8 * j; const LAS float* s = scr + (8 * c) * 33 + n;
        u32x4 o; o.x = pk2(s[0 * 33], s[1 * 33]); o.y = pk2(s[2 * 33], s[3 * 33]); o.z = pk2(s[4 * 33], s[5 * 33]); o.w = pk2(s[6 * 33], s[7 * 33]);
        *(u32x4*)(WT + (size_t)(d0 + n) * K + k0 + 8 * c) = o; }
    asm volatile("s_waitcnt lgkmcnt(0)" ::: "memory");
}
DI void p0_prologue(const Args& A, ldsp lds, int G) {
    const int tid = threadIdx.x, lane = tid & 63, wave = tid >> 6;
    LAS float* scr = (LAS float*)(lds + wave * 16384);
    const int gw = blockIdx.x * NWAVES + wave, NGW = G * NWAVES;
    unsigned char* ws = A.ws;
    constexpr int I_IN = (D_ / 64) * (INW / 32), I_SB = 16 * 32, I_RET = 32 * 32, I_OUT = 16 * 32, I_FFI = 16 * (2 * DFF / 32), I_FFO = (DFF / 64) * 32;
    constexpr int I_MOD = 96 * 8, I_ROPE = 2048 * 128 / 64;
    constexpr int NIT = I_IN + I_SB + I_RET + I_OUT + I_FFI + I_FFO + I_MOD + I_ROPE;
    for (int it = gw; it < NIT; it += NGW) {
        int r = it;
        if (r < I_IN) { transpose_item(A.w_in, D_, INW, (bf16*)(ws + WS_WIN), 0, scr, r, lane); continue; } r -= I_IN;
        if (r < I_SB) { transpose_item(A.w_sb, 1024, 1024, (bf16*)(ws + WS_WSB), 0, scr, r, lane); continue; } r -= I_SB;
        if (r < I_RET) { transpose_item(A.w_ret, 2048, 1024, (bf16*)(ws + WS_WRET), 0, scr, r, lane); continue; } r -= I_RET;
        if (r < I_OUT) { transpose_item(A.w_out, 1024, 1024, (bf16*)(ws + WS_WOUT), 0, scr, r, lane); continue; } r -= I_OUT;
        if (r < I_FFI) { transpose_item(A.w_ffi, 1024, 2 * DFF, (bf16*)(ws + WS_WFFI), 1, scr, r, lane); continue; } r -= I_FFI;
        if (r < I_FFO) { transpose_item(A.w_ffo, DFF, 1024, (bf16*)(ws + WS_WFFO), 0, scr, r, lane); continue; } r -= I_FFO;
        if (r < I_MOD) {
            const int eb = r % 96, ks = r / 96, d0 = ks * 128, e = eb * 64 + lane;
#pragma unroll 4
            for (int i = 0; i < 32; ++i) { const int idx = i * 64 + lane, b = idx >> 7, dd = idx & 127; const float cv = A.c[b * 1024 + d0 + dd]; scr[idx] = cv * fsigmoid(cv); }
            asm volatile("s_waitcnt lgkmcnt(0)" ::: "memory");
            float a[16];
#pragma unroll
            for (int b = 0; b < 16; ++b) a[b] = 0.f;
            for (int dd = 0; dd < 128; ++dd) { const float w = A.w_ada[(size_t)(d0 + dd) * NMOD + e];
#pragma unroll
                for (int b = 0; b < 16; ++b) a[b] += scr[b * 128 + dd] * w; }
            float* mp = (float*)(ws + WS_MODP) + (size_t)ks * NB * NMOD + e;
#pragma unroll
            for (int b = 0; b < 16; ++b) mp[b * NMOD] = a[b];
            asm volatile("s_waitcnt lgkmcnt(0)" ::: "memory");
            continue;
        } r -= I_MOD;
        {
            const int idx = r * 64 + lane, pos = idx >> 7, j = idx & 127;
            const float inv = exp2f(-(float)j * (13.287712379549449f / 128.0f));
            const float ang = (float)pos * inv;
            const float n = rintf(ang * 0.15915494309189535f);
            float rr = __builtin_fmaf(-n, 6.28125f, ang); rr = __builtin_fmaf(-n, 0.0019353071795864769f, rr);
            ((float*)(ws + WS_COS))[idx] = cosf(rr); ((float*)(ws + WS_SIN))[idx] = sinf(rr);
        }
    }
}
template <bool FIRST> DI void norm_mod_phase(const Args& A, ldsp lds, int G, const float* src, const float* gw_, bf16* dst, int shift_off) {
    const int tid = threadIdx.x, lane = tid & 63, wave = tid >> 6;
    LAS float* modl = (LAS float*)lds;
    const float* modp = (const float*)(A.ws + WS_MODP); float* modf = (float*)(A.ws + WS_MODF);
    for (int rb = blockIdx.x; rb < 256; rb += G) {
        const int b = rb >> 4;
        __syncthreads();
        for (int i = tid; i < 2048; i += NTHR) {
            float v;
            if (FIRST) { const int e = i; v = A.b_ada[e]; for (int ks = 0; ks < 8; ++ks) v += modp[(size_t)ks * NB * NMOD + b * NMOD + e]; }
            else v = modf[b * NMOD + shift_off + i];
            modl[i] = v;
        }
        if (FIRST && tid < 384) { const int idx = rb * 384 + tid, e = idx % NMOD; float v = A.b_ada[e]; for (int ks = 0; ks < 8; ++ks) v += modp[(size_t)ks * NB * NMOD + idx]; modf[idx] = v; }
        __syncthreads();
        for (int rr = 0; rr < 16; ++rr) {
            const int row = rb * 128 + wave * 16 + rr;
            f32x4 v[4]; float s = 0.f;
            if (!FIRST) { const u32x2* xb = (const u32x2*)((const bf16*)(const void*)src + (size_t)row * 1024) + lane;
#pragma unroll
                for (int j = 0; j < 4; ++j) { const u32x2 w2 = xb[64 * j]; v[j] = (f32x4){bflo(w2.x), bfhi(w2.x), bflo(w2.y), bfhi(w2.y)}; } }
            else { const f32x4* xr = (const f32x4*)(src + (size_t)row * 1024) + lane;
#pragma unroll
                for (int j = 0; j < 4; ++j) v[j] = xr[64 * j]; }
#pragma unroll
            for (int j = 0; j < 4; ++j) { s += (v[j][0] * v[j][0] + v[j][1] * v[j][1]) + (v[j][2] * v[j][2] + v[j][3] * v[j][3]); }
            const float rstd = rsqrtf(wave_sum(s) * (1.0f / 1024.0f) + EPS_);
            unsigned long long* o8 = (unsigned long long*)(dst + (size_t)row * 1024) + lane;
#pragma unroll
            for (int j = 0; j < 4; ++j) {
                const int col = 4 * lane + 256 * j;
                const f32x4 g = *(const f32x4*)(gw_ + col); const f32x4 sh = *(const LAS f32x4*)(modl + col), sc = *(const LAS f32x4*)(modl + 1024 + col);
                const f32x4 y = v[j] * rstd * g * (sc + 1.0f) + sh;
                o8[64 * j] = (unsigned long long)pk2(y[0], y[1]) | ((unsigned long long)pk2(y[2], y[3]) << 32);
            }
        }
    }
    __syncthreads();
}
DI void final_norm_phase(const Args& A, int G, const bf16* x3) {
    const int tid = threadIdx.x, lane = tid & 63, wave = tid >> 6;
    const int gw = blockIdx.x * NWAVES + wave, NGW = G * NWAVES;
    for (int row = gw; row < T_; row += NGW) {
        const u32x2* xb = (const u32x2*)(x3 + (size_t)row * 1024) + lane;
        f32x4* orow = (f32x4*)(A.out + (size_t)row * 1024) + lane;
        f32x4 v[4]; float s = 0.f;
#pragma unroll
        for (int j = 0; j < 4; ++j) { const u32x2 w2 = xb[64 * j]; v[j] = (f32x4){bflo(w2.x), bfhi(w2.x), bflo(w2.y), bfhi(w2.y)}; s += (v[j][0] * v[j][0] + v[j][1] * v[j][1]) + (v[j][2] * v[j][2] + v[j][3] * v[j][3]); }
        const float rstd = rsqrtf(wave_sum(s) * (1.0f / 1024.0f) + EPS_);
#pragma unroll
        for (int j = 0; j < 4; ++j) { const f32x4 g = *(const f32x4*)(A.gf + 4 * lane + 256 * j); orow[64 * j] = v[j] * rstd * g; }
    }
}

typedef short v4i16_t __attribute__((ext_vector_type(4)));
DI s16x4 tr_read(const LAS unsigned char* p) { return __builtin_bit_cast(s16x4, __builtin_amdgcn_ds_read_tr16_b64_v4i16((LAS v4i16_t*)p)); }
#define MFMA32(a, b, c) __builtin_amdgcn_mfma_f32_32x32x16_bf16((a), (b), (c), 0, 0, 0)
#define MFMA16(a, b, c) __builtin_amdgcn_mfma_f32_16x16x32_bf16((a), (b), (c), 0, 0, 0)
DI int crow(int r, int hi) { return (r & 3) + 8 * (r >> 2) + 4 * hi; }
DI bf16x8 pack_step(const f32x16& x, int s) {
    u32x4 p; p.x = pk2(x[8 * s], x[8 * s + 1]); p.y = pk2(x[8 * s + 2], x[8 * s + 3]); p.z = pk2(x[8 * s + 4], x[8 * s + 5]); p.w = pk2(x[8 * s + 6], x[8 * s + 7]);
    return __builtin_bit_cast(bf16x8, p);
}
constexpr int SB_PK = 144, SB_PV = 192;
constexpr int SB_KBYTES = 64 * SB_PK, SB_VBYTES = 64 * SB_PV, SB_BUF = SB_KBYTES + SB_VBYTES;
DI void sb_attn_unit(ldsp lds, const bf16* Q, const bf16* K, const bf16* V, bf16* O, int b, int h, int qb, int dry = 0) {
    const int tid = threadIdx.x, lane = tid & 63, wave = __builtin_amdgcn_readfirstlane(tid >> 6), r32 = lane & 31, hi = lane >> 5;
    const int t0 = qb * 256 + wave * 32, tq = t0 + r32;
    const size_t rowbase = (size_t)b * S_;
    bf16x8 qf[4];
#pragma unroll
    for (int ks = 0; ks < 4; ++ks) qf[ks] = *(const bf16x8*)(Q + (rowbase + tq) * 1024 + h * 64 + 16 * ks + 8 * hi);
    bf16x8 U0, U1, ONES;
#pragma unroll
    for (int jj = 0; jj < 8; ++jj) { const int k0 = 8 * (jj >> 2) + 4 * hi + (jj & 3); U0[jj] = (k0 >= r32) ? (short)0x3F80 : (short)0; U1[jj] = (16 + k0 >= r32) ? (short)0x3F80 : (short)0; ONES[jj] = (short)0x3F80; }
    f32x16 o0, o1;
#pragma unroll
    for (int i = 0; i < 16; ++i) { o0[i] = 0.f; o1[i] = 0.f; }
    float R2 = 0.f;
    const int ntiles = qb * 4 + 4;
    const int srow = tid >> 3, schunk = tid & 7;
    const bf16* kg = K + (rowbase + srow) * 1024 + h * 64 + schunk * 8; const bf16* vg = V + (rowbase + srow) * 1024 + h * 64 + schunk * 8;
    const int kso = srow * SB_PK + schunk * 16, vso = SB_KBYTES + srow * SB_PV + schunk * 16;
    LAS unsigned* doneF = (LAS unsigned*)(lds + 2 * SB_BUF);
    bool wdone = false;
    __syncthreads();
    { const int jt = ntiles - 1; const u32x4 kr = *(const u32x4*)(kg + (size_t)jt * 64 * 1024), vr = *(const u32x4*)(vg + (size_t)jt * 64 * 1024);
      *(LAS u32x4*)(lds + kso) = kr; *(LAS u32x4*)(lds + vso) = vr; }
    __syncthreads();
    const float C2 = 0.125f * 1.4426950408889634f;
    const int i16 = lane & 15, blk = (lane >> 4) & 1, qq = i16 >> 2, pp = i16 & 3;
    for (int jt = ntiles - 1; jt >= 0; --jt) {
        const int cur = (ntiles - 1 - jt) & 1;
        u32x4 kr, vr;
        if (jt > 0) { kr = *(const u32x4*)(kg + (size_t)(jt - 1) * 64 * 1024); vr = *(const u32x4*)(vg + (size_t)(jt - 1) * 64 * 1024); }
        if (!wdone && 64 * jt < t0 + 31) {
            const LAS unsigned char* Kb = lds + cur * SB_BUF; const LAS unsigned char* Vb = Kb + SB_KBYTES;
            const bool diag = (64 * jt + 63 >= t0);
            f32x16 z[2];
#pragma unroll
            for (int rb = 0; rb < 2; ++rb) {
#pragma unroll
                for (int i = 0; i < 16; ++i) z[rb][i] = 0.f;
#pragma unroll
                for (int ks = 0; ks < 4; ++ks) { const bf16x8 a = *(const LAS bf16x8*)(Kb + (32 * rb + r32) * SB_PK + (16 * ks + 8 * hi) * 2); z[rb] = MFMA32(a, qf[ks], z[rb]); }
            }
            float lsum = 0.f; f32x16 L[2];
#pragma unroll
            for (int rb = 0; rb < 2; ++rb)
#pragma unroll
                for (int i = 0; i < 16; ++i) {
                    const float z2 = z[rb][i] * C2;
                    const float e = __builtin_amdgcn_exp2f(-__builtin_fabsf(z2));
                    float l = -(__builtin_fmaxf(z2, 0.f) + __builtin_amdgcn_logf(1.0f + e));
                    if (diag) { const int s = 64 * jt + 32 * rb + crow(i, hi); if (!(s < tq)) l = 0.f; }
                    L[rb][i] = l; lsum += l; z[rb][i] = z2 + R2;
                }
            bf16x8 Lp[4];
#pragma unroll
            for (int q = 0; q < 4; ++q) Lp[q] = pack_step(L[q >> 1], q & 1);
            f32x16 la0 = MFMA32(U0, Lp[0], z[0]); la0 = MFMA32(U1, Lp[1], la0); la0 = MFMA32(ONES, Lp[2], la0); la0 = MFMA32(ONES, Lp[3], la0);
            f32x16 la1 = MFMA32(U0, Lp[2], z[1]); la1 = MFMA32(U1, Lp[3], la1);
#pragma unroll
            for (int i = 0; i < 16; ++i) {
                float a0 = __builtin_amdgcn_exp2f(la0[i]), a1 = __builtin_amdgcn_exp2f(la1[i]);
                if (diag) { const int s = 64 * jt + crow(i, hi); if (!(s < tq)) a0 = 0.f; if (!(s + 32 < tq)) a1 = 0.f; }
                la0[i] = a0; la1[i] = a1;
            }
            bf16x8 Ap[4]; Ap[0] = pack_step(la0, 0); Ap[1] = pack_step(la0, 1); Ap[2] = pack_step(la1, 0); Ap[3] = pack_step(la1, 1);
#pragma unroll
            for (int q = 0; q < 4; ++q) {
                const int key0 = 16 * q + 4 * hi;
#pragma unroll
                for (int db = 0; db < 2; ++db) {
                    const LAS unsigned char* ap = Vb + (key0 + qq) * SB_PV + (32 * db + 16 * blk + 4 * pp) * 2;
                    const s16x4 lo = tr_read(ap), hi4 = tr_read(ap + 8 * SB_PV);
                    const bf16x8 va = __builtin_shufflevector(lo, hi4, 0, 1, 2, 3, 4, 5, 6, 7);
                    if (db == 0) o0 = MFMA32(va, Ap[q], o0); else o1 = MFMA32(va, Ap[q], o1);
                }
            }
            R2 += lsum + __shfl_xor(lsum, 32);
            wdone = __all(R2 < -160.0f);
        }
        if (lane == 0) doneF[(jt & 1) * 8 + wave] = wdone ? 1u : 0u;
        if (jt > 0) { *(LAS u32x4*)(lds + (cur ^ 1) * SB_BUF + kso) = kr; *(LAS u32x4*)(lds + (cur ^ 1) * SB_BUF + vso) = vr; }
        __syncthreads();
        { const LAS u32x4* df = (const LAS u32x4*)(doneF + (jt & 1) * 8); const u32x4 f0 = df[0], f1 = df[1];
          if ((f0.x & f0.y & f0.z & f0.w & f1.x & f1.y & f1.z & f1.w) != 0u) break; }
    }
    bf16* op = O + (rowbase + tq) * 1024 + h * 64 + 4 * hi;
#pragma unroll
    for (int g = 0; g < 4; ++g) {
        u32x2 w0, w1; w0.x = pk2(o0[4 * g], o0[4 * g + 1]); w0.y = pk2(o0[4 * g + 2], o0[4 * g + 3]); w1.x = pk2(o1[4 * g], o1[4 * g + 1]); w1.y = pk2(o1[4 * g + 2], o1[4 * g + 3]);
        if (!dry) { *(u32x2*)(op + 8 * g) = w0; *(u32x2*)(op + 32 + 8 * g) = w1; }
    }
}


DI void sb_attn_wave(ldsp vl  , const bf16* Q, const bf16* K, const bf16* V, bf16* O, int b, int h, int rg) {
    const int lane = threadIdx.x & 63, r32 = lane & 31, hi = lane >> 5;
    const int t0 = rg * 32, tq = t0 + r32;
    const size_t rowbase = (size_t)b * S_;
    bf16x8 qf[4];
#pragma unroll
    for (int ks = 0; ks < 4; ++ks) qf[ks] = *(const bf16x8*)(Q + (rowbase + tq) * 1024 + h * 64 + 16 * ks + 8 * hi);
    bf16x8 U0, U1, ONES;
#pragma unroll
    for (int jj = 0; jj < 8; ++jj) { const int k0 = 8 * (jj >> 2) + 4 * hi + (jj & 3); U0[jj] = (k0 >= r32) ? (short)0x3F80 : (short)0; U1[jj] = (16 + k0 >= r32) ? (short)0x3F80 : (short)0; ONES[jj] = (short)0x3F80; }
    f32x16 o0, o1;
#pragma unroll
    for (int i = 0; i < 16; ++i) { o0[i] = 0.f; o1[i] = 0.f; }
    float R2 = 0.f;
    const int jtop = (t0 + 30) >> 6;
    const bf16* kg = K + (rowbase + r32) * 1024 + h * 64 + 8 * hi;
    const bf16* vg = V + (rowbase + (lane >> 3)) * 1024 + h * 64 + (((lane & 7) ^ ((((lane >> 3) >> 1) & 1) << 2)) * 8);
    const int i16 = lane & 15, blk = (lane >> 4) & 1, qq = i16 >> 2, pp = i16 & 3;
    const int vro = (4 * hi + qq) * 128 + (((2 * blk + (pp >> 1)) ^ (((qq >> 1) & 1) << 2)) * 16) + 8 * (pp & 1);
    bf16x8 kf[8];
#pragma unroll
    for (int i = 0; i < 8; ++i) __builtin_amdgcn_global_load_lds((const unsigned*)(vg + (size_t)(64 * jtop + 8 * i) * 1024), (LAS unsigned*)(vl + i * 1024), 16, 0, 0);
#pragma unroll
    for (int i = 0; i < 8; ++i) kf[i] = *(const bf16x8*)(kg + (size_t)(64 * jtop + 32 * (i >> 2)) * 1024 + 16 * (i & 3));
    const float C2 = 0.125f * 1.4426950408889634f;
    for (int jt = jtop; jt >= 0; --jt) {
        const int cur = (jtop - jt) & 1;
        asm volatile("s_waitcnt vmcnt(0)" ::: "memory");
        f32x16 z[2];
#pragma unroll
        for (int rb = 0; rb < 2; ++rb) {
#pragma unroll
            for (int i = 0; i < 16; ++i) z[rb][i] = 0.f;
#pragma unroll
            for (int ks = 0; ks < 4; ++ks) z[rb] = MFMA32(kf[rb * 4 + ks], qf[ks], z[rb]);
        }
        if (jt > 0) {
#pragma unroll
            for (int i = 0; i < 8; ++i) __builtin_amdgcn_global_load_lds((const unsigned*)(vg + (size_t)(64 * (jt - 1) + 8 * i) * 1024), (LAS unsigned*)(vl + (cur ^ 1) * 8192 + i * 1024), 16, 0, 0);
#pragma unroll
            for (int i = 0; i < 8; ++i) kf[i] = *(const bf16x8*)(kg + (size_t)(64 * (jt - 1) + 32 * (i >> 2)) * 1024 + 16 * (i & 3));
        }
        const bool diag = (jt == jtop);
        float lsum = 0.f; f32x16 L[2];
#pragma unroll
        for (int rb = 0; rb < 2; ++rb)
#pragma unroll
            for (int i = 0; i < 16; ++i) {
                const float z2 = z[rb][i] * C2;
                const float e = __builtin_amdgcn_exp2f(-__builtin_fabsf(z2));
                L[rb][i] = -(__builtin_fmaxf(z2, 0.f) + __builtin_amdgcn_logf(1.0f + e));
                z[rb][i] = z2 + R2;
            }
        if (diag) {
#pragma unroll
            for (int rb = 0; rb < 2; ++rb)
#pragma unroll
                for (int i = 0; i < 16; ++i) { const int s = 64 * jt + 32 * rb + crow(i, hi); if (!(s < tq)) L[rb][i] = 0.f; }
        }
#pragma unroll
        for (int i = 0; i < 16; ++i) lsum += L[0][i] + L[1][i];
        bf16x8 Lp[4];
#pragma unroll
        for (int q = 0; q < 4; ++q) Lp[q] = pack_step(L[q >> 1], q & 1);
        f32x16 la0 = MFMA32(U0, Lp[0], z[0]); la0 = MFMA32(U1, Lp[1], la0); la0 = MFMA32(ONES, Lp[2], la0); la0 = MFMA32(ONES, Lp[3], la0);
        f32x16 la1 = MFMA32(U0, Lp[2], z[1]); la1 = MFMA32(U1, Lp[3], la1);
#pragma unroll
        for (int i = 0; i < 16; ++i) { la0[i] = __builtin_amdgcn_exp2f(la0[i]); la1[i] = __builtin_amdgcn_exp2f(la1[i]); }
        if (diag) {
#pragma unroll
            for (int i = 0; i < 16; ++i) { const int s = 64 * jt + crow(i, hi); if (!(s < tq)) la0[i] = 0.f; if (!(s + 32 < tq)) la1[i] = 0.f; }
        }
        bf16x8 Ap[4]; Ap[0] = pack_step(la0, 0); Ap[1] = pack_step(la0, 1); Ap[2] = pack_step(la1, 0); Ap[3] = pack_step(la1, 1);
        const LAS unsigned char* vb = vl + cur * 8192 + vro;
#pragma unroll
        for (int q = 0; q < 4; ++q) {
#pragma unroll
            for (int db = 0; db < 2; ++db) {
                const LAS unsigned char* ap = (const LAS unsigned char*)((unsigned)(size_t)(vb + 2048 * q) ^ (unsigned)(64 * db));
                const s16x4 lo = tr_read(ap), hi4 = tr_read(ap + 1024);
                const bf16x8 va = __builtin_shufflevector(lo, hi4, 0, 1, 2, 3, 4, 5, 6, 7);
                if (db == 0) o0 = MFMA32(va, Ap[q], o0); else o1 = MFMA32(va, Ap[q], o1);
            }
        }
        R2 += lsum + __shfl_xor(lsum, 32);
        if (__all(R2 < -152.0f)) break;
    }
    asm volatile("s_waitcnt vmcnt(0)" ::: "memory");
    bf16* op = O + (rowbase + tq) * 1024 + h * 64 + 4 * hi;
#pragma unroll
    for (int g = 0; g < 4; ++g) {
        u32x2 w0, w1; w0.x = pk2(o0[4 * g], o0[4 * g + 1]); w0.y = pk2(o0[4 * g + 2], o0[4 * g + 3]); w1.x = pk2(o1[4 * g], o1[4 * g + 1]); w1.y = pk2(o1[4 * g + 2], o1[4 * g + 3]);
        *(u32x2*)(op + 8 * g) = w0; *(u32x2*)(op + 32 + 8 * g) = w1;
    }
}

constexpr int RT_P = 272;
constexpr int RT_TILE = 128 * RT_P, RT_Q = 0, RT_K = RT_TILE, RT_V = 2 * RT_TILE, RT_PS = 3 * RT_TILE, RT_SS = 4 * RT_TILE;
#define RT_STAGE(dh_, withv_) do { \
    const int row_ = tid >> 4, chunk_ = tid & 15; \
    const bf16* qg_ = RQ + (rowbase + c0 + row_) * 1024 + hh * 256 + (dh_) * 128 + chunk_ * 8; \
    const bf16* kg_ = RK + (rowbase + c0 + row_) * 1024 + hh * 256 + (dh_) * 128 + chunk_ * 8; \
    const ldsp lq_ = lds + row_ * RT_P + chunk_ * 16; \
    _Pragma("unroll") for (int i_ = 0; i_ < 4; ++i_) *(LAS u32x4*)(lq_ + RT_Q + i_ * 32 * RT_P) = *(const u32x4*)(qg_ + (size_t)i_ * 32 * 1024); \
    __builtin_amdgcn_sched_barrier(0); \
    _Pragma("unroll") for (int i_ = 0; i_ < 4; ++i_) *(LAS u32x4*)(lq_ + RT_K + i_ * 32 * RT_P) = *(const u32x4*)(kg_ + (size_t)i_ * 32 * 1024); \
    __builtin_amdgcn_sched_barrier(0); \
    if (withv_) { const bf16* vg_ = RV + (rowbase + c0 + row_) * 2048 + hh * 512 + es * 128 + chunk_ * 8; \
        _Pragma("unroll") for (int i_ = 0; i_ < 4; ++i_) *(LAS u32x4*)(lq_ + RT_V + i_ * 32 * RT_P) = *(const u32x4*)(vg_ + (size_t)i_ * 32 * 2048); } \
    __builtin_amdgcn_sched_barrier(0); } while (0)
DI void retention_unit(ldsp lds, const bf16* RQ, const bf16* RK, bf16* RV, float* RS, int b, int hh, int es, int dry = 0) {
    const int tid = threadIdx.x, lane = tid & 63, w = __builtin_amdgcn_readfirstlane(tid >> 6), i16 = lane & 15, g = lane >> 4, qq = i16 >> 2, pp = i16 & 3;
    const size_t rowbase = (size_t)b * S_;
    const float g128 = exp2f(128.0f * __log2f(1.0f - exp2f(-5.0f - (float)hh)));
    f32x4 Tst[16];
#pragma unroll
    for (int i = 0; i < 16; ++i) Tst[i] = (f32x4){0.f, 0.f, 0.f, 0.f};
    for (int ch = 0; ch < 16; ++ch) {
        const int c0 = ch * 128;
        {
            f32x4 sc[8];
#pragma unroll
            for (int i = 0; i < 8; ++i) sc[i] = (f32x4){0.f, 0.f, 0.f, 0.f};
#pragma unroll
            for (int dh = 0; dh < 2; ++dh) {
                __syncthreads();
                RT_STAGE(dh, false);
                __syncthreads();
#pragma unroll
                for (int kb = 0; kb < 4; ++kb) {
                    const bf16x8 bq = *(const LAS bf16x8*)(lds + RT_Q + (16 * w + i16) * RT_P + (32 * kb + 8 * g) * 2);
#pragma unroll
                    for (int mb = 0; mb < 8; ++mb) { const bf16x8 ak = *(const LAS bf16x8*)(lds + RT_K + (16 * mb + i16) * RT_P + (32 * kb + 8 * g) * 2); sc[mb] = MFMA16(ak, bq, sc[mb]); }
                    __builtin_amdgcn_sched_barrier(0);
                }
            }
            const int c = 16 * w + i16;
#pragma unroll
            for (int mb = 0; mb < 8; ++mb) {
                const int m0 = 16 * mb + 4 * g;
                const float v0 = (m0 <= c) ? sc[mb][0] : 0.f, v1 = (m0 + 1 <= c) ? sc[mb][1] : 0.f, v2 = (m0 + 2 <= c) ? sc[mb][2] : 0.f, v3 = (m0 + 3 <= c) ? sc[mb][3] : 0.f;
                u32x2 pw; pw.x = pk2(v0, v1); pw.y = pk2(v2, v3);
                *(LAS u32x2*)(lds + RT_PS + c * RT_P + m0 * 2) = pw;
            }
        }
        __builtin_amdgcn_sched_barrier(0);
        f32x4 cr[8]; bf16x8 vf[4];
#pragma unroll
        for (int i = 0; i < 8; ++i) cr[i] = (f32x4){0.f, 0.f, 0.f, 0.f};
#pragma unroll
        for (int dh = 0; dh < 2; ++dh) {
            __syncthreads();
            RT_STAGE(dh, dh == 0);
            __syncthreads();
            if (dh == 0) {
#pragma unroll
                for (int cbk = 0; cbk < 4; ++cbk) {
                    const LAS unsigned char* ap = lds + RT_V + (32 * cbk + 8 * g + qq) * RT_P + (16 * w + 4 * pp) * 2;
                    const s16x4 lo = tr_read(ap), hi4 = tr_read(ap + 4 * RT_P);
                    vf[cbk] = __builtin_shufflevector(lo, hi4, 0, 1, 2, 3, 4, 5, 6, 7);
                }
            }
#pragma unroll
            for (int kb = 0; kb < 4; ++kb) {
                const int kbg = 4 * dh + kb;
                u32x4 tp; tp.x = pk2(Tst[2 * kbg][0], Tst[2 * kbg][1]); tp.y = pk2(Tst[2 * kbg][2], Tst[2 * kbg][3]); tp.z = pk2(Tst[2 * kbg + 1][0], Tst[2 * kbg + 1][1]); tp.w = pk2(Tst[2 * kbg + 1][2], Tst[2 * kbg + 1][3]);
                const bf16x8 tb = __builtin_bit_cast(bf16x8, tp);
#pragma unroll
                for (int cb = 0; cb < 8; ++cb) {
                    const LAS unsigned char* qp = lds + RT_Q + (16 * cb + i16) * RT_P + (32 * kb + 4 * g) * 2;
                    const s16x4 lo = *(const LAS s16x4*)qp, hi4 = *(const LAS s16x4*)(qp + 32);
                    const bf16x8 aq = __builtin_shufflevector(lo, hi4, 0, 1, 2, 3, 4, 5, 6, 7);
                    cr[cb] = MFMA16(aq, tb, cr[cb]);
                }
                __builtin_amdgcn_sched_barrier(0);
            }
#pragma unroll
            for (int dtl = 0; dtl < 8; ++dtl) {
                const int dt = 8 * dh + dtl;
                Tst[dt] = Tst[dt] * g128;
#pragma unroll
                for (int cbk = 0; cbk < 4; ++cbk) {
                    const LAS unsigned char* ap = lds + RT_K + (32 * cbk + 8 * g + qq) * RT_P + (16 * dtl + 4 * pp) * 2;
                    const s16x4 lo = tr_read(ap), hi4 = tr_read(ap + 4 * RT_P);
                    const bf16x8 ak = __builtin_shufflevector(lo, hi4, 0, 1, 2, 3, 4, 5, 6, 7);
                    Tst[dt] = MFMA16(ak, vf[cbk], Tst[dt]);
                }
                __builtin_amdgcn_sched_barrier(0);
            }
        }
#pragma unroll
        for (int cb = 0; cb < 8; ++cb) cr[cb] = cr[cb] * g128;
#pragma unroll
        for (int cb = 0; cb < 8; ++cb)
#pragma unroll
            for (int mbk = 0; mbk < 4; ++mbk) if (32 * mbk <= 16 * cb + 15) {
                const bf16x8 ap = *(const LAS bf16x8*)(lds + RT_PS + (16 * cb + i16) * RT_P + (32 * mbk + 8 * g) * 2);
                cr[cb] = MFMA16(ap, vf[mbk], cr[cb]);
            }
        LAS float* ssq = (LAS float*)(lds + RT_SS);
#pragma unroll
        for (int cb = 0; cb < 8; ++cb)
#pragma unroll
            for (int j = 0; j < 4; ++j) {
                const int c = 16 * cb + 4 * g + j;
                const unsigned short ob = (unsigned short)(pk2(cr[cb][j], 0.f) & 0xffffu);
                if (!dry) RV[(rowbase + c0 + c) * 2048 + hh * 512 + es * 128 + 16 * w + i16] = ob;
                const float of = bf2f(ob); float s = of * of;
                s += __shfl_xor(s, 1); s += __shfl_xor(s, 2); s += __shfl_xor(s, 4); s += __shfl_xor(s, 8);
                if (i16 == 0) ssq[w * 128 + c] = s;
            }
        __syncthreads();
        if (tid < 128) { float s = 0.f;
#pragma unroll
            for (int ww = 0; ww < 8; ++ww) s += ssq[ww * 128 + tid];
            if (!dry) RS[(rowbase + c0 + tid) * 16 + hh * 4 + es] = s; }
    }
    __syncthreads();
}


constexpr int SC_P = 528;
DI void ret_scores_item(ldsp lds, const bf16* RQ, const bf16* RK, bf16* PG, int item) {
    const int tid = threadIdx.x, lane = tid & 63, w = __builtin_amdgcn_readfirstlane(tid >> 6), i16 = lane & 15, g = lane >> 4;
    const int ch = item & 15, hh = (item >> 4) & 3, b = item >> 6;
    const size_t grow0 = (size_t)b * S_ + ch * 128;
    __syncthreads();
#pragma unroll
    for (int t = 0; t < 2; ++t) {
        const bf16* src = (t ? RK : RQ) + grow0 * 1024 + hh * 256;
#pragma unroll
        for (int i = 0; i < 8; ++i) { const int idx = tid + 512 * i, row = idx >> 5, chunk = idx & 31;
            *(LAS u32x4*)(lds + t * (128 * SC_P) + row * SC_P + chunk * 16) = *(const u32x4*)(src + (size_t)row * 1024 + chunk * 8); }
        __builtin_amdgcn_sched_barrier(0);
    }
    __syncthreads();
    f32x4 sc[8];
#pragma unroll
    for (int i = 0; i < 8; ++i) sc[i] = (f32x4){0.f, 0.f, 0.f, 0.f};
#pragma unroll
    for (int kb = 0; kb < 8; ++kb) {
        const bf16x8 bq = *(const LAS bf16x8*)(lds + (16 * w + i16) * SC_P + (32 * kb + 8 * g) * 2);
#pragma unroll
        for (int mb = 0; mb < 8; ++mb) { const bf16x8 ak = *(const LAS bf16x8*)(lds + 128 * SC_P + (16 * mb + i16) * SC_P + (32 * kb + 8 * g) * 2); sc[mb] = MFMA16(ak, bq, sc[mb]); }
        __builtin_amdgcn_sched_barrier(0);
    }
    const int c = 16 * w + i16;
    bf16* prow = PG + (size_t)item * 16384 + c * 128;
#pragma unroll
    for (int mb = 0; mb < 8; ++mb) {
        const int m0 = 16 * mb + 4 * g;
        const float v0 = (m0 <= c) ? sc[mb][0] : 0.f, v1 = (m0 + 1 <= c) ? sc[mb][1] : 0.f, v2 = (m0 + 2 <= c) ? sc[mb][2] : 0.f, v3 = (m0 + 3 <= c) ? sc[mb][3] : 0.f;
        u32x2 pw; pw.x = pk2(v0, v1); pw.y = pk2(v2, v3);
        *(u32x2*)(prow + m0) = pw;
    }
}

constexpr int R2_RING = 0, R2_V = 65536, R2_P = 98304, R2_SS = 131072;
#define DMA16(gp, lp) __builtin_amdgcn_global_load_lds((const unsigned*)(gp), (LAS unsigned*)(lp), 16, 0, 0)
DI void retention_unit2(ldsp lds, const bf16* RQ, const bf16* RK, bf16* RV, const bf16* PG, float* RS, int b, int hh, int es) {
    const int tid = threadIdx.x, lane = tid & 63, w = __builtin_amdgcn_readfirstlane(tid >> 6), i16 = lane & 15, g = lane >> 4, qq = i16 >> 2, pp = i16 & 3;
    const size_t rowbase = (size_t)b * S_;
    const float g128 = exp2f(128.0f * __log2f(1.0f - exp2f(-5.0f - (float)hh)));
    const int r8 = lane >> 3;
    const int fq0 = (((r8 >> 1) & 1) << 1) | ((r8 >> 2) & 1);
    const unsigned char* qsrc = (const unsigned char*)(RQ + (rowbase + 16 * w) * 1024 + hh * 256);
    const unsigned char* ksrc = (const unsigned char*)(RK + (rowbase + 16 * w) * 1024 + hh * 256);
    const unsigned qc0 = (unsigned)(r8 * 1024 + ((lane & 7) ^ fq0) * 8) * 2u, qc1 = (unsigned)((r8 + 8) * 1024 + ((lane & 7) ^ (fq0 | 4)) * 8) * 2u;
    const int r4 = lane >> 4;
    const unsigned char* vsrc = (const unsigned char*)(RV + (rowbase + 16 * w) * 2048 + hh * 512 + es * 128);
    const unsigned char* psrc = (const unsigned char*)(PG + ((size_t)((b * 4 + hh) * 16) * 128 + 16 * w) * 128);
    unsigned voff[4], poff[4];
#pragma unroll
    for (int j = 0; j < 4; ++j) { const int row = 16 * w + 4 * j + r4; const int hs = 2 * ((row & 3) | (((row >> 3) & 1) << 2));
        voff[j] = (unsigned)((4 * j + r4) * 2048 + (((lane & 15) ^ hs) * 8)) * 2u; poff[j] = (unsigned)((4 * j + r4) * 128 + (((lane & 15) ^ (row & 15)) * 8)) * 2u; }
    const int fA0 = (((i16 >> 1) & 1) << 1) | ((i16 >> 2) & 1) | (((i16 >> 3) & 1) << 2);
    const int fT0 = (((qq >> 1) & 1) << 1) | ((g & 1) << 2);
    const int hV0 = 2 * (qq | ((g & 1) << 2));
    f32x4 Tst[16];
#pragma unroll
    for (int i = 0; i < 16; ++i) Tst[i] = (f32x4){0.f, 0.f, 0.f, 0.f};
    __syncthreads();
    {
        DMA16(qsrc + qc0, lds + R2_RING + (2 * w) * 1024); DMA16(qsrc + qc1, lds + R2_RING + (2 * w + 1) * 1024);
        DMA16(ksrc + qc0, lds + R2_RING + 16384 + (2 * w) * 1024); DMA16(ksrc + qc1, lds + R2_RING + 16384 + (2 * w + 1) * 1024);
#pragma unroll
        for (int j = 0; j < 4; ++j) DMA16(vsrc + voff[j], lds + R2_V + (4 * w + j) * 1024);
    }
    asm volatile("s_waitcnt vmcnt(0)" ::: "memory");
    __syncthreads();
    for (int ch = 0; ch < 16; ++ch) {
        const int c0 = ch * 128;
        f32x4 cr[8]; bf16x8 vf[4];
#pragma unroll
        for (int i = 0; i < 8; ++i) cr[i] = (f32x4){0.f, 0.f, 0.f, 0.f};
#pragma unroll
        for (int qd = 0; qd < 4; ++qd) {
            const int cur = qd & 1;
            int fA = fA0, fT = fT0, hV = hV0, lane_ = lane;
            asm volatile("" : "+v"(fA), "+v"(fT), "+v"(hV), "+v"(lane_));
            const int i16 = lane_ & 15, g = lane_ >> 4, qq = i16 >> 2, pp = i16 & 3;
            {
                const int nch = (qd == 3) ? ch + 1 : ch, nqd = (qd + 1) & 3;
                if (nch < 16) {
                    const size_t go = ((size_t)(nch * 128) * 1024 + nqd * 64) * 2;
                    const ldsp rb = lds + R2_RING + (cur ^ 1) * 32768;
                    DMA16(qsrc + go + qc0, rb + (2 * w) * 1024); DMA16(qsrc + go + qc1, rb + (2 * w + 1) * 1024);
                    DMA16(ksrc + go + qc0, rb + 16384 + (2 * w) * 1024); DMA16(ksrc + go + qc1, rb + 16384 + (2 * w + 1) * 1024);
                }
                if (qd == 0) {
#pragma unroll
                    for (int j = 0; j < 4; ++j) DMA16(psrc + (size_t)ch * 32768 + poff[j], lds + R2_P + (4 * w + j) * 1024);
                }
                if (qd == 1 && ch + 1 < 16) {
#pragma unroll
                    for (int j = 0; j < 4; ++j) DMA16(vsrc + (size_t)((ch + 1) * 128) * 4096 + voff[j], lds + R2_V + (4 * w + j) * 1024);
                }
            }
            const LAS unsigned char* Qb = lds + R2_RING + cur * 32768; const LAS unsigned char* Kb = Qb + 16384;
            if (qd == 0) {
#pragma unroll
                for (int cbk = 0; cbk < 4; ++cbk) {
                    const LAS unsigned char* ap = lds + R2_V + (32 * cbk + 8 * g + qq) * 256 + (((2 * w + (pp >> 1)) ^ hV) * 16) + 8 * (pp & 1);
                    const s16x4 lo = tr_read(ap), hi4 = tr_read(ap + 4 * 256);
                    vf[cbk] = __builtin_shufflevector(lo, hi4, 0, 1, 2, 3, 4, 5, 6, 7);
                }
            }
#pragma unroll
            for (int kb = 0; kb < 2; ++kb) {
                const int kbg = 2 * qd + kb;
                u32x4 tp; tp.x = pk2(Tst[2 * kbg][0], Tst[2 * kbg][1]); tp.y = pk2(Tst[2 * kbg][2], Tst[2 * kbg][3]); tp.z = pk2(Tst[2 * kbg + 1][0], Tst[2 * kbg + 1][1]); tp.w = pk2(Tst[2 * kbg + 1][2], Tst[2 * kbg + 1][3]);
                const bf16x8 tb = __builtin_bit_cast(bf16x8, tp);
                const int ol = (((4 * kb + (g >> 1)) ^ fA) * 16) + 8 * (g & 1), oh = (((4 * kb + (g >> 1) + 2) ^ fA) * 16) + 8 * (g & 1);
#pragma unroll
                for (int cb = 0; cb < 8; ++cb) {
                    const LAS unsigned char* qp = Qb + (16 * cb + i16) * 128;
                    const s16x4 lo = *(const LAS s16x4*)(qp + ol), hi4 = *(const LAS s16x4*)(qp + oh);
                    const bf16x8 aq = __builtin_shufflevector(lo, hi4, 0, 1, 2, 3, 4, 5, 6, 7);
                    cr[cb] = MFMA16(aq, tb, cr[cb]);
                }
                __builtin_amdgcn_sched_barrier(0);
            }
#pragma unroll
            for (int dtl = 0; dtl < 4; ++dtl) {
                const int dt = 4 * qd + dtl;
                Tst[dt] = Tst[dt] * g128;
                const int ot = (((2 * dtl + (pp >> 1)) ^ fT) * 16) + 8 * (pp & 1);
#pragma unroll
                for (int cbk = 0; cbk < 4; ++cbk) {
                    const LAS unsigned char* ap = Kb + (32 * cbk + 8 * g + qq) * 128;
                    const s16x4 lo = tr_read(ap + ot), hi4 = tr_read(ap + 4 * 128 + (ot ^ 16));
                    const bf16x8 ak = __builtin_shufflevector(lo, hi4, 0, 1, 2, 3, 4, 5, 6, 7);
                    Tst[dt] = MFMA16(ak, vf[cbk], Tst[dt]);
                }
                __builtin_amdgcn_sched_barrier(0);
            }
            asm volatile("s_waitcnt vmcnt(0)" ::: "memory");
            __syncthreads();
        }
#pragma unroll
        for (int cb = 0; cb < 8; ++cb) cr[cb] = cr[cb] * g128;
#pragma unroll
        for (int cb = 0; cb < 8; ++cb)
#pragma unroll
            for (int mbk = 0; mbk < 4; ++mbk) if (32 * mbk <= 16 * cb + 15) {
                const bf16x8 ap = *(const LAS bf16x8*)(lds + R2_P + (16 * cb + i16) * 256 + (((4 * mbk + g) ^ i16) * 16));
                cr[cb] = MFMA16(ap, vf[mbk], cr[cb]);
            }
        __syncthreads();
        {
            const ldsp ob = lds + R2_P + (16 * w + i16) * 2;
#pragma unroll
            for (int cb = 0; cb < 8; ++cb)
#pragma unroll
                for (int j = 0; j < 4; ++j) *(LAS unsigned short*)(ob + (16 * cb + 4 * g + j) * 256) = (unsigned short)(pk2(cr[cb][j], 0.f) & 0xffffu);
        }
        __syncthreads();
        {
            const int row = tid >> 2, seg = tid & 3;
            const LAS u32x4* src = (const LAS u32x4*)(lds + R2_P + row * 256 + seg * 64);
            u32x4* dst = (u32x4*)(RV + (rowbase + c0 + row) * 2048 + hh * 512 + es * 128 + seg * 32);
            float s = 0.f;
#pragma unroll
            for (int k = 0; k < 4; ++k) { const u32x4 v = src[k]; dst[k] = v; f32x4 fa, fb; unpack8(v, fa, fb);
                s += (fa[0] * fa[0] + fa[1] * fa[1]) + (fa[2] * fa[2] + fa[3] * fa[3]) + (fb[0] * fb[0] + fb[1] * fb[1]) + (fb[2] * fb[2] + fb[3] * fb[3]); }
            s += __shfl_xor(s, 1); s += __shfl_xor(s, 2);
            if (seg == 0) RS[(rowbase + c0 + row) * 16 + hh * 4 + es] = s;
        }
        __syncthreads();
    }
    __syncthreads();
}

#define GEMM_PHASE2(EpiT, E, Aptr, Bptr, N_, K_, A2ptr, SPLIT_) do { pg8::Gemm g_{(const pg8::bf16_t*)(Aptr), (const pg8::bf16_t*)(Bptr), T_, (N_), (K_), (const pg8::bf16_t*)(A2ptr), (SPLIT_)}; pg8::StaticOrder S_o; S_o.init(T_, (N_), G, (int)blockIdx.x); \
    pg8::gemm_phase<EpiT, pg8::StaticOrder, true, true>(lds, g_, S_o, (E)); } while (0)
#define GEMM_PHASE(EpiT, E, Aptr, Bptr, N_, K_) GEMM_PHASE2(EpiT, E, Aptr, Bptr, N_, K_, Aptr, (1 << 30))
#ifndef PH_LO
#define PH_LO 0
#endif
#ifndef PH_HI
#define PH_HI 99
#endif
#define XB_TMO      128
#define XB_XCNT(j)  (256  + 64 * (j))
#define XB_XSUB(j)  (1280 + 64 * (j))
#define XB_XGEN(j)  (2304 + 64 * (j))
#define XB_TOP      3328
#define XB_TOPGEN   3392
#define XCD_BAR_WORDS 3456
#define XB_SPIN_CAP (1u << 18)

__device__ __forceinline__ unsigned xb_ld(unsigned* p)              { return __hip_atomic_load(p, __ATOMIC_RELAXED, __HIP_MEMORY_SCOPE_AGENT); }
__device__ __forceinline__ unsigned xb_add(unsigned* p, unsigned v) { return __hip_atomic_fetch_add(p, v, __ATOMIC_RELAXED, __HIP_MEMORY_SCOPE_AGENT); }
__device__ __forceinline__ unsigned xb_xcc_id() { return (unsigned)__builtin_amdgcn_s_getreg((3 << 11) | 20) & 0xFu; }
#define XB_SPIN(cond, bar) do { unsigned _sp = 0; while (cond) { __builtin_amdgcn_s_sleep(1); \
    if ((++_sp & 255u) == 0u) { if (xb_ld(&(bar)[XB_TMO])) break; if (_sp > XB_SPIN_CAP) { atomicAdd(&(bar)[XB_TMO], 1u); break; } } } } while (0)

struct XcdBarrier {
    unsigned* bar; unsigned x;
    volatile LAS unsigned* st;
};

__device__ __forceinline__ XcdBarrier xcd_barrier_post(unsigned* bar, volatile LAS unsigned* st) {
    XcdBarrier b; b.bar = bar; b.x = xb_xcc_id(); b.st = st;
    if (threadIdx.x == 0) (void)xb_add(&bar[XB_XCNT(b.x)], 1u);
    return b;
}
__device__ __forceinline__ void xcd_barrier_complete(unsigned* bar, unsigned x, unsigned& nloc, unsigned& nx) {
    const unsigned G = gridDim.x * gridDim.y * gridDim.z;
    unsigned sum, cnt, mine, sp = 0u;
    for (;;) {
        sum = 0u; cnt = 0u; mine = 0u;
#pragma unroll
        for (unsigned j = 0; j < 16; ++j) { const unsigned c = xb_ld(&bar[XB_XCNT(j)]); sum += c; cnt += (c > 0u) ? 1u : 0u; mine = (j == x) ? c : mine; }
        if (sum == G) break;
        __builtin_amdgcn_s_sleep(1);
        if ((++sp & 255u) == 0u) { if (xb_ld(&bar[XB_TMO])) break; if (sp > XB_SPIN_CAP) { atomicAdd(&bar[XB_TMO], 1u); break; } }
    }
    nloc = mine > 0u ? mine : 1u; nx = cnt > 0u ? cnt : 1u;
}

__device__ __forceinline__ void xcd_barrier(const XcdBarrier& b) {
    asm volatile("s_waitcnt vmcnt(0)" ::: "memory");
    __syncthreads();
    if (threadIdx.x == 0) {
        unsigned* bar = b.bar;
        __builtin_amdgcn_s_waitcnt(0);
        unsigned nloc = b.st[0], nx = b.st[1];
        if (nloc == 0u) { xcd_barrier_complete(bar, b.x, nloc, nx); b.st[0] = nloc; b.st[1] = nx; }
        const unsigned old = xb_add(&bar[XB_XSUB(b.x)], 1u);
        const unsigned gen = old / nloc;
        if (old + 1u == (gen + 1u) * nloc) {
            __builtin_amdgcn_fence(__ATOMIC_RELEASE, "agent");
            asm volatile("s_waitcnt vmcnt(0)" ::: "memory");
            const unsigned og = xb_add(&bar[XB_TOP], 1u);
            const unsigned tg = og / nx;
            if (og + 1u == (tg + 1u) * nx) xb_add(&bar[XB_TOPGEN], 1u);
            else XB_SPIN(xb_ld(&bar[XB_TOPGEN]) == tg, bar);
            __builtin_amdgcn_fence(__ATOMIC_ACQUIRE, "agent");
            xb_add(&bar[XB_XGEN(b.x)], 1u);
            asm volatile("s_waitcnt vmcnt(0)" ::: "memory");
        } else {
            XB_SPIN(xb_ld(&bar[XB_XGEN(b.x)]) == gen, bar);
            __builtin_amdgcn_fence(__ATOMIC_ACQUIRE, "agent");
            asm volatile("s_waitcnt vmcnt(0)" ::: "memory");
        }
    }
    __syncthreads();
}

DI void fast_grid_barrier(unsigned* ctr, unsigned target) {
    asm volatile("s_waitcnt vmcnt(0)" ::: "memory");
    __syncthreads();
    if (threadIdx.x == 0) {
        __builtin_amdgcn_fence(__ATOMIC_RELEASE, "agent");
        asm volatile("s_waitcnt vmcnt(0)" ::: "memory");
        __hip_atomic_fetch_add(ctr, 1u, __ATOMIC_RELAXED, __HIP_MEMORY_SCOPE_AGENT);
        while (__hip_atomic_load(ctr, __ATOMIC_RELAXED, __HIP_MEMORY_SCOPE_AGENT) < target) __builtin_amdgcn_s_sleep(1);
        __builtin_amdgcn_fence(__ATOMIC_ACQUIRE, "agent");
        asm volatile("s_waitcnt vmcnt(0)" ::: "memory");
    }
    __syncthreads();
}
typedef const __attribute__((address_space(4))) Args* kargp;
#if defined(__HIP_DEVICE_COMPILE__)
DI Args load_args() { kargp kp = (kargp)__builtin_amdgcn_kernarg_segment_ptr(); asm volatile("" : "+s"(kp)); Args a;
    a.x = kp->x; a.c = kp->c; a.w_ada = kp->w_ada; a.b_ada = kp->b_ada; a.g1 = kp->g1; a.w_in = kp->w_in; a.b_branch = kp->b_branch; a.w_sb = kp->w_sb; a.w_ret = kp->w_ret; a.w_out = kp->w_out;
    a.g2 = kp->g2; a.w_ffi = kp->w_ffi; a.w_ffo = kp->w_ffo; a.gf = kp->gf; a.out = kp->out; a.ws = kp->ws; return a; }
#else
DI Args load_args() { return Args{}; }
#endif
#define PHASE_ARGS const Args A = load_args(); unsigned char* const ws = A.ws; bf16* const hmix = (bf16*)A.out; (void)ws; (void)hmix
__global__ void __launch_bounds__(NTHR, 2) fwd_megakernel(Args Aunused) {
    extern __shared__ __attribute__((aligned(16))) unsigned char lds_raw[];
    ldsp lds = (ldsp)lds_raw;
    cg::grid_group grid = cg::this_grid();
    const int G = gridDim.x;
    unsigned bar_k = 0u; (void)bar_k;
    volatile LAS unsigned* xb_st = (volatile LAS unsigned*)(lds + LDS_BYTES - 64);
    if (threadIdx.x < 2) xb_st[threadIdx.x] = 0u;
    XcdBarrier xbar; xbar.bar = nullptr; xbar.x = 0; xbar.st = xb_st;
#define GBAR() do { xcd_barrier(xbar); } while (0)
#ifndef PHM
#define PHM 0xFFFFF
#endif
    if (PHM & 1) { PHASE_ARGS; if (blockIdx.x == 0) { for (int i = threadIdx.x; i < XCD_BAR_WORDS; i += NTHR) __hip_atomic_store((unsigned*)(ws + WS_CTR) + 1024 + i, 0u, __ATOMIC_RELAXED, __HIP_MEMORY_SCOPE_AGENT); }
      if (blockIdx.x == 0 && threadIdx.x == 0) { __hip_atomic_store((unsigned*)(ws + WS_CTR), 0u, __ATOMIC_RELAXED, __HIP_MEMORY_SCOPE_AGENT); __hip_atomic_store((unsigned*)(ws + WS_CTR) + 64, 0u, __ATOMIC_RELAXED, __HIP_MEMORY_SCOPE_AGENT); } p0_prologue(A, lds, G); }
    grid.sync();
    { PHASE_ARGS; xbar = xcd_barrier_post((unsigned*)(ws + WS_CTR) + 1024, xb_st); }
    if (PHM & 2) { PHASE_ARGS; norm_mod_phase<true>(A, lds, G, A.x, A.g1, hmix, 0); }
    GBAR();
    if (PHM & 4) { PHASE_ARGS; EpiInProj E{(bf16*)(ws + WS_SBQ), (bf16*)(ws + WS_SBK), (bf16*)(ws + WS_SBV), (bf16*)(ws + WS_RQ), (bf16*)(ws + WS_RK), (bf16*)(ws + WS_RV), (const float*)(ws + WS_COS), (const float*)(ws + WS_SIN)};
      GEMM_PHASE(EpiInProj, E, hmix, ws + WS_WIN, 7168, 1024); }
    GBAR();
    if (PHM & 8) { PHASE_ARGS; for (int it = blockIdx.x; it < 1024; it += G) ret_scores_item(lds, (const bf16*)(ws + WS_RQ), (const bf16*)(ws + WS_RK), (bf16*)((unsigned char*)A.out + 64 * MiB), it); }
    __syncthreads();
    if (PHM & 16) { PHASE_ARGS;
        const int wv = __builtin_amdgcn_readfirstlane(threadIdx.x >> 6);
        unsigned* ctr = (unsigned*)(ws + WS_CTR);
        for (;;) {
            unsigned uu = 0u;
            if ((threadIdx.x & 63) == 0) uu = __hip_atomic_fetch_add(ctr, 1u, __ATOMIC_RELAXED, __HIP_MEMORY_SCOPE_AGENT);
            const int u = __builtin_amdgcn_readfirstlane((int)uu);
            if (u >= 16384) break;
            sb_attn_wave(lds + wv * 16384, (const bf16*)(ws + WS_SBQ), (const bf16*)(ws + WS_SBK), (const bf16*)(ws + WS_SBV), (bf16*)(ws + WS_SBQ), u >> 10, (u >> 6) & 15, 63 - (u & 63));
        }
    }
    GBAR();
    if (PHM & 0x2000) { PHASE_ARGS; for (int u = blockIdx.x; u < 256; u += G) retention_unit2(lds, (const bf16*)(ws + WS_RQ), (const bf16*)(ws + WS_RK), (bf16*)(ws + WS_RV), (const bf16*)((unsigned char*)A.out + 64 * MiB), (float*)(ws + WS_RS), u >> 4, (u >> 2) & 3, u & 3); }
    GBAR();
    if (PHM & 32) { PHASE_ARGS; EpiGates E{(bf16*)(ws + WS_RV), (bf16*)(ws + WS_GATES), (const float*)(ws + WS_RS), A.b_branch, (bf16*)(ws + WS_M1)};
      GEMM_PHASE2(EpiGates, E, hmix, ws + WS_WIN + (size_t)7168 * 1024 * 2, 5120, 1024, ws + WS_SBQ, 16); }
    GBAR();
    if (PHM & 128) { PHASE_ARGS; EpiMerge2 E{(const bf16*)(ws + WS_GATES), (const bf16*)(ws + WS_M1), (bf16*)(ws + WS_MERGED)};
      GEMM_PHASE(EpiMerge2, E, ws + WS_RV, ws + WS_WRET, 1024, 2048); }
    GBAR();
    if (PHM & 256) { PHASE_ARGS; EpiResid<false> E{A.x, (bf16*)(ws + WS_X2), (const float*)(ws + WS_MODF) + 2048};
      GEMM_PHASE(EpiResid<false>, E, ws + WS_MERGED, ws + WS_WOUT, 1024, 1024); }
    GBAR();
    if (PHM & 512) { PHASE_ARGS; norm_mod_phase<false>(A, lds, G, (const float*)(ws + WS_X2), A.g2, (bf16*)(ws + WS_HFFN), 3072); }
    GBAR();
    if (PHM & 1024) { PHASE_ARGS; EpiSwiglu E{(bf16*)(ws + WS_H)};
      GEMM_PHASE(EpiSwiglu, E, ws + WS_HFFN, ws + WS_WFFI, 2 * DFF, 1024); }
    GBAR();
    if (PHM & 2048) { PHASE_ARGS; EpiResid<true> E{(const void*)(ws + WS_X2), (bf16*)(ws + WS_X2), (const float*)(ws + WS_MODF) + 5120};
      GEMM_PHASE(EpiResid<true>, E, ws + WS_H, ws + WS_WFFO, 1024, DFF); }
    GBAR();
    if (PHM & 4096) { PHASE_ARGS; final_norm_phase(A, G, (const bf16*)(ws + WS_X2)); }
}

extern "C" void kernel_launch(void* const* d_in, const int* in_sizes, int n_in, void* d_out, int out_size, void* d_ws, size_t ws_size, hipStream_t stream) {
    static int grid = 0;
    if (grid == 0) {
        if (n_in != 14 || in_sizes[0] != T_ * D_ || out_size != T_ * D_ || ws_size < WS_END) { fprintf(stderr, "kernel_launch: unexpected shapes / ws %zu\n", ws_size); grid = -1; return; }
        int dev = 0, cus = 0, per_cu = 0;
        hipGetDevice(&dev); hipDeviceGetAttribute(&cus, hipDeviceAttributeMultiprocessorCount, dev);
        if (hipFuncSetAttribute((const void*)fwd_megakernel, hipFuncAttributeMaxDynamicSharedMemorySize, LDS_BYTES) != hipSuccess) { fprintf(stderr, "hipFuncSetAttribute failed\n"); grid = -1; return; }
        if (hipOccupancyMaxActiveBlocksPerMultiprocessor(&per_cu, (const void*)fwd_megakernel, NTHR, LDS_BYTES) != hipSuccess || per_cu < 1) { fprintf(stderr, "occupancy query: %d\n", per_cu); per_cu = 1; }
        (void)hipGetLastError();
        grid = cus * per_cu;
    }
    if (grid < 0) return;
    Args a{};
    a.x = (const float*)d_in[0]; a.c = (const float*)d_in[1]; a.w_ada = (const float*)d_in[2]; a.b_ada = (const float*)d_in[3]; a.g1 = (const float*)d_in[4];
    a.w_in = (const float*)d_in[5]; a.b_branch = (const float*)d_in[6]; a.w_sb = (const float*)d_in[7]; a.w_ret = (const float*)d_in[8]; a.w_out = (const float*)d_in[9];
    a.g2 = (const float*)d_in[10]; a.w_ffi = (const float*)d_in[11]; a.w_ffo = (const float*)d_in[12]; a.gf = (const float*)d_in[13];
    a.out = (float*)d_out; a.ws = (unsigned char*)d_ws;
    void* args[] = {&a};
    hipError_t e = hipLaunchCooperativeKernel((const void*)fwd_megakernel, dim3(grid), dim3(NTHR), args, LDS_BYTES, stream);
    if (e != hipSuccess) fprintf(stderr, "cooperative launch failed: %s (grid %d)\n", hipGetErrorString(e), grid);
}
```

```cpp
#include <hip/hip_runtime.h>
#include <hip/hip_cooperative_groups.h>
#include <cstdio>
#include <cstdint>
namespace cg = cooperative_groups;
namespace pg8 {
#define PG8_LAS __attribute__((address_space(3)))
typedef unsigned short bf16_t;
typedef short bf16x8 __attribute__((ext_vector_type(8)));
typedef float f32x4 __attribute__((ext_vector_type(4)));
typedef unsigned u32x4 __attribute__((ext_vector_type(4)));
constexpr int BM = 256, BK = 64, HALF = 128, HTB = HALF * BK * 2  , STAGE_BYTES = 8 * HTB, NXCD = 8, WGM = 8;

__host__ __device__ __forceinline__ int lds_byte(int r, int c) { const int st = (r >> 4) * 2 + (c >> 5), rr = r & 15, cc = c & 31, ob = rr * 64 + cc * 2; return st * 1024 + (ob ^ (((ob >> 9) & 1) << 5)); }
__host__ __device__ __forceinline__ void stage_rc(int b, int& R, int& C) { const int st = b / 1024, sb = b % 1024, swz = sb ^ (((sb >> 9) & 1) << 5); R = (st >> 1) * 16 + swz / 64; C = (st & 1) * 32 + (swz % 64) / 2; }
__host__ __device__ __forceinline__ int perm32(int rho) { const int n = rho >> 4, i = rho & 15; return 8 * (i >> 2) + 4 * n + (i & 3); }

struct Unit { int pm, pn; };
struct Gemm { const bf16_t* A; const bf16_t* Bt; int M, N, K; const bf16_t* A2; int pn_split; };

struct StaticOrder {
    int nM, nN, nwg, G, c;
    __host__ __device__ void init(int M, int N, int G_, int c_) { nM = M / BM; nN = N / BM; nwg = nM * nN; G = G_; c = c_; }
    __host__ __device__ bool next(int i, Unit& u) const {
        const long L = (long)i * G + c; if (L >= nwg) return false;
        int wgid = (int)L; { const int q = nwg / NXCD, r = nwg % NXCD, xcd = wgid % NXCD, off = wgid / NXCD; wgid = (xcd < r ? xcd * (q + 1) : r * (q + 1) + (xcd - r) * q) + off; }
        const int nig = WGM * nN, gid = wgid / nig, fm = gid * WGM, gsz = (nM - fm) < WGM ? (nM - fm) : WGM;
        u.pm = fm + ((wgid % nig) % gsz); u.pn = (wgid % nig) / gsz; return true;
    }
    __device__ __forceinline__ void a_ready(const Unit&) const {}
    __device__ __forceinline__ void done(const Unit&) const {}
};

__device__ __forceinline__ unsigned cvt_pk_bf16(float lo, float hi) { unsigned r; asm volatile("v_cvt_pk_bf16_f32 %0, %1, %2" : "=v"(r) : "v"(lo), "v"(hi)); return r; }
template <class Epi, class Sched, bool ALIGN_EPI = false, bool SP2 = false>
__device__ __forceinline__ void gemm_phase(PG8_LAS unsigned char* lds, const Gemm g, const Sched& S, const Epi& E) {
    int tid_ = threadIdx.x; asm volatile("" : "+v"(tid_));
    const int tid = tid_, wid = __builtin_amdgcn_readfirstlane(tid >> 6), lane = tid & 63, wr = wid >> 2, wc = wid & 3, fr = lane & 15, fq = lane >> 4;
    const int K = g.K, nt = K / BK;
    unsigned voffA[2], voffB[2];
#pragma unroll
    for (int i = 0; i < 2; ++i) { int R, C; stage_rc(tid * 16 + i * 8192, R, C); const int Rb = Epi::PERM ? ((R & ~31) + perm32(R & 31)) : R;
        voffA[i] = (unsigned)(R * K + C) * 2u; voffB[i] = (unsigned)(Rb * K + C) * 2u; }
    const size_t kstep = (size_t)(BK * 2);
    const size_t hstep = (size_t)HALF * K * 2;
    const size_t tstep = 2 * hstep;
    const unsigned ldsw = (unsigned)wid * 1024u;
    const int aoff = lds_byte(wr * 64 + fr, fq * 8), boff = lds_byte(wc * 32 + fr, fq * 8);
#define PG8_SA(b, h) (((b) * 2 + (h)) * HTB)
#define PG8_SB(b, h) ((4 + (b) * 2 + (h)) * HTB)
#define PG8_STAGE(bufoff, gbase, voff) do { _Pragma("unroll") for (int _i = 0; _i < 2; ++_i) \
        __builtin_amdgcn_global_load_lds((const unsigned*)((const char*)(gbase) + (voff)[_i]), (PG8_LAS unsigned*)(lds + (bufoff) + ldsw + _i * 8192), 16, 0, 0); } while (0)
#define PG8_LDA(dst, b, h) do { _Pragma("unroll") for (int m = 0; m < 4; ++m) _Pragma("unroll") for (int k = 0; k < 2; ++k) dst[m][k] = *(const PG8_LAS bf16x8*)(lds + PG8_SA(b, h) + aoff + m * 2048 + k * 1024); } while (0)
#define PG8_LDB(dst, b, h) do { _Pragma("unroll") for (int n = 0; n < 2; ++n) _Pragma("unroll") for (int k = 0; k < 2; ++k) dst[n][k] = *(const PG8_LAS bf16x8*)(lds + PG8_SB(b, h) + boff + n * 2048 + k * 1024); } while (0)
#define PG8_MMA(ai, bj, At, Bt) do { __builtin_amdgcn_s_setprio(1); _Pragma("unroll") for (int m = 0; m < 4; ++m) _Pragma("unroll") for (int n = 0; n < 2; ++n) _Pragma("unroll") for (int k = 0; k < 2; ++k) \
        acc[ai][bj][m][n] = __builtin_amdgcn_mfma_f32_16x16x32_bf16(Bt[n][k], At[m][k], acc[ai][bj][m][n], 0, 0, 0); __builtin_amdgcn_s_setprio(0); } while (0)
#define PG8_WAIT_V(n) asm volatile("s_waitcnt vmcnt(" #n ")" ::: "memory")
#define PG8_WAIT_L(n) asm volatile("s_waitcnt lgkmcnt(" #n ")" ::: "memory")
#define PG8_BAR __builtin_amdgcn_s_barrier()
#define PG8_SCHED __builtin_amdgcn_sched_barrier(0)
    Unit cur, nxt; int ui = 0;
    if (!S.next(0, cur)) return;
    f32x4 acc[2][2][4][2];
#pragma unroll
    for (int a = 0; a < 2; ++a)
#pragma unroll
        for (int b = 0; b < 2; ++b)
#pragma unroll
            for (int m = 0; m < 4; ++m)
#pragma unroll
                for (int n = 0; n < 2; ++n) acc[a][b][m][n] = (f32x4){0.f, 0.f, 0.f, 0.f};
    bf16x8 At[4][2], B0[2][2], B1[2][2];
    const char* cA = (const char*)(cur.pn >= g.pn_split ? g.A2 : g.A) + (size_t)cur.pm * tstep; const char* cB = (const char*)g.Bt + (size_t)cur.pn * tstep;
    S.a_ready(cur);
    if constexpr (SP2) {
        PG8_STAGE(PG8_SB(0, 0), cB, voffB); PG8_STAGE(PG8_SB(0, 1), cB + hstep, voffB); PG8_STAGE(PG8_SA(0, 0), cA, voffA); PG8_STAGE(PG8_SA(0, 1), cA + hstep, voffA);
        if (wr == 1) PG8_BAR;
        PG8_WAIT_V(2); PG8_BAR;
        PG8_STAGE(PG8_SB(1, 0), cB + kstep, voffB); PG8_STAGE(PG8_SA(1, 0), cA + kstep, voffA); PG8_STAGE(PG8_SB(1, 1), cB + hstep + kstep, voffB);
        PG8_WAIT_V(6); PG8_BAR;
    } else {
        PG8_STAGE(PG8_SB(0, 0), cB, voffB); PG8_STAGE(PG8_SA(0, 0), cA, voffA); PG8_STAGE(PG8_SB(0, 1), cB + hstep, voffB); PG8_STAGE(PG8_SA(0, 1), cA + hstep, voffA);
        if (wr == 1) PG8_BAR;
        PG8_WAIT_V(4); PG8_BAR;
        PG8_STAGE(PG8_SB(1, 0), cB + kstep, voffB); PG8_STAGE(PG8_SA(1, 0), cA + kstep, voffA); PG8_STAGE(PG8_SB(1, 1), cB + hstep + kstep, voffB);
        PG8_WAIT_V(6); PG8_BAR;
    }
    for (;;) {
        const bool has_next = S.next(ui + 1, nxt);
        const char* nA = has_next ? (const char*)(nxt.pn >= g.pn_split ? g.A2 : g.A) + (size_t)nxt.pm * tstep : cA; const char* nB = has_next ? (const char*)g.Bt + (size_t)nxt.pn * tstep : cB;
        for (int t = 0; t < nt; t += 2) {
            const bool last = (t == nt - 2);
            const char* a1 = cA + (size_t)(t + 1) * kstep;
            const char* a2 = last ? nA : cA + (size_t)(t + 2) * kstep; const char* b2 = last ? nB : cB + (size_t)(t + 2) * kstep;
            const char* a3 = a2 + kstep; const char* b3 = b2 + kstep;
            if (last && has_next) S.a_ready(nxt);
            if constexpr (SP2) {
            PG8_LDB(B0, 0, 0); PG8_LDB(B1, 0, 1); PG8_SCHED; PG8_LDA(At, 0, 0); PG8_STAGE(PG8_SA(1, 1), a1 + hstep, voffA);
            PG8_WAIT_V(8); PG8_WAIT_L(0); PG8_BAR; PG8_MMA(0, 0, At, B0); PG8_MMA(0, 1, At, B1); PG8_BAR; PG8_SCHED;
            PG8_LDA(At, 0, 1); PG8_STAGE(PG8_SB(0, 0), b2, voffB); PG8_STAGE(PG8_SB(0, 1), b2 + hstep, voffB); PG8_STAGE(PG8_SA(0, 0), a2, voffA);
            PG8_WAIT_V(8); PG8_WAIT_L(0); PG8_BAR; PG8_MMA(1, 0, At, B0); PG8_MMA(1, 1, At, B1); PG8_BAR; PG8_SCHED;
            PG8_LDB(B0, 1, 0); PG8_LDB(B1, 1, 1); PG8_SCHED; PG8_LDA(At, 1, 0); PG8_STAGE(PG8_SA(0, 1), a2 + hstep, voffA);
            PG8_WAIT_V(8); PG8_WAIT_L(0); PG8_BAR; PG8_MMA(0, 0, At, B0); PG8_MMA(0, 1, At, B1); PG8_BAR; PG8_SCHED;
            PG8_LDA(At, 1, 1); PG8_STAGE(PG8_SB(1, 0), b3, voffB); PG8_STAGE(PG8_SB(1, 1), b3 + hstep, voffB); PG8_STAGE(PG8_SA(1, 0), a3, voffA);
            PG8_WAIT_V(8); PG8_WAIT_L(0); PG8_BAR; PG8_MMA(1, 0, At, B0); PG8_MMA(1, 1, At, B1); PG8_BAR; PG8_SCHED;
            } else {
            PG8_LDB(B0, 0, 0); PG8_SCHED; PG8_LDA(At, 0, 0); PG8_STAGE(PG8_SA(1, 1), a1 + hstep, voffA);
            PG8_WAIT_L(8); PG8_BAR; PG8_WAIT_L(0); PG8_MMA(0, 0, At, B0); PG8_BAR; PG8_SCHED;
            PG8_LDB(B1, 0, 1); PG8_STAGE(PG8_SB(0, 0), b2, voffB);
            PG8_BAR; PG8_WAIT_L(0); PG8_MMA(0, 1, At, B1); PG8_BAR;
            PG8_LDA(At, 0, 1); PG8_STAGE(PG8_SA(0, 0), a2, voffA);
            PG8_BAR; PG8_WAIT_L(0); PG8_MMA(1, 0, At, B0); PG8_BAR; PG8_SCHED;
            PG8_STAGE(PG8_SB(0, 1), b2 + hstep, voffB);
            PG8_WAIT_V(6); PG8_BAR; PG8_MMA(1, 1, At, B1); PG8_BAR;
            PG8_LDB(B0, 1, 0); PG8_SCHED; PG8_LDA(At, 1, 0); PG8_STAGE(PG8_SA(0, 1), a2 + hstep, voffA);
            PG8_WAIT_L(8); PG8_BAR; PG8_WAIT_L(0); PG8_MMA(0, 0, At, B0); PG8_BAR; PG8_SCHED;
            PG8_LDB(B1, 1, 1); PG8_STAGE(PG8_SB(1, 0), b3, voffB);
            PG8_BAR; PG8_WAIT_L(0); PG8_MMA(0, 1, At, B1); PG8_BAR;
            PG8_LDA(At, 1, 1); PG8_STAGE(PG8_SA(1, 0), a3, voffA);
            PG8_BAR; PG8_WAIT_L(0); PG8_MMA(1, 0, At, B0); PG8_BAR; PG8_SCHED;
            PG8_STAGE(PG8_SB(1, 1), b3 + hstep, voffB);
            PG8_WAIT_V(6); PG8_BAR; PG8_MMA(1, 1, At, B1); PG8_BAR;
            }
        }
        if constexpr (ALIGN_EPI) { if (wr == 0) PG8_BAR; }
        if constexpr (!Epi::AFTER_DRAIN) { E(acc, cur, wr, wc, fr, fq); S.done(cur); }
        if (!has_next) break;
#pragma unroll
        for (int a = 0; a < 2; ++a)
#pragma unroll
            for (int b = 0; b < 2; ++b)
#pragma unroll
                for (int m = 0; m < 4; ++m)
#pragma unroll
                    for (int n = 0; n < 2; ++n) acc[a][b][m][n] = (f32x4){0.f, 0.f, 0.f, 0.f};
        cur = nxt; cA = nA; cB = nB; ++ui;
        if constexpr (ALIGN_EPI) { if (wr == 1) PG8_BAR; }
    }
    PG8_WAIT_V(0);
    if constexpr (!ALIGN_EPI) { if (wr == 0) PG8_BAR; }
    PG8_BAR;
    if constexpr (Epi::AFTER_DRAIN) { E.fused(acc, cur, wr, wc, fr, fq, lds, wid, lane); S.done(cur); }
#undef PG8_SA
#undef PG8_SB
#undef PG8_STAGE
#undef PG8_LDA
#undef PG8_LDB
#undef PG8_MMA
#undef PG8_WAIT_V
#undef PG8_WAIT_L
#undef PG8_BAR
#undef PG8_SCHED
}
}

#define GAS __attribute__((address_space(1)))
#define LAS __attribute__((address_space(3)))
#define DI __device__ __forceinline__
typedef unsigned short bf16;
typedef unsigned u32x4 __attribute__((ext_vector_type(4)));
typedef unsigned u32x2 __attribute__((ext_vector_type(2)));
typedef float f32x4 __attribute__((ext_vector_type(4)));
typedef float f32x16 __attribute__((ext_vector_type(16)));
typedef short bf16x8 __attribute__((ext_vector_type(8)));
typedef short s16x4 __attribute__((ext_vector_type(4)));
typedef LAS unsigned char* ldsp;

constexpr int NWAVES = 8, NTHR = 512;
constexpr int T_ = 32768, D_ = 1024, S_ = 2048, NB = 16, DFF = 2816, INW = 11264, NMOD = 6144;
constexpr float EPS_ = 1e-6f;
constexpr size_t MiB = 1u << 20;
constexpr size_t WS_SBQ = 0, WS_SBK = 64 * MiB, WS_SBV = 128 * MiB, WS_RQ = 192 * MiB, WS_RK = 256 * MiB, WS_RV = 320 * MiB;
constexpr size_t WS_WIN = 448 * MiB, WS_WSB = 470 * MiB, WS_WRET = 472 * MiB, WS_WOUT = 476 * MiB, WS_WFFI = 478 * MiB, WS_WFFO = 489 * MiB;
constexpr size_t WS_CTR = 494 * MiB + 512 * 1024;
constexpr size_t WS_MODP = 495 * MiB, WS_MODF = 498 * MiB, WS_COS = 499 * MiB, WS_SIN = 500 * MiB, WS_RS = 501 * MiB, WS_END = 512 * MiB;
constexpr size_t WS_GATES = 64 * MiB, WS_M1 = 196 * MiB, WS_MERGED = 0, WS_HFFN = 0, WS_H = 64 * MiB;
constexpr size_t WS_X2 = 320 * MiB;
constexpr int LDG = 2080, LDM1 = 1056;
constexpr int LDS_BYTES = 147456;

typedef float f32x2_t __attribute__((ext_vector_type(2))); typedef __bf16 bf16x2_t __attribute__((ext_vector_type(2)));
DI unsigned pk2(float lo, float hi) { f32x2_t v = {lo, hi}; bf16x2_t b = __builtin_convertvector(v, bf16x2_t); return __builtin_bit_cast(unsigned, b); }
DI float bf2f(unsigned short v) { return __uint_as_float((unsigned)v << 16); }
DI float bflo(unsigned w) { return __uint_as_float(w << 16); }
DI float bfhi(unsigned w) { return __uint_as_float(w & 0xffff0000u); }
DI float wave_sum(float v) {
#pragma unroll
    for (int o = 1; o < 64; o <<= 1) v += __shfl_xor(v, o);
    return v;
}
DI float fsigmoid(float v) { return __builtin_amdgcn_rcpf(1.0f + __builtin_amdgcn_exp2f(v * -1.4426950408889634f)); }
DI u32x4 pack8(f32x4 a, f32x4 b) { u32x4 w; w.x = pk2(a[0], a[1]); w.y = pk2(a[2], a[3]); w.z = pk2(b[0], b[1]); w.w = pk2(b[2], b[3]); return w; }
DI void unpack8(u32x4 w, f32x4& a, f32x4& b) { a = (f32x4){bflo(w.x), bfhi(w.x), bflo(w.y), bfhi(w.y)}; b = (f32x4){bflo(w.z), bfhi(w.z), bflo(w.w), bfhi(w.w)}; }

struct Args {
    const float *x, *c, *w_ada, *b_ada, *g1, *w_in, *b_branch, *w_sb, *w_ret, *w_out, *g2, *w_ffi, *w_ffo, *gf;
    float* out; unsigned char* ws;
};

using pg8::Unit;
#define EPI_ARGS const f32x4 (&acc)[2][2][4][2], const Unit& u, int wr, int wc, int fr, int fq
struct EpiInProj {
    static constexpr bool PERM = true, AFTER_DRAIN = false;
    bf16 *sbq, *sbk, *sbv, *rq, *rk, *rv; const float *cosT, *sinT;
    DI void operator()(EPI_ARGS) const {
        const int pn = u.pn, row0 = u.pm * 256 + wr * 64 + fr, cw = wc * 32 + 8 * fq;
        if (pn < 12 || pn >= 20) {
            bf16* base; int ld = 1024, colt;
            if (pn < 4) { base = sbq; colt = pn * 256; } else if (pn < 8) { base = sbk; colt = (pn - 4) * 256; }
            else if (pn < 12) { base = sbv; colt = (pn - 8) * 256; } else { base = rv; ld = 2048; colt = (pn - 20) * 256; }
#pragma unroll
            for (int ai = 0; ai < 2; ++ai)
#pragma unroll
                for (int m = 0; m < 4; ++m) { bf16* rowp = base + (size_t)(row0 + ai * 128 + m * 16) * ld + colt + cw;
#pragma unroll
                    for (int bj = 0; bj < 2; ++bj) *(u32x4*)(rowp + bj * 128) = pack8(acc[ai][bj][m][0], acc[ai][bj][m][1]); }
        } else {
            const bool isk = pn >= 16; const int hh = isk ? pn - 16 : pn - 12; bf16* base = (isk ? rk : rq) + hh * 256 + cw;
            const float lg = __log2f(1.0f - exp2f(-5.0f - (float)hh));
            float fj[8];
#pragma unroll
            for (int e = 0; e < 8; ++e) fj[e] = exp2f(-(float)(cw + e) * (13.287712379549449f / 128.0f)) * 0.15915494309189535f;
#pragma unroll
            for (int ai = 0; ai < 2; ++ai)
#pragma unroll
                for (int m = 0; m < 4; ++m) {
                    const int row = row0 + ai * 128 + m * 16, pos = row & 2047, c = row & 127;
                    const float f = isk ? exp2f(-(float)c * lg) * 0.0625f : exp2f((float)c * lg);
                    bf16* rowp = base + (size_t)row * 1024;
                    f32x4 o1[2], o2[2];
#pragma unroll
                    for (int n = 0; n < 2; ++n) {
                        f32x4 cs, sn;
#pragma unroll
                        for (int e = 0; e < 4; ++e) { const float rev = __builtin_amdgcn_fractf((float)pos * fj[4 * n + e]); cs[e] = __builtin_amdgcn_cosf(rev) * f; sn[e] = __builtin_amdgcn_sinf(rev) * f; }
                        const f32x4 v1 = acc[ai][0][m][n], v2 = acc[ai][1][m][n];
                        o1[n] = v1 * cs - v2 * sn; o2[n] = v1 * sn + v2 * cs;
                    }
                    *(u32x4*)rowp = pack8(o1[0], o1[1]); *(u32x4*)(rowp + 128) = pack8(o2[0], o2[1]);
                }
        }
    }
};
struct EpiGates {
    static constexpr bool PERM = true, AFTER_DRAIN = false;
    bf16 *rv, *gates; const float *rs, *bb; bf16* m1;
    DI void operator()(EPI_ARGS) const {
        const int pn = u.pn, row0 = u.pm * 256 + wr * 64 + fr, cw = wc * 32 + 8 * fq;
        if (pn < 8) {
            const int head = pn >> 1;
#pragma unroll
            for (int ai = 0; ai < 2; ++ai) {
                f32x4 q[4]; u32x4 ov[4][2];
#pragma unroll
                for (int m = 0; m < 4; ++m) { const int row = row0 + ai * 128 + m * 16; q[m] = *(const f32x4*)(rs + (size_t)row * 16 + head * 4);
#pragma unroll
                    for (int bj = 0; bj < 2; ++bj) ov[m][bj] = *(const u32x4*)(rv + (size_t)row * 2048 + pn * 256 + bj * 128 + cw); }
#pragma unroll
                for (int m = 0; m < 4; ++m) {
                    const int row = row0 + ai * 128 + m * 16;
                    const float rsv = rsqrtf(((q[m][0] + q[m][1]) + (q[m][2] + q[m][3])) * (1.0f / 512.0f) + EPS_);
#pragma unroll
                    for (int bj = 0; bj < 2; ++bj) {
                        f32x4 oa, ob; unpack8(ov[m][bj], oa, ob);
                        f32x4 ga = acc[ai][bj][m][0], gb = acc[ai][bj][m][1];
#pragma unroll
                        for (int e = 0; e < 4; ++e) { ga[e] = ga[e] * fsigmoid(ga[e]) * oa[e] * rsv; gb[e] = gb[e] * fsigmoid(gb[e]) * ob[e] * rsv; }
                        *(u32x4*)(rv + (size_t)row * 2048 + pn * 256 + bj * 128 + cw) = pack8(ga, gb);
                    }
                }
            }
        } else if (pn < 16) {
#pragma unroll
            for (int bj = 0; bj < 2; ++bj) {
                const int col = (pn - 8) * 256 + bj * 128 + cw;
                const f32x4 b0 = *(const f32x4*)(bb + col), b1 = *(const f32x4*)(bb + col + 4);
#pragma unroll
                for (int ai = 0; ai < 2; ++ai)
#pragma unroll
                    for (int m = 0; m < 4; ++m) {
                        const int row = row0 + ai * 128 + m * 16;
                        f32x4 ga = acc[ai][bj][m][0] + b0, gb = acc[ai][bj][m][1] + b1;
#pragma unroll
                        for (int e = 0; e < 4; ++e) { ga[e] = fsigmoid(ga[e]); gb[e] = fsigmoid(gb[e]); }
                        *(u32x4*)(gates + (size_t)row * LDG + col) = pack8(ga, gb);
                    }
            }
        } else {
#pragma unroll
            for (int ai = 0; ai < 2; ++ai)
#pragma unroll
                for (int m = 0; m < 4; ++m) { bf16* rowp = m1 + (size_t)(row0 + ai * 128 + m * 16) * LDM1 + (pn - 16) * 256 + cw;
#pragma unroll
                    for (int bj = 0; bj < 2; ++bj) *(u32x4*)(rowp + bj * 128) = pack8(acc[ai][bj][m][0], acc[ai][bj][m][1]); }
        }
    }
};
struct EpiMerge2 {
    static constexpr bool PERM = true, AFTER_DRAIN = false;
    const bf16* gates; const bf16* m1; bf16* outp;
    DI void operator()(EPI_ARGS) const {
        const int row0 = u.pm * 256 + wr * 64 + fr, cw = wc * 32 + 8 * fq;
#pragma unroll
        for (int ai = 0; ai < 2; ++ai)
#pragma unroll
            for (int mp = 0; mp < 2; ++mp) {
                u32x4 gs[2][2], gr[2][2], pv[2][2];
#pragma unroll
                for (int mm = 0; mm < 2; ++mm)
#pragma unroll
                    for (int bj = 0; bj < 2; ++bj) { const int row = row0 + ai * 128 + (2 * mp + mm) * 16, col = u.pn * 256 + bj * 128 + cw;
                        gs[mm][bj] = *(const u32x4*)(gates + (size_t)row * LDG + col); gr[mm][bj] = *(const u32x4*)(gates + (size_t)row * LDG + 1024 + col);
                        pv[mm][bj] = *(const u32x4*)(m1 + (size_t)row * LDM1 + col); }
#pragma unroll
                for (int mm = 0; mm < 2; ++mm)
#pragma unroll
                    for (int bj = 0; bj < 2; ++bj) { const int m = 2 * mp + mm, row = row0 + ai * 128 + m * 16, col = u.pn * 256 + bj * 128 + cw;
                        f32x4 sa, sb, ra, rb, pa, pb; unpack8(gs[mm][bj], sa, sb); unpack8(gr[mm][bj], ra, rb); unpack8(pv[mm][bj], pa, pb);
                        *(u32x4*)(outp + (size_t)row * 1024 + col) = pack8(sa * pa + ra * acc[ai][bj][m][0], sb * pb + rb * acc[ai][bj][m][1]); }
            }
    }
};
template <bool IN_BF16> struct EpiResid {
    static constexpr bool PERM = true, AFTER_DRAIN = false;
    const void* base; bf16* outp; const float* gate;
    DI void operator()(EPI_ARGS) const {
        const int row0 = u.pm * 256 + wr * 64 + fr, cw = wc * 32 + 8 * fq, b = u.pm >> 3;
        f32x4 gt[2][2];
#pragma unroll
        for (int bj = 0; bj < 2; ++bj) { const int col = u.pn * 256 + bj * 128 + cw; gt[bj][0] = *(const f32x4*)(gate + b * NMOD + col); gt[bj][1] = *(const f32x4*)(gate + b * NMOD + col + 4); }
#pragma unroll
        for (int ai = 0; ai < 2; ++ai)
#pragma unroll
            for (int mp = 0; mp < 2; ++mp) {
                f32x4 xv[2][2][2];
#pragma unroll
                for (int mm = 0; mm < 2; ++mm)
#pragma unroll
                    for (int bj = 0; bj < 2; ++bj) { const size_t off = (size_t)(row0 + ai * 128 + (2 * mp + mm) * 16) * 1024 + u.pn * 256 + bj * 128 + cw;
                        if (IN_BF16) unpack8(*(const u32x4*)((const bf16*)base + off), xv[mm][bj][0], xv[mm][bj][1]);
                        else { xv[mm][bj][0] = *(const f32x4*)((const float*)base + off); xv[mm][bj][1] = *(const f32x4*)((const float*)base + off + 4); } }
#pragma unroll
                for (int mm = 0; mm < 2; ++mm)
#pragma unroll
                    for (int bj = 0; bj < 2; ++bj) { const int m = 2 * mp + mm; const size_t off = (size_t)(row0 + ai * 128 + m * 16) * 1024 + u.pn * 256 + bj * 128 + cw;
                        *(u32x4*)(outp + off) = pack8(xv[mm][bj][0] + gt[bj][0] * acc[ai][bj][m][0], xv[mm][bj][1] + gt[bj][1] * acc[ai][bj][m][1]); }
            }
    }
};
struct EpiSwiglu {
    static constexpr bool PERM = true, AFTER_DRAIN = false;
    bf16* H;
    DI void operator()(EPI_ARGS) const {
        const int row0 = u.pm * 256 + wr * 64 + fr, cw = wc * 32 + 8 * fq;
#pragma unroll
        for (int ai = 0; ai < 2; ++ai)
#pragma unroll
            for (int m = 0; m < 4; ++m) {
                f32x4 a0 = acc[ai][0][m][0], a1 = acc[ai][0][m][1]; const f32x4 u0 = acc[ai][1][m][0], u1 = acc[ai][1][m][1];
#pragma unroll
                for (int e = 0; e < 4; ++e) { a0[e] = a0[e] * fsigmoid(a0[e]) * u0[e]; a1[e] = a1[e] * fsigmoid(a1[e]) * u1[e]; }
                *(u32x4*)(H + (size_t)(row0 + ai * 128 + m * 16) * DFF + u.pn * 128 + cw) = pack8(a0, a1);
            }
    }
};

DI int ffi_row(int n) { return n < DFF ? 256 * (n >> 7) + (n & 127) : 256 * ((n - DFF) >> 7) + 128 + ((n - DFF) & 127); }
DI void transpose_item(const float* W, int K, int N, bf16* WT, int mode, LAS float* scr, int item, int lane) {
    const int nblk = N / 32, kb = item / nblk, nb = item % nblk, k0 = 64 * kb, n0 = 32 * nb;
    const int d0 = mode ? ffi_row(n0) : n0;
#pragma unroll 8
    for (int i = 0; i < 32; ++i) { const int kk = 2 * i + (lane >> 5); scr[kk * 33 + (lane & 31)] = W[(size_t)(k0 + kk) * N + n0 + (lane & 31)]; }
    asm volatile("s_waitcnt lgkmcnt(0)" ::: "memory");
    const int c = lane & 7;
#pragma unroll
    for (int j = 0; j < 4; ++j) { const int n = (lane >> 3) + 8 * j; const LAS float* s = scr + (8 * c) * 33 + n;
        u32x4 o; o.x = pk2(s[0 * 33], s[1 * 33]); o.y = pk2(s[2 * 33], s[3 * 33]); o.z = pk2(s[4 * 33], s[5 * 33]); o.w = pk2(s[6 * 33], s[7 * 33]);
        *(u32x4*)(WT + (size_t)(d0 + n) * K + k0 + 8 * c) = o; }
    asm volatile("s_waitcnt lgkmcnt(0)" ::: "memory");
}
template <int WHICH> DI void p0_prologue(const Args& A, ldsp lds, int G) {
    const int tid = threadIdx.x, lane = tid & 63, wave = tid >> 6;
    LAS float* scr = (LAS float*)(lds + wave * 16384);
    const int gw = blockIdx.x * NWAVES + wave, NGW = G * NWAVES;
    unsigned char* ws = A.ws;
    constexpr int I_IN = (D_ / 64) * (INW / 32), I_SB = 16 * 32, I_RET = 32 * 32, I_OUT = 16 * 32, I_FFI = 16 * (2 * DFF / 32), I_FFO = (DFF / 64) * 32;
    constexpr int I_MOD = 96 * 8, I_ROPE = 2048 * 128 / 64;
    constexpr int NIT = I_IN + I_SB + I_RET + I_OUT + I_FFI + I_FFO + I_MOD + I_ROPE;
    const int it_lo = WHICH == 0 ? (I_IN + I_SB + I_RET + I_OUT + I_FFI + I_FFO) : 0, it_hi = WHICH == 0 ? it_lo + I_MOD : (I_IN + I_SB + I_RET + I_OUT + I_FFI + I_FFO);
    for (int it = it_lo + gw; it < it_hi; it += NGW) {
        int r = it;
        if (r < I_IN) { transpose_item(A.w_in, D_, INW, (bf16*)(ws + WS_WIN), 0, scr, r, lane); continue; } r -= I_IN;
        if (r < I_SB) { transpose_item(A.w_sb, 1024, 1024, (bf16*)(ws + WS_WSB), 0, scr, r, lane); continue; } r -= I_SB;
        if (r < I_RET) { transpose_item(A.w_ret, 2048, 1024, (bf16*)(ws + WS_WRET), 0, scr, r, lane); continue; } r -= I_RET;
        if (r < I_OUT) { transpose_item(A.w_out, 1024, 1024, (bf16*)(ws + WS_WOUT), 0, scr, r, lane); continue; } r -= I_OUT;
        if (r < I_FFI) { transpose_item(A.w_ffi, 1024, 2 * DFF, (bf16*)(ws + WS_WFFI), 1, scr, r, lane); continue; } r -= I_FFI;
        if (r < I_FFO) { transpose_item(A.w_ffo, DFF, 1024, (bf16*)(ws + WS_WFFO), 0, scr, r, lane); continue; } r -= I_FFO;
        if (r < I_MOD) {
            const int eb = r % 96, ks = r / 96, d0 = ks * 128, e = eb * 64 + lane;
#pragma unroll 4
            for (int i = 0; i < 32; ++i) { const int idx = i * 64 + lane, b = idx >> 7, dd = idx & 127; const float cv = A.c[b * 1024 + d0 + dd]; scr[idx] = cv * fsigmoid(cv); }
            asm volatile("s_waitcnt lgkmcnt(0)" ::: "memory");
            float a[16];
#pragma unroll
            for (int b = 0; b < 16; ++b) a[b] = 0.f;
            for (int dd = 0; dd < 128; ++dd) { const float w = A.w_ada[(size_t)(d0 + dd) * NMOD + e];
#pragma unroll
                for (int b = 0; b < 16; ++b) a[b] += scr[b * 128 + dd] * w; }
            float* mp = (float*)(ws + WS_MODP) + (size_t)ks * NB * NMOD + e;
#pragma unroll
            for (int b = 0; b < 16; ++b) mp[b * NMOD] = a[b];
            asm volatile("s_waitcnt lgkmcnt(0)" ::: "memory");
            continue;
        } r -= I_MOD;
        {
            const int idx = r * 64 + lane, pos = idx >> 7, j = idx & 127;
            const float inv = exp2f(-(float)j * (13.287712379549449f / 128.0f));
            const float ang = (float)pos * inv;
            const float n = rintf(ang * 0.15915494309189535f);
            float rr = __builtin_fmaf(-n, 6.28125f, ang); rr = __builtin_fmaf(-n, 0.0019353071795864769f, rr);
            ((float*)(ws + WS_COS))[idx] = cosf(rr); ((float*)(ws + WS_SIN))[idx] = sinf(rr);
        }
    }
}
template <bool FIRST> DI void norm_mod_phase(const Args& A, ldsp lds, int G, const float* src, const float* gw_, bf16* dst, int shift_off) {
    const int tid = threadIdx.x, lane = tid & 63, wave = tid >> 6;
    LAS float* modl = (LAS float*)lds;
    const float* modp = (const float*)(A.ws + WS_MODP); float* modf = (float*)(A.ws + WS_MODF);
    for (int rb = blockIdx.x; rb < 256; rb += G) {
        const int b = rb >> 4;
        __syncthreads();
        for (int i = tid; i < 2048; i += NTHR) {
            float v;
            if (FIRST) { const int e = i; v = A.b_ada[e]; for (int ks = 0; ks < 8; ++ks) v += modp[(size_t)ks * NB * NMOD + b * NMOD + e]; }
            else v = modf[b * NMOD + shift_off + i];
            modl[i] = v;
        }
        if (FIRST && tid < 384) { const int idx = rb * 384 + tid, e = idx % NMOD; float v = A.b_ada[e]; for (int ks = 0; ks < 8; ++ks) v += modp[(size_t)ks * NB * NMOD + idx]; modf[idx] = v; }
        __syncthreads();
        for (int rr = 0; rr < 16; ++rr) {
            const int row = rb * 128 + wave * 16 + rr;
            f32x4 v[4]; float s = 0.f;
            if (!FIRST) { const u32x2* xb = (const u32x2*)((const bf16*)(const void*)src + (size_t)row * 1024) + lane;
#pragma unroll
                for (int j = 0; j < 4; ++j) { const u32x2 w2 = xb[64 * j]; v[j] = (f32x4){bflo(w2.x), bfhi(w2.x), bflo(w2.y), bfhi(w2.y)}; } }
            else { const f32x4* xr = (const f32x4*)(src + (size_t)row * 1024) + lane;
#pragma unroll
                for (int j = 0; j < 4; ++j) v[j] = xr[64 * j]; }
#pragma unroll
            for (int j = 0; j < 4; ++j) { s += (v[j][0] * v[j][0] + v[j][1] * v[j][1]) + (v[j][2] * v[j][2] + v[j][3] * v[j][3]); }
            const float rstd = rsqrtf(wave_sum(s) * (1.0f / 1024.0f) + EPS_);
            unsigned long long* o8 = (unsigned long long*)(dst + (size_t)row * 1024) + lane;
#pragma unroll
            for (int j = 0; j < 4; ++j) {
                const int col = 4 * lane + 256 * j;
                const f32x4 g = *(const f32x4*)(gw_ + col); const f32x4 sh = *(const LAS f32x4*)(modl + col), sc = *(const LAS f32x4*)(modl + 1024 + col);
                const f32x4 y = v[j] * rstd * g * (sc + 1.0f) + sh;
                o8[64 * j] = (unsigned long long)pk2(y[0], y[1]) | ((unsigned long long)pk2(y[2], y[3]) << 32);
            }
        }
    }
    __syncthreads();
}
DI void final_norm_phase(const Args& A, int G, const bf16* x3) {
    const int tid = threadIdx.x, lane = tid & 63, wave = tid >> 6;
    const int gw = blockIdx.x * NWAVES + wave, NGW = G * NWAVES;
    for (int row = gw; row < T_; row += NGW) {
        const u32x2* xb = (const u32x2*)(x3 + (size_t)row * 1024) + lane;
        f32x4* orow = (f32x4*)(A.out + (size_t)row * 1024) + lane;
        f32x4 v[4]; float s = 0.f;
#pragma unroll
        for (int j = 0; j < 4; ++j) { const u32x2 w2 = xb[64 * j]; v[j] = (f32x4){bflo(w2.x), bfhi(w2.x), bflo(w2.y), bfhi(w2.y)}; s += (v[j][0] * v[j][0] + v[j][1] * v[j][1]) + (v[j][2] * v[j][2] + v[j][3] * v[j][3]); }
        const float rstd = rsqrtf(wave_sum(s) * (1.0f / 1024.0f) + EPS_);
#pragma unroll
        for (int j = 0; j < 4; ++j) { const f32x4 g = *(const f32x4*)(A.gf + 4 * lane + 256 * j); orow[64 * j] = v[j] * rstd * g; }
    }
}

typedef short v4i16_t __attribute__((ext_vector_type(4)));
DI s16x4 tr_read(const LAS unsigned char* p) { return __builtin_bit_cast(s16x4, __builtin_amdgcn_ds_read_tr16_b64_v4i16((LAS v4i16_t*)p)); }
#define MFMA32(a, b, c) __builtin_amdgcn_mfma_f32_32x32x16_bf16((a), (b), (c), 0, 0, 0)
#define MFMA16(a, b, c) __builtin_amdgcn_mfma_f32_16x16x32_bf16((a), (b), (c), 0, 0, 0)
DI int crow(int r, int hi) { return (r & 3) + 8 * (r >> 2) + 4 * hi; }
DI bf16x8 pack_step(const f32x16& x, int s) {
    u32x4 p; p.x = pk2(x[8 * s], x[8 * s + 1]); p.y = pk2(x[8 * s + 2], x[8 * s + 3]); p.z = pk2(x[8 * s + 4], x[8 * s + 5]); p.w = pk2(x[8 * s + 6], x[8 * s + 7]);
    return __builtin_bit_cast(bf16x8, p);
}
constexpr int SB_PK = 144, SB_PV = 192;
constexpr int SB_KBYTES = 64 * SB_PK, SB_VBYTES = 64 * SB_PV, SB_BUF = SB_KBYTES + SB_VBYTES;
DI void sb_attn_unit(ldsp lds, const bf16* Q, const bf16* K, const bf16* V, bf16* O, int b, int h, int qb, int dry = 0) {
    const int tid = threadIdx.x, lane = tid & 63, wave = __builtin_amdgcn_readfirstlane(tid >> 6), r32 = lane & 31, hi = lane >> 5;
    const int t0 = qb * 256 + wave * 32, tq = t0 + r32;
    const size_t rowbase = (size_t)b * S_;
    bf16x8 qf[4];
#pragma unroll
    for (int ks = 0; ks < 4; ++ks) qf[ks] = *(const bf16x8*)(Q + (rowbase + tq) * 1024 + h * 64 + 16 * ks + 8 * hi);
    bf16x8 U0, U1, ONES;
#pragma unroll
    for (int jj = 0; jj < 8; ++jj) { const int k0 = 8 * (jj >> 2) + 4 * hi + (jj & 3); U0[jj] = (k0 >= r32) ? (short)0x3F80 : (short)0; U1[jj] = (16 + k0 >= r32) ? (short)0x3F80 : (short)0; ONES[jj] = (short)0x3F80; }
    f32x16 o0, o1;
#pragma unroll
    for (int i = 0; i < 16; ++i) { o0[i] = 0.f; o1[i] = 0.f; }
    float R2 = 0.f;
    const int ntiles = qb * 4 + 4;
    const int srow = tid >> 3, schunk = tid & 7;
    const bf16* kg = K + (rowbase + srow) * 1024 + h * 64 + schunk * 8; const bf16* vg = V + (rowbase + srow) * 1024 + h * 64 + schunk * 8;
    const int kso = srow * SB_PK + schunk * 16, vso = SB_KBYTES + srow * SB_PV + schunk * 16;
    LAS unsigned* doneF = (LAS unsigned*)(lds + 2 * SB_BUF);
    bool wdone = false;
    __syncthreads();
    { const int jt = ntiles - 1; const u32x4 kr = *(const u32x4*)(kg + (size_t)jt * 64 * 1024), vr = *(const u32x4*)(vg + (size_t)jt * 64 * 1024);
      *(LAS u32x4*)(lds + kso) = kr; *(LAS u32x4*)(lds + vso) = vr; }
    __syncthreads();
    const float C2 = 0.125f * 1.4426950408889634f;
    const int i16 = lane & 15, blk = (lane >> 4) & 1, qq = i16 >> 2, pp = i16 & 3;
    for (int jt = ntiles - 1; jt >= 0; --jt) {
        const int cur = (ntiles - 1 - jt) & 1;
        u32x4 kr, vr;
        if (jt > 0) { kr = *(const u32x4*)(kg + (size_t)(jt - 1) * 64 * 1024); vr = *(const u32x4*)(vg + (size_t)(jt - 1) * 64 * 1024); }
        if (!wdone && 64 * jt < t0 + 31) {
            const LAS unsigned char* Kb = lds + cur * SB_BUF; const LAS unsigned char* Vb = Kb + SB_KBYTES;
            const bool diag = (64 * jt + 63 >= t0);
            f32x16 z[2];
#pragma unroll
            for (int rb = 0; rb < 2; ++rb) {
#pragma unroll
                for (int i = 0; i < 16; ++i) z[rb][i] = 0.f;
#pragma unroll
                for (int ks = 0; ks < 4; ++ks) { const bf16x8 a = *(const LAS bf16x8*)(Kb + (32 * rb + r32) * SB_PK + (16 * ks + 8 * hi) * 2); z[rb] = MFMA32(a, qf[ks], z[rb]); }
            }
            float lsum = 0.f; f32x16 L[2];
#pragma unroll
            for (int rb = 0; rb < 2; ++rb)
#pragma unroll
                for (int i = 0; i < 16; ++i) {
                    const float z2 = z[rb][i] * C2;
                    const float e = __builtin_amdgcn_exp2f(-__builtin_fabsf(z2));
                    float l = -(__builtin_fmaxf(z2, 0.f) + __builtin_amdgcn_logf(1.0f + e));
                    if (diag) { const int s = 64 * jt + 32 * rb + crow(i, hi); if (!(s < tq)) l = 0.f; }
                    L[rb][i] = l; lsum += l; z[rb][i] = z2 + R2;
                }
            bf16x8 Lp[4];
#pragma unroll
            for (int q = 0; q < 4; ++q) Lp[q] = pack_step(L[q >> 1], q & 1);
            f32x16 la0 = MFMA32(U0, Lp[0], z[0]); la0 = MFMA32(U1, Lp[1], la0); la0 = MFMA32(ONES, Lp[2], la0); la0 = MFMA32(ONES, Lp[3], la0);
            f32x16 la1 = MFMA32(U0, Lp[2], z[1]); la1 = MFMA32(U1, Lp[3], la1);
#pragma unroll
            for (int i = 0; i < 16; ++i) {
                float a0 = __builtin_amdgcn_exp2f(la0[i]), a1 = __builtin_amdgcn_exp2f(la1[i]);
                if (diag) { const int s = 64 * jt + crow(i, hi); if (!(s < tq)) a0 = 0.f; if (!(s + 32 < tq)) a1 = 0.f; }
                la0[i] = a0; la1[i] = a1;
            }
            bf16x8 Ap[4]; Ap[0] = pack_step(la0, 0); Ap[1] = pack_step(la0, 1); Ap[2] = pack_step(la1, 0); Ap[3] = pack_step(la1, 1);
#pragma unroll
            for (int q = 0; q < 4; ++q) {
                const int key0 = 16 * q + 4 * hi;
#pragma unroll
                for (int db = 0; db < 2; ++db) {
                    const LAS unsigned char* ap = Vb + (key0 + qq) * SB_PV + (32 * db + 16 * blk + 4 * pp) * 2;
                    const s16x4 lo = tr_read(ap), hi4 = tr_read(ap + 8 * SB_PV);
                    const bf16x8 va = __builtin_shufflevector(lo, hi4, 0, 1, 2, 3, 4, 5, 6, 7);
                    if (db == 0) o0 = MFMA32(va, Ap[q], o0); else o1 = MFMA32(va, Ap[q], o1);
                }
            }
            R2 += lsum + __shfl_xor(lsum, 32);
            wdone = __all(R2 < -160.0f);
        }
        if (lane == 0) doneF[(jt & 1) * 8 + wave] = wdone ? 1u : 0u;
        if (jt > 0) { *(LAS u32x4*)(lds + (cur ^ 1) * SB_BUF + kso) = kr; *(LAS u32x4*)(lds + (cur ^ 1) * SB_BUF + vso) = vr; }
        __syncthreads();
        { const LAS u32x4* df = (const LAS u32x4*)(doneF + (jt & 1) * 8); const u32x4 f0 = df[0], f1 = df[1];
          if ((f0.x & f0.y & f0.z & f0.w & f1.x & f1.y & f1.z & f1.w) != 0u) break; }
    }
    bf16* op = O + (rowbase + tq) * 1024 + h * 64 + 4 * hi;
#pragma unroll
    for (int g = 0; g < 4; ++g) {
        u32x2 w0, w1; w0.x = pk2(o0[4 * g], o0[4 * g + 1]); w0.y = pk2(o0[4 * g + 2], o0[4 * g + 3]); w1.x = pk2(o1[4 * g], o1[4 * g + 1]); w1.y = pk2(o1[4 * g + 2], o1[4 * g + 3]);
        if (!dry) { *(u32x2*)(op + 8 * g) = w0; *(u32x2*)(op + 32 + 8 * g) = w1; }
    }
}


DI void sb_attn_wave(ldsp vl  , const bf16* Q, const bf16* K, const bf16* V, bf16* O, int b, int h, int rg) {
    const int lane = threadIdx.x & 63, r32 = lane & 31, hi = lane >> 5;
    const int t0 = rg * 32, tq = t0 + r32;
    const size_t rowbase = (size_t)b * S_;
    bf16x8 qf[4];
#pragma unroll
    for (int ks = 0; ks < 4; ++ks) qf[ks] = *(const bf16x8*)(Q + (rowbase + tq) * 1024 + h * 64 + 16 * ks + 8 * hi);
    bf16x8 U0, U1, ONES;
#pragma unroll
    for (int jj = 0; jj < 8; ++jj) { const int k0 = 8 * (jj >> 2) + 4 * hi + (jj & 3); U0[jj] = (k0 >= r32) ? (short)0x3F80 : (short)0; U1[jj] = (16 + k0 >= r32) ? (short)0x3F80 : (short)0; ONES[jj] = (short)0x3F80; }
    f32x16 o0, o1;
#pragma unroll
    for (int i = 0; i < 16; ++i) { o0[i] = 0.f; o1[i] = 0.f; }
    float R2 = 0.f;
    const int jtop = (t0 + 30) >> 6;
    const bf16* kg = K + (rowbase + r32) * 1024 + h * 64 + 8 * hi;
    const bf16* vg = V + (rowbase + (lane >> 3)) * 1024 + h * 64 + (((lane & 7) ^ ((((lane >> 3) >> 1) & 1) << 2)) * 8);
    const int i16 = lane & 15, blk = (lane >> 4) & 1, qq = i16 >> 2, pp = i16 & 3;
    const int vro = (4 * hi + qq) * 128 + (((2 * blk + (pp >> 1)) ^ (((qq >> 1) & 1) << 2)) * 16) + 8 * (pp & 1);
    bf16x8 kf[8];
#pragma unroll
    for (int i = 0; i < 8; ++i) __builtin_amdgcn_global_load_lds((const unsigned*)(vg + (size_t)(64 * jtop + 8 * i) * 1024), (LAS unsigned*)(vl + i * 1024), 16, 0, 0);
#pragma unroll
    for (int i = 0; i < 8; ++i) kf[i] = *(const bf16x8*)(kg + (size_t)(64 * jtop + 32 * (i >> 2)) * 1024 + 16 * (i & 3));
    const float C2 = 0.125f * 1.4426950408889634f;
    for (int jt = jtop; jt >= 0; --jt) {
        const int cur = (jtop - jt) & 1;
        asm volatile("s_waitcnt vmcnt(0)" ::: "memory");
        f32x16 z[2];
#pragma unroll
        for (int rb = 0; rb < 2; ++rb) {
#pragma unroll
            for (int i = 0; i < 16; ++i) z[rb][i] = 0.f;
#pragma unroll
            for (int ks = 0; ks < 4; ++ks) z[rb] = MFMA32(kf[rb * 4 + ks], qf[ks], z[rb]);
        }
        if (jt > 0) {
#pragma unroll
            for (int i = 0; i < 8; ++i) __builtin_amdgcn_global_load_lds((const unsigned*)(vg + (size_t)(64 * (jt - 1) + 8 * i) * 1024), (LAS unsigned*)(vl + (cur ^ 1) * 8192 + i * 1024), 16, 0, 0);
#pragma unroll
            for (int i = 0; i < 8; ++i) kf[i] = *(const bf16x8*)(kg + (size_t)(64 * (jt - 1) + 32 * (i >> 2)) * 1024 + 16 * (i & 3));
        }
        const bool diag = (jt == jtop);
        f32x16 L[2];
#pragma unroll
        for (int rb = 0; rb < 2; ++rb)
#pragma unroll
            for (int i = 0; i < 16; ++i) {
                const float z2 = z[rb][i] * C2;
                const float e = __builtin_amdgcn_exp2f(-__builtin_fabsf(z2));
                L[rb][i] = -(__builtin_fmaxf(z2, 0.f) + __builtin_amdgcn_logf(1.0f + e));
                z[rb][i] = z2 + R2;
            }
        if (diag) {
#pragma unroll
            for (int rb = 0; rb < 2; ++rb)
#pragma unroll
                for (int i = 0; i < 16; ++i) { const int s = 64 * jt + 32 * rb + crow(i, hi); if (!(s < tq)) L[rb][i] = 0.f; }
        }
        const float cin0 = z[0][0];
        bf16x8 Lp[4];
#pragma unroll
        for (int q = 0; q < 4; ++q) Lp[q] = pack_step(L[q >> 1], q & 1);
        f32x16 la0 = MFMA32(U0, Lp[0], z[0]); la0 = MFMA32(U1, Lp[1], la0); la0 = MFMA32(ONES, Lp[2], la0); la0 = MFMA32(ONES, Lp[3], la0);
        f32x16 la1 = MFMA32(U0, Lp[2], z[1]); la1 = MFMA32(U1, Lp[3], la1);
        const float tot0 = la0[0] - cin0;
#pragma unroll
        for (int i = 0; i < 16; ++i) { la0[i] = __builtin_amdgcn_exp2f(la0[i]); la1[i] = __builtin_amdgcn_exp2f(la1[i]); }
        if (diag) {
#pragma unroll
            for (int i = 0; i < 16; ++i) { const int s = 64 * jt + crow(i, hi); if (!(s < tq)) la0[i] = 0.f; if (!(s + 32 < tq)) la1[i] = 0.f; }
        }
        bf16x8 Ap[4]; Ap[0] = pack_step(la0, 0); Ap[1] = pack_step(la0, 1); Ap[2] = pack_step(la1, 0); Ap[3] = pack_step(la1, 1);
        const LAS unsigned char* vb = vl + cur * 8192 + vro;
#pragma unroll
        for (int q = 0; q < 4; ++q) {
#pragma unroll
            for (int db = 0; db < 2; ++db) {
                const LAS unsigned char* ap = (const LAS unsigned char*)((unsigned)(size_t)(vb + 2048 * q) ^ (unsigned)(64 * db));
                const s16x4 lo = tr_read(ap), hi4 = tr_read(ap + 1024);
                const bf16x8 va = __builtin_shufflevector(lo, hi4, 0, 1, 2, 3, 4, 5, 6, 7);
                if (db == 0) o0 = MFMA32(va, Ap[q], o0); else o1 = MFMA32(va, Ap[q], o1);
            }
        }
        R2 += __shfl(tot0, r32);
        if (__all(R2 < -152.0f)) break;
    }
    asm volatile("s_waitcnt vmcnt(0)" ::: "memory");
    bf16* op = O + (rowbase + tq) * 1024 + h * 64 + 4 * hi;
#pragma unroll
    for (int g = 0; g < 4; ++g) {
        u32x2 w0, w1; w0.x = pk2(o0[4 * g], o0[4 * g + 1]); w0.y = pk2(o0[4 * g + 2], o0[4 * g + 3]); w1.x = pk2(o1[4 * g], o1[4 * g + 1]); w1.y = pk2(o1[4 * g + 2], o1[4 * g + 3]);
        *(u32x2*)(op + 8 * g) = w0; *(u32x2*)(op + 32 + 8 * g) = w1;
    }
}

constexpr int RT_P = 272;
constexpr int RT_TILE = 128 * RT_P, RT_Q = 0, RT_K = RT_TILE, RT_V = 2 * RT_TILE, RT_PS = 3 * RT_TILE, RT_SS = 4 * RT_TILE;
#define RT_STAGE(dh_, withv_) do { \
    const int row_ = tid >> 4, chunk_ = tid & 15; \
    const bf16* qg_ = RQ + (rowbase + c0 + row_) * 1024 + hh * 256 + (dh_) * 128 + chunk_ * 8; \
    const bf16* kg_ = RK + (rowbase + c0 + row_) * 1024 + hh * 256 + (dh_) * 128 + chunk_ * 8; \
    const ldsp lq_ = lds + row_ * RT_P + chunk_ * 16; \
    _Pragma("unroll") for (int i_ = 0; i_ < 4; ++i_) *(LAS u32x4*)(lq_ + RT_Q + i_ * 32 * RT_P) = *(const u32x4*)(qg_ + (size_t)i_ * 32 * 1024); \
    __builtin_amdgcn_sched_barrier(0); \
    _Pragma("unroll") for (int i_ = 0; i_ < 4; ++i_) *(LAS u32x4*)(lq_ + RT_K + i_ * 32 * RT_P) = *(const u32x4*)(kg_ + (size_t)i_ * 32 * 1024); \
    __builtin_amdgcn_sched_barrier(0); \
    if (withv_) { const bf16* vg_ = RV + (rowbase + c0 + row_) * 2048 + hh * 512 + es * 128 + chunk_ * 8; \
        _Pragma("unroll") for (int i_ = 0; i_ < 4; ++i_) *(LAS u32x4*)(lq_ + RT_V + i_ * 32 * RT_P) = *(const u32x4*)(vg_ + (size_t)i_ * 32 * 2048); } \
    __builtin_amdgcn_sched_barrier(0); } while (0)
DI void retention_unit(ldsp lds, const bf16* RQ, const bf16* RK, bf16* RV, float* RS, int b, int hh, int es, int dry = 0) {
    const int tid = threadIdx.x, lane = tid & 63, w = __builtin_amdgcn_readfirstlane(tid >> 6), i16 = lane & 15, g = lane >> 4, qq = i16 >> 2, pp = i16 & 3;
    const size_t rowbase = (size_t)b * S_;
    const float g128 = exp2f(128.0f * __log2f(1.0f - exp2f(-5.0f - (float)hh)));
    f32x4 Tst[16];
#pragma unroll
    for (int i = 0; i < 16; ++i) Tst[i] = (f32x4){0.f, 0.f, 0.f, 0.f};
    for (int ch = 0; ch < 16; ++ch) {
        const int c0 = ch * 128;
        {
            f32x4 sc[8];
#pragma unroll
            for (int i = 0; i < 8; ++i) sc[i] = (f32x4){0.f, 0.f, 0.f, 0.f};
#pragma unroll
            for (int dh = 0; dh < 2; ++dh) {
                __syncthreads();
                RT_STAGE(dh, false);
                __syncthreads();
#pragma unroll
                for (int kb = 0; kb < 4; ++kb) {
                    const bf16x8 bq = *(const LAS bf16x8*)(lds + RT_Q + (16 * w + i16) * RT_P + (32 * kb + 8 * g) * 2);
#pragma unroll
                    for (int mb = 0; mb < 8; ++mb) { const bf16x8 ak = *(const LAS bf16x8*)(lds + RT_K + (16 * mb + i16) * RT_P + (32 * kb + 8 * g) * 2); sc[mb] = MFMA16(ak, bq, sc[mb]); }
                    __builtin_amdgcn_sched_barrier(0);
                }
            }
            const int c = 16 * w + i16;
#pragma unroll
            for (int mb = 0; mb < 8; ++mb) {
                const int m0 = 16 * mb + 4 * g;
                const float v0 = (m0 <= c) ? sc[mb][0] : 0.f, v1 = (m0 + 1 <= c) ? sc[mb][1] : 0.f, v2 = (m0 + 2 <= c) ? sc[mb][2] : 0.f, v3 = (m0 + 3 <= c) ? sc[mb][3] : 0.f;
                u32x2 pw; pw.x = pk2(v0, v1); pw.y = pk2(v2, v3);
                *(LAS u32x2*)(lds + RT_PS + c * RT_P + m0 * 2) = pw;
            }
        }
        __builtin_amdgcn_sched_barrier(0);
        f32x4 cr[8]; bf16x8 vf[4];
#pragma unroll
        for (int i = 0; i < 8; ++i) cr[i] = (f32x4){0.f, 0.f, 0.f, 0.f};
#pragma unroll
        for (int dh = 0; dh < 2; ++dh) {
            __syncthreads();
            RT_STAGE(dh, dh == 0);
            __syncthreads();
            if (dh == 0) {
#pragma unroll
                for (int cbk = 0; cbk < 4; ++cbk) {
                    const LAS unsigned char* ap = lds + RT_V + (32 * cbk + 8 * g + qq) * RT_P + (16 * w + 4 * pp) * 2;
                    const s16x4 lo = tr_read(ap), hi4 = tr_read(ap + 4 * RT_P);
                    vf[cbk] = __builtin_shufflevector(lo, hi4, 0, 1, 2, 3, 4, 5, 6, 7);
                }
            }
#pragma unroll
            for (int kb = 0; kb < 4; ++kb) {
                const int kbg = 4 * dh + kb;
                u32x4 tp; tp.x = pk2(Tst[2 * kbg][0], Tst[2 * kbg][1]); tp.y = pk2(Tst[2 * kbg][2], Tst[2 * kbg][3]); tp.z = pk2(Tst[2 * kbg + 1][0], Tst[2 * kbg + 1][1]); tp.w = pk2(Tst[2 * kbg + 1][2], Tst[2 * kbg + 1][3]);
                const bf16x8 tb = __builtin_bit_cast(bf16x8, tp);
#pragma unroll
                for (int cb = 0; cb < 8; ++cb) {
                    const LAS unsigned char* qp = lds + RT_Q + (16 * cb + i16) * RT_P + (32 * kb + 4 * g) * 2;
                    const s16x4 lo = *(const LAS s16x4*)qp, hi4 = *(const LAS s16x4*)(qp + 32);
                    const bf16x8 aq = __builtin_shufflevector(lo, hi4, 0, 1, 2, 3, 4, 5, 6, 7);
                    cr[cb] = MFMA16(aq, tb, cr[cb]);
                }
                __builtin_amdgcn_sched_barrier(0);
            }
#pragma unroll
            for (int dtl = 0; dtl < 8; ++dtl) {
                const int dt = 8 * dh + dtl;
                Tst[dt] = Tst[dt] * g128;
#pragma unroll
                for (int cbk = 0; cbk < 4; ++cbk) {
                    const LAS unsigned char* ap = lds + RT_K + (32 * cbk + 8 * g + qq) * RT_P + (16 * dtl + 4 * pp) * 2;
                    const s16x4 lo = tr_read(ap), hi4 = tr_read(ap + 4 * RT_P);
                    const bf16x8 ak = __builtin_shufflevector(lo, hi4, 0, 1, 2, 3, 4, 5, 6, 7);
                    Tst[dt] = MFMA16(ak, vf[cbk], Tst[dt]);
                }
                __builtin_amdgcn_sched_barrier(0);
            }
        }
#pragma unroll
        for (int cb = 0; cb < 8; ++cb) cr[cb] = cr[cb] * g128;
#pragma unroll
        for (int cb = 0; cb < 8; ++cb)
#pragma unroll
            for (int mbk = 0; mbk < 4; ++mbk) if (32 * mbk <= 16 * cb + 15) {
                const bf16x8 ap = *(const LAS bf16x8*)(lds + RT_PS + (16 * cb + i16) * RT_P + (32 * mbk + 8 * g) * 2);
                cr[cb] = MFMA16(ap, vf[mbk], cr[cb]);
            }
        LAS float* ssq = (LAS float*)(lds + RT_SS);
#pragma unroll
        for (int cb = 0; cb < 8; ++cb)
#pragma unroll
            for (int j = 0; j < 4; ++j) {
                const int c = 16 * cb + 4 * g + j;
                const unsigned short ob = (unsigned short)(pk2(cr[cb][j], 0.f) & 0xffffu);
                if (!dry) RV[(rowbase + c0 + c) * 2048 + hh * 512 + es * 128 + 16 * w + i16] = ob;
                const float of = bf2f(ob); float s = of * of;
                s += __shfl_xor(s, 1); s += __shfl_xor(s, 2); s += __shfl_xor(s, 4); s += __shfl_xor(s, 8);
                if (i16 == 0) ssq[w * 128 + c] = s;
            }
        __syncthreads();
        if (tid < 128) { float s = 0.f;
#pragma unroll
            for (int ww = 0; ww < 8; ++ww) s += ssq[ww * 128 + tid];
            if (!dry) RS[(rowbase + c0 + tid) * 16 + hh * 4 + es] = s; }
    }
    __syncthreads();
}


constexpr int SC_P = 528;
DI void ret_scores_item(ldsp lds, const bf16* RQ, const bf16* RK, bf16* PG, int item) {
    const int tid = threadIdx.x, lane = tid & 63, w = __builtin_amdgcn_readfirstlane(tid >> 6), i16 = lane & 15, g = lane >> 4;
    const int ch = item & 15, hh = (item >> 4) & 3, b = item >> 6;
    const size_t grow0 = (size_t)b * S_ + ch * 128;
    __syncthreads();
#pragma unroll
    for (int t = 0; t < 2; ++t) {
        const bf16* src = (t ? RK : RQ) + grow0 * 1024 + hh * 256;
#pragma unroll
        for (int i = 0; i < 8; ++i) { const int idx = tid + 512 * i, row = idx >> 5, chunk = idx & 31;
            *(LAS u32x4*)(lds + t * (128 * SC_P) + row * SC_P + chunk * 16) = *(const u32x4*)(src + (size_t)row * 1024 + chunk * 8); }
        __builtin_amdgcn_sched_barrier(0);
    }
    __syncthreads();
    f32x4 sc[8];
#pragma unroll
    for (int i = 0; i < 8; ++i) sc[i] = (f32x4){0.f, 0.f, 0.f, 0.f};
#pragma unroll
    for (int kb = 0; kb < 8; ++kb) {
        const bf16x8 bq = *(const LAS bf16x8*)(lds + (16 * w + i16) * SC_P + (32 * kb + 8 * g) * 2);
#pragma unroll
        for (int mb = 0; mb < 8; ++mb) { const bf16x8 ak = *(const LAS bf16x8*)(lds + 128 * SC_P + (16 * mb + i16) * SC_P + (32 * kb + 8 * g) * 2); sc[mb] = MFMA16(ak, bq, sc[mb]); }
        __builtin_amdgcn_sched_barrier(0);
    }
    const int c = 16 * w + i16;
    bf16* prow = PG + (size_t)item * 16384 + c * 128;
#pragma unroll
    for (int mb = 0; mb < 8; ++mb) {
        const int m0 = 16 * mb + 4 * g;
        const float v0 = (m0 <= c) ? sc[mb][0] : 0.f, v1 = (m0 + 1 <= c) ? sc[mb][1] : 0.f, v2 = (m0 + 2 <= c) ? sc[mb][2] : 0.f, v3 = (m0 + 3 <= c) ? sc[mb][3] : 0.f;
        u32x2 pw; pw.x = pk2(v0, v1); pw.y = pk2(v2, v3);
        *(u32x2*)(prow + m0) = pw;
    }
}

constexpr int R2_RING = 0, R2_V = 65536, R2_P = 98304, R2_SS = 131072;
#define DMA16(gp, lp) __builtin_amdgcn_global_load_lds((const unsigned*)(gp), (LAS unsigned*)(lp), 16, 0, 0)
DI void retention_unit2(ldsp lds, const bf16* RQ, const bf16* RK, bf16* RV, const bf16* PG, float* RS, int b, int hh, int es) {
    const int tid = threadIdx.x, lane = tid & 63, w = __builtin_amdgcn_readfirstlane(tid >> 6), i16 = lane & 15, g = lane >> 4, qq = i16 >> 2, pp = i16 & 3;
    const size_t rowbase = (size_t)b * S_;
    const float g128 = exp2f(128.0f * __log2f(1.0f - exp2f(-5.0f - (float)hh)));
    const int r8 = lane >> 3;
    const int fq0 = (((r8 >> 1) & 1) << 1) | ((r8 >> 2) & 1);
    const unsigned char* qsrc = (const unsigned char*)(RQ + (rowbase + 16 * w) * 1024 + hh * 256);
    const unsigned char* ksrc = (const unsigned char*)(RK + (rowbase + 16 * w) * 1024 + hh * 256);
    const unsigned qc0 = (unsigned)(r8 * 1024 + ((lane & 7) ^ fq0) * 8) * 2u, qc1 = (unsigned)((r8 + 8) * 1024 + ((lane & 7) ^ (fq0 | 4)) * 8) * 2u;
    const int r4 = lane >> 4;
    const unsigned char* vsrc = (const unsigned char*)(RV + (rowbase + 16 * w) * 2048 + hh * 512 + es * 128);
    const unsigned char* psrc = (const unsigned char*)(PG + ((size_t)((b * 4 + hh) * 16) * 128 + 16 * w) * 128);
    unsigned voff[4], poff[4];
#pragma unroll
    for (int j = 0; j < 4; ++j) { const int row = 16 * w + 4 * j + r4; const int hs = 2 * ((row & 3) | (((row >> 3) & 1) << 2));
        voff[j] = (unsigned)((4 * j + r4) * 2048 + (((lane & 15) ^ hs) * 8)) * 2u; poff[j] = (unsigned)((4 * j + r4) * 128 + (((lane & 15) ^ (row & 15)) * 8)) * 2u; }
    const int fA0 = (((i16 >> 1) & 1) << 1) | ((i16 >> 2) & 1) | (((i16 >> 3) & 1) << 2);
    const int fT0 = (((qq >> 1) & 1) << 1) | ((g & 1) << 2);
    const int hV0 = 2 * (qq | ((g & 1) << 2));
    f32x4 Tst[16];
#pragma unroll
    for (int i = 0; i < 16; ++i) Tst[i] = (f32x4){0.f, 0.f, 0.f, 0.f};
    __syncthreads();
    {
        DMA16(qsrc + qc0, lds + R2_RING + (2 * w) * 1024); DMA16(qsrc + qc1, lds + R2_RING + (2 * w + 1) * 1024);
        DMA16(ksrc + qc0, lds + R2_RING + 16384 + (2 * w) * 1024); DMA16(ksrc + qc1, lds + R2_RING + 16384 + (2 * w + 1) * 1024);
#pragma unroll
        for (int j = 0; j < 4; ++j) DMA16(vsrc + voff[j], lds + R2_V + (4 * w + j) * 1024);
    }
    asm volatile("s_waitcnt vmcnt(0)" ::: "memory");
    __syncthreads();
    for (int ch = 0; ch < 16; ++ch) {
        const int c0 = ch * 128;
        f32x4 cr[8]; bf16x8 vf[4];
#pragma unroll
        for (int i = 0; i < 8; ++i) cr[i] = (f32x4){0.f, 0.f, 0.f, 0.f};
#pragma unroll
        for (int qd = 0; qd < 4; ++qd) {
            const int cur = qd & 1;
            int fA = fA0, fT = fT0, hV = hV0, lane_ = lane;
            asm volatile("" : "+v"(fA), "+v"(fT), "+v"(hV), "+v"(lane_));
            const int i16 = lane_ & 15, g = lane_ >> 4, qq = i16 >> 2, pp = i16 & 3;
            {
                const int nch = (qd == 3) ? ch + 1 : ch, nqd = (qd + 1) & 3;
                if (nch < 16) {
                    const size_t go = ((size_t)(nch * 128) * 1024 + nqd * 64) * 2;
                    const ldsp rb = lds + R2_RING + (cur ^ 1) * 32768;
                    DMA16(qsrc + go + qc0, rb + (2 * w) * 1024); DMA16(qsrc + go + qc1, rb + (2 * w + 1) * 1024);
                    DMA16(ksrc + go + qc0, rb + 16384 + (2 * w) * 1024); DMA16(ksrc + go + qc1, rb + 16384 + (2 * w + 1) * 1024);
                }
                if (qd == 0) {
#pragma unroll
                    for (int j = 0; j < 4; ++j) DMA16(psrc + (size_t)ch * 32768 + poff[j], lds + R2_P + (4 * w + j) * 1024);
                }
                if (qd == 1 && ch + 1 < 16) {
#pragma unroll
                    for (int j = 0; j < 4; ++j) DMA16(vsrc + (size_t)((ch + 1) * 128) * 4096 + voff[j], lds + R2_V + (4 * w + j) * 1024);
                }
            }
            const LAS unsigned char* Qb = lds + R2_RING + cur * 32768; const LAS unsigned char* Kb = Qb + 16384;
            if (qd == 0) {
#pragma unroll
                for (int cbk = 0; cbk < 4; ++cbk) {
                    const LAS unsigned char* ap = lds + R2_V + (32 * cbk + 8 * g + qq) * 256 + (((2 * w + (pp >> 1)) ^ hV) * 16) + 8 * (pp & 1);
                    const s16x4 lo = tr_read(ap), hi4 = tr_read(ap + 4 * 256);
                    vf[cbk] = __builtin_shufflevector(lo, hi4, 0, 1, 2, 3, 4, 5, 6, 7);
                }
            }
#pragma unroll
            for (int kb = 0; kb < 2; ++kb) {
                const int kbg = 2 * qd + kb;
                u32x4 tp; tp.x = pk2(Tst[2 * kbg][0], Tst[2 * kbg][1]); tp.y = pk2(Tst[2 * kbg][2], Tst[2 * kbg][3]); tp.z = pk2(Tst[2 * kbg + 1][0], Tst[2 * kbg + 1][1]); tp.w = pk2(Tst[2 * kbg + 1][2], Tst[2 * kbg + 1][3]);
                const bf16x8 tb = __builtin_bit_cast(bf16x8, tp);
                const int ol = (((4 * kb + (g >> 1)) ^ fA) * 16) + 8 * (g & 1), oh = (((4 * kb + (g >> 1) + 2) ^ fA) * 16) + 8 * (g & 1);
#pragma unroll
                for (int cb = 0; cb < 8; ++cb) {
                    const LAS unsigned char* qp = Qb + (16 * cb + i16) * 128;
                    const s16x4 lo = *(const LAS s16x4*)(qp + ol), hi4 = *(const LAS s16x4*)(qp + oh);
                    const bf16x8 aq = __builtin_shufflevector(lo, hi4, 0, 1, 2, 3, 4, 5, 6, 7);
                    cr[cb] = MFMA16(aq, tb, cr[cb]);
                }
                __builtin_amdgcn_sched_barrier(0);
            }
#pragma unroll
            for (int dtp = 0; dtp < 2; ++dtp) {
                const int dt0 = 4 * qd + 2 * dtp;
                Tst[dt0] = Tst[dt0] * g128; Tst[dt0 + 1] = Tst[dt0 + 1] * g128;
                const int ot0 = (((4 * dtp + (pp >> 1)) ^ fT) * 16) + 8 * (pp & 1), ot1 = (((4 * dtp + 2 + (pp >> 1)) ^ fT) * 16) + 8 * (pp & 1);
#pragma unroll
                for (int cbk = 0; cbk < 4; ++cbk) {
                    const LAS unsigned char* ap = Kb + (32 * cbk + 8 * g + qq) * 128;
                    const s16x4 lo0 = tr_read(ap + ot0), hi0 = tr_read(ap + 4 * 128 + (ot0 ^ 16));
                    const s16x4 lo1 = tr_read(ap + ot1), hi1 = tr_read(ap + 4 * 128 + (ot1 ^ 16));
                    const bf16x8 ak0 = __builtin_shufflevector(lo0, hi0, 0, 1, 2, 3, 4, 5, 6, 7), ak1 = __builtin_shufflevector(lo1, hi1, 0, 1, 2, 3, 4, 5, 6, 7);
                    Tst[dt0] = MFMA16(ak0, vf[cbk], Tst[dt0]);
                    Tst[dt0 + 1] = MFMA16(ak1, vf[cbk], Tst[dt0 + 1]);
                }
                __builtin_amdgcn_sched_barrier(0);
            }
            asm volatile("s_waitcnt vmcnt(0)" ::: "memory");
            __syncthreads();
        }
#pragma unroll
        for (int cb = 0; cb < 8; ++cb) cr[cb] = cr[cb] * g128;
#pragma unroll
        for (int cb = 0; cb < 8; ++cb)
#pragma unroll
            for (int mbk = 0; mbk < 4; ++mbk) if (32 * mbk <= 16 * cb + 15) {
                const bf16x8 ap = *(const LAS bf16x8*)(lds + R2_P + (16 * cb + i16) * 256 + (((4 * mbk + g) ^ i16) * 16));
                cr[cb] = MFMA16(ap, vf[mbk], cr[cb]);
            }
        __syncthreads();
        {
            const ldsp ob = lds + R2_P + (16 * w + i16) * 2;
#pragma unroll
            for (int cb = 0; cb < 8; ++cb)
#pragma unroll
                for (int j = 0; j < 4; ++j) *(LAS unsigned short*)(ob + (16 * cb + 4 * g + j) * 256) = (unsigned short)(pk2(cr[cb][j], 0.f) & 0xffffu);
        }
        __syncthreads();
        {
            const int row = tid >> 2, seg = tid & 3;
            const LAS u32x4* src = (const LAS u32x4*)(lds + R2_P + row * 256 + seg * 64);
            u32x4* dst = (u32x4*)(RV + (rowbase + c0 + row) * 2048 + hh * 512 + es * 128 + seg * 32);
            float s = 0.f;
#pragma unroll
            for (int k = 0; k < 4; ++k) { const u32x4 v = src[k]; dst[k] = v; f32x4 fa, fb; unpack8(v, fa, fb);
                s += (fa[0] * fa[0] + fa[1] * fa[1]) + (fa[2] * fa[2] + fa[3] * fa[3]) + (fb[0] * fb[0] + fb[1] * fb[1]) + (fb[2] * fb[2] + fb[3] * fb[3]); }
            s += __shfl_xor(s, 1); s += __shfl_xor(s, 2);
            if (seg == 0) RS[(rowbase + c0 + row) * 16 + hh * 4 + es] = s;
        }
        __syncthreads();
    }
    __syncthreads();
}

#define GEMM_PHASE2(EpiT, E, Aptr, Bptr, N_, K_, A2ptr, SPLIT_) do { pg8::Gemm g_{(const pg8::bf16_t*)(Aptr), (const pg8::bf16_t*)(Bptr), T_, (N_), (K_), (const pg8::bf16_t*)(A2ptr), (SPLIT_)}; pg8::StaticOrder S_o; S_o.init(T_, (N_), G, (int)blockIdx.x); \
    pg8::gemm_phase<EpiT, pg8::StaticOrder, true, true>(lds, g_, S_o, (E)); } while (0)
#define GEMM_PHASE(EpiT, E, Aptr, Bptr, N_, K_) GEMM_PHASE2(EpiT, E, Aptr, Bptr, N_, K_, Aptr, (1 << 30))
#ifndef PH_LO
#define PH_LO 0
#endif
#ifndef PH_HI
#define PH_HI 99
#endif
#define XB_TMO      128
#define XB_XCNT(j)  (256  + 64 * (j))
#define XB_XSUB(j)  (1280 + 64 * (j))
#define XB_XGEN(j)  (2304 + 64 * (j))
#define XB_TOP      3328
#define XB_TOPGEN   3392
#define XCD_BAR_WORDS 3456
#define XB_SPIN_CAP (1u << 18)

__device__ __forceinline__ unsigned xb_ld(unsigned* p)              { return __hip_atomic_load(p, __ATOMIC_RELAXED, __HIP_MEMORY_SCOPE_AGENT); }
__device__ __forceinline__ unsigned xb_add(unsigned* p, unsigned v) { return __hip_atomic_fetch_add(p, v, __ATOMIC_RELAXED, __HIP_MEMORY_SCOPE_AGENT); }
__device__ __forceinline__ unsigned xb_xcc_id() { return (unsigned)__builtin_amdgcn_s_getreg((3 << 11) | 20) & 0xFu; }
#define XB_SPIN(cond, bar) do { unsigned _sp = 0; while (cond) { __builtin_amdgcn_s_sleep(1); \
    if ((++_sp & 255u) == 0u) { if (xb_ld(&(bar)[XB_TMO])) break; if (_sp > XB_SPIN_CAP) { atomicAdd(&(bar)[XB_TMO], 1u); break; } } } } while (0)

struct XcdBarrier {
    unsigned* bar; unsigned x;
    volatile LAS unsigned* st;
};

__device__ __forceinline__ XcdBarrier xcd_barrier_post(unsigned* bar, volatile LAS unsigned* st) {
    XcdBarrier b; b.bar = bar; b.x = xb_xcc_id(); b.st = st;
    if (threadIdx.x == 0) (void)xb_add(&bar[XB_XCNT(b.x)], 1u);
    return b;
}
__device__ __forceinline__ void xcd_barrier_complete(unsigned* bar, unsigned x, unsigned& nloc, unsigned& nx) {
    const unsigned G = gridDim.x * gridDim.y * gridDim.z;
    unsigned sum, cnt, mine, sp = 0u;
    for (;;) {
        sum = 0u; cnt = 0u; mine = 0u;
#pragma unroll
        for (unsigned j = 0; j < 16; ++j) { const unsigned c = xb_ld(&bar[XB_XCNT(j)]); sum += c; cnt += (c > 0u) ? 1u : 0u; mine = (j == x) ? c : mine; }
        if (sum == G) break;
        __builtin_amdgcn_s_sleep(1);
        if ((++sp & 255u) == 0u) { if (xb_ld(&bar[XB_TMO])) break; if (sp > XB_SPIN_CAP) { atomicAdd(&bar[XB_TMO], 1u); break; } }
    }
    nloc = mine > 0u ? mine : 1u; nx = cnt > 0u ? cnt : 1u;
}

__device__ __forceinline__ void xcd_barrier(const XcdBarrier& b) {
    asm volatile("s_waitcnt vmcnt(0)" ::: "memory");
    __syncthreads();
    if (threadIdx.x == 0) {
        unsigned* bar = b.bar;
        __builtin_amdgcn_s_waitcnt(0);
        unsigned nloc = b.st[0], nx = b.st[1];
        if (nloc == 0u) { xcd_barrier_complete(bar, b.x, nloc, nx); b.st[0] = nloc; b.st[1] = nx; }
        const unsigned old = xb_add(&bar[XB_XSUB(b.x)], 1u);
        const unsigned gen = old / nloc;
        if (old + 1u == (gen + 1u) * nloc) {
            __builtin_amdgcn_fence(__ATOMIC_RELEASE, "agent");
            asm volatile("s_waitcnt vmcnt(0)" ::: "memory");
            const unsigned og = xb_add(&bar[XB_TOP], 1u);
            const unsigned tg = og / nx;
            if (og + 1u == (tg + 1u) * nx) xb_add(&bar[XB_TOPGEN], 1u);
            else XB_SPIN(xb_ld(&bar[XB_TOPGEN]) == tg, bar);
            __builtin_amdgcn_fence(__ATOMIC_ACQUIRE, "agent");
            xb_add(&bar[XB_XGEN(b.x)], 1u);
            asm volatile("s_waitcnt vmcnt(0)" ::: "memory");
        } else {
            XB_SPIN(xb_ld(&bar[XB_XGEN(b.x)]) == gen, bar);
            __builtin_amdgcn_fence(__ATOMIC_ACQUIRE, "agent");
            asm volatile("s_waitcnt vmcnt(0)" ::: "memory");
        }
    }
    __syncthreads();
}

DI void fast_grid_barrier(unsigned* ctr, unsigned target) {
    asm volatile("s_waitcnt vmcnt(0)" ::: "memory");
    __syncthreads();
    if (threadIdx.x == 0) {
        __builtin_amdgcn_fence(__ATOMIC_RELEASE, "agent");
        asm volatile("s_waitcnt vmcnt(0)" ::: "memory");
        __hip_atomic_fetch_add(ctr, 1u, __ATOMIC_RELAXED, __HIP_MEMORY_SCOPE_AGENT);
        while (__hip_atomic_load(ctr, __ATOMIC_RELAXED, __HIP_MEMORY_SCOPE_AGENT) < target) __builtin_amdgcn_s_sleep(1);
        __builtin_amdgcn_fence(__ATOMIC_ACQUIRE, "agent");
        asm volatile("s_waitcnt vmcnt(0)" ::: "memory");
    }
    __syncthreads();
}
typedef const __attribute__((address_space(4))) Args* kargp;
#if defined(__HIP_DEVICE_COMPILE__)
DI Args load_args() { kargp kp = (kargp)__builtin_amdgcn_kernarg_segment_ptr(); asm volatile("" : "+s"(kp)); Args a;
    a.x = kp->x; a.c = kp->c; a.w_ada = kp->w_ada; a.b_ada = kp->b_ada; a.g1 = kp->g1; a.w_in = kp->w_in; a.b_branch = kp->b_branch; a.w_sb = kp->w_sb; a.w_ret = kp->w_ret; a.w_out = kp->w_out;
    a.g2 = kp->g2; a.w_ffi = kp->w_ffi; a.w_ffo = kp->w_ffo; a.gf = kp->gf; a.out = kp->out; a.ws = kp->ws; return a; }
#else
DI Args load_args() { return Args{}; }
#endif
#define PHASE_ARGS const Args A = load_args(); unsigned char* const ws = A.ws; bf16* const hmix = (bf16*)A.out; (void)ws; (void)hmix
__global__ void __launch_bounds__(NTHR, 2) fwd_megakernel(Args Aunused) {
    extern __shared__ __attribute__((aligned(16))) unsigned char lds_raw[];
    ldsp lds = (ldsp)lds_raw;
    cg::grid_group grid = cg::this_grid();
    const int G = gridDim.x;
    unsigned bar_k = 0u; (void)bar_k;
    volatile LAS unsigned* xb_st = (volatile LAS unsigned*)(lds + LDS_BYTES - 64);
    if (threadIdx.x < 2) xb_st[threadIdx.x] = 0u;
    XcdBarrier xbar; xbar.bar = nullptr; xbar.x = 0; xbar.st = xb_st;
#define GBAR() do { xcd_barrier(xbar); } while (0)
#ifndef PHM
#define PHM 0xFFFFF
#endif
    if (PHM & 1) { PHASE_ARGS; if (blockIdx.x == 0) { for (int i = threadIdx.x; i < XCD_BAR_WORDS; i += NTHR) __hip_atomic_store((unsigned*)(ws + WS_CTR) + 1024 + i, 0u, __ATOMIC_RELAXED, __HIP_MEMORY_SCOPE_AGENT); }
      if (blockIdx.x == 0 && threadIdx.x == 0) { __hip_atomic_store((unsigned*)(ws + WS_CTR), 0u, __ATOMIC_RELAXED, __HIP_MEMORY_SCOPE_AGENT); __hip_atomic_store((unsigned*)(ws + WS_CTR) + 64, 0u, __ATOMIC_RELAXED, __HIP_MEMORY_SCOPE_AGENT); } p0_prologue<0>(A, lds, G); }
    grid.sync();
    { PHASE_ARGS; xbar = xcd_barrier_post((unsigned*)(ws + WS_CTR) + 1024, xb_st); }
    if (PHM & 2) { PHASE_ARGS; norm_mod_phase<true>(A, lds, G, A.x, A.g1, hmix, 0); p0_prologue<1>(A, lds, G); }
    GBAR();
    if (PHM & 4) { PHASE_ARGS; EpiInProj E{(bf16*)(ws + WS_SBQ), (bf16*)(ws + WS_SBK), (bf16*)(ws + WS_SBV), (bf16*)(ws + WS_RQ), (bf16*)(ws + WS_RK), (bf16*)(ws + WS_RV), (const float*)(ws + WS_COS), (const float*)(ws + WS_SIN)};
      GEMM_PHASE(EpiInProj, E, hmix, ws + WS_WIN, 7168, 1024); }
    GBAR();
    if (PHM & 8) { PHASE_ARGS; for (int it = blockIdx.x; it < 1024; it += G) ret_scores_item(lds, (const bf16*)(ws + WS_RQ), (const bf16*)(ws + WS_RK), (bf16*)((unsigned char*)A.out + 64 * MiB), it); }
    __syncthreads();
    if (PHM & 16) { PHASE_ARGS;
        const int wv = __builtin_amdgcn_readfirstlane(threadIdx.x >> 6);
        unsigned* ctr = (unsigned*)(ws + WS_CTR);
        for (;;) {
            unsigned uu = 0u;
            if ((threadIdx.x & 63) == 0) uu = __hip_atomic_fetch_add(ctr, 1u, __ATOMIC_RELAXED, __HIP_MEMORY_SCOPE_AGENT);
            const int u = __builtin_amdgcn_readfirstlane((int)uu);
            if (u >= 16384) break;
            sb_attn_wave(lds + wv * 16384, (const bf16*)(ws + WS_SBQ), (const bf16*)(ws + WS_SBK), (const bf16*)(ws + WS_SBV), (bf16*)(ws + WS_SBQ), u >> 10, (u >> 6) & 15, 63 - (u & 63));
        }
    }
    GBAR();
    if (PHM & 0x2000) { PHASE_ARGS; for (int u = blockIdx.x; u < 256; u += G) retention_unit2(lds, (const bf16*)(ws + WS_RQ), (const bf16*)(ws + WS_RK), (bf16*)(ws + WS_RV), (const bf16*)((unsigned char*)A.out + 64 * MiB), (float*)(ws + WS_RS), u >> 4, (u >> 2) & 3, u & 3); }
    GBAR();
    if (PHM & 32) { PHASE_ARGS; EpiGates E{(bf16*)(ws + WS_RV), (bf16*)(ws + WS_GATES), (const float*)(ws + WS_RS), A.b_branch, (bf16*)(ws + WS_M1)};
      GEMM_PHASE2(EpiGates, E, hmix, ws + WS_WIN + (size_t)7168 * 1024 * 2, 5120, 1024, ws + WS_SBQ, 16); }
    GBAR();
    if (PHM & 128) { PHASE_ARGS; EpiMerge2 E{(const bf16*)(ws + WS_GATES), (const bf16*)(ws + WS_M1), (bf16*)(ws + WS_MERGED)};
      GEMM_PHASE(EpiMerge2, E, ws + WS_RV, ws + WS_WRET, 1024, 2048); }
    GBAR();
    if (PHM & 256) { PHASE_ARGS; EpiResid<false> E{A.x, (bf16*)(ws + WS_X2), (const float*)(ws + WS_MODF) + 2048};
      GEMM_PHASE(EpiResid<false>, E, ws + WS_MERGED, ws + WS_WOUT, 1024, 1024); }
    GBAR();
    if (PHM & 512) { PHASE_ARGS; norm_mod_phase<false>(A, lds, G, (const float*)(ws + WS_X2), A.g2, (bf16*)(ws + WS_HFFN), 3072); }
    GBAR();
    if (PHM & 1024) { PHASE_ARGS; EpiSwiglu E{(bf16*)(ws + WS_H)};
      GEMM_PHASE(EpiSwiglu, E, ws + WS_HFFN, ws + WS_WFFI, 2 * DFF, 1024); }
    GBAR();
    if (PHM & 2048) { PHASE_ARGS; EpiResid<true> E{(const void*)(ws + WS_X2), (bf16*)(ws + WS_X2), (const float*)(ws + WS_MODF) + 5120};
      GEMM_PHASE(EpiResid<true>, E, ws + WS_H, ws + WS_WFFO, 1024, DFF); }
    GBAR();
    if (PHM & 4096) { PHASE_ARGS; final_norm_phase(A, G, (const bf16*)(ws + WS_X2)); }
}

extern "C" void kernel_launch(void* const* d_in, const int* in_sizes, int n_in, void* d_out, int out_size, void* d_ws, size_t ws_size, hipStream_t stream) {
    static int grid = 0;
    if (grid == 0) {
        if (n_in != 14 || in_sizes[0] != T_ * D_ || out_size != T_ * D_ || ws_size < WS_END) { fprintf(stderr, "kernel_launch: unexpected shapes / ws %zu\n", ws_size); grid = -1; return; }
        int dev = 0, cus = 0, per_cu = 0;
        hipGetDevice(&dev); hipDeviceGetAttribute(&cus, hipDeviceAttributeMultiprocessorCount, dev);
        if (hipFuncSetAttribute((const void*)fwd_megakernel, hipFuncAttributeMaxDynamicSharedMemorySize, LDS_BYTES) != hipSuccess) { fprintf(stderr, "hipFuncSetAttribute failed\n"); grid = -1; return; }
        if (hipOccupancyMaxActiveBlocksPerMultiprocessor(&per_cu, (const void*)fwd_megakernel, NTHR, LDS_BYTES) != hipSuccess || per_cu < 1) { fprintf(stderr, "occupancy query: %d\n", per_cu); per_cu = 1; }
        (void)hipGetLastError();
        grid = cus * per_cu;
    }
    if (grid < 0) return;
    Args a{};
    a.x = (const float*)d_in[0]; a.c = (const float*)d_in[1]; a.w_ada = (const float*)d_in[2]; a.b_ada = (const float*)d_in[3]; a.g1 = (const float*)d_in[4];
    a.w_in = (const float*)d_in[5]; a.b_branch = (const float*)d_in[6]; a.w_sb = (const float*)d_in[7]; a.w_ret = (const float*)d_in[8]; a.w_out = (const float*)d_in[9];
    a.g2 = (const float*)d_in[10]; a.w_ffi = (const float*)d_in[11]; a.w_ffo = (const float*)d_in[12]; a.gf = (const float*)d_in[13];
    a.out = (float*)d_out; a.ws = (unsigned char*)d_ws;
    void* args[] = {&a};
    hipError_t e = hipLaunchCooperativeKernel((const void*)fwd_megakernel, dim3(grid), dim3(NTHR), args, LDS_BYTES, stream);
    if (e != hipSuccess) fprintf(stderr, "cooperative launch failed: %s (grid %d)\n", hipGetErrorString(e), grid);
}
```
